# Optimizing an MI355X kernel written in HIP

```python
import math
import jax
import jax.numpy as jnp
from jax import lax
import numpy as np

D_MODEL = 1024
BATCH = 8
SEQ = 2048
DEPTH = 1
DEC_BATCH = 32
DEC_SEQ = 8
PAST_LEN = 8192
PAGE_SIZE = 128

ATTN_HEADS = 4
QK_DIM = 64
V_DIM = 2 * QK_DIM
ATTN_WIDTH = ATTN_HEADS * V_DIM
QK_COLS = ATTN_HEADS * 2 * QK_DIM
ROT_DIM = QK_DIM // 4
ROPE_THETA = 500000.0
Q_BLOCK = 128
RG_WIDTH = D_MODEL - ATTN_WIDTH
RG_BLOCKS = 8
RG_BLOCK_W = RG_WIDTH // RG_BLOCKS
RG_C = 8.0
CONV_WIDTH = 4
MIX_WIDTH = ATTN_WIDTH + RG_WIDTH
IN_WIDTH = 2 * QK_COLS + ATTN_WIDTH + 2 * RG_WIDTH
PEER_HEADS = 8
PEER_KEYS = 128
PEER_EXPERTS = PEER_KEYS * PEER_KEYS
PEER_TOPK = 16
PEER_QHALF = 128
PEER_BLOCK = 128
PLE_DIM = 256
LN_EPS = 1e-5
DEEPNORM_ALPHA = (2.0 * DEPTH) ** 0.25
DEEPNORM_BETA = (8.0 * DEPTH) ** -0.25

kernel_name = 'hybrid_diffattn_rglru_peer_step'


def layer_norm(x, g, b):
    xf = x.astype(jnp.float32)
    mu = jnp.mean(xf, -1, keepdims=True)
    var = jnp.mean(jnp.square(xf - mu), -1, keepdims=True)
    return ((xf - mu) * lax.rsqrt(var + LN_EPS)).astype(x.dtype) * g + b


def rotary(x, pos):
    half = ROT_DIM // 2
    inv_freq = jnp.float32(ROPE_THETA) ** (-jnp.arange(0, ROT_DIM, 2, dtype=jnp.float32) / ROT_DIM)
    ang = pos.astype(jnp.float32)[:, None] * inv_freq[None, :]
    cos = jnp.cos(ang)[:, None, None, :]
    sin = jnp.sin(ang)[:, None, None, :]
    xr = x[..., :ROT_DIM].astype(jnp.float32)
    x1, x2 = xr[..., :half], xr[..., half:]
    rot = jnp.concatenate([x1 * cos - x2 * sin, x2 * cos + x1 * sin], -1).astype(x.dtype)
    return jnp.concatenate([rot, x[..., ROT_DIM:]], -1)


def diff_attention(q, k, v, q_pos, k_pos, lam):
    s = jnp.einsum('bqhmd,bkhmd->bhmqk', q, k).astype(jnp.float32) * (QK_DIM ** -0.5)
    mask = k_pos[None, :] <= q_pos[:, None]
    p = jax.nn.softmax(jnp.where(mask, s, -jnp.inf), axis=-1)
    w = (p[:, :, 0] - lam * p[:, :, 1]).astype(v.dtype)
    return jnp.einsum('bhqk,bkhd->bqhd', w, v)


def prompt_attention(q, k, v, pos, lam):
    b, s = q.shape[:2]
    nb = s // Q_BLOCK
    qb = jnp.moveaxis(q.reshape(b, nb, Q_BLOCK, ATTN_HEADS, 2, QK_DIM), 1, 0)
    pb = pos.reshape(nb, Q_BLOCK)
    o = lax.map(lambda a: diff_attention(a[0], k, v, a[1], pos, lam), (qb, pb))
    return jnp.moveaxis(o, 0, 1).reshape(b, s, ATTN_HEADS, V_DIM)


def sample_attention(q, k, v, pos, past_k, past_v, lam):
    k_all = jnp.concatenate([past_k.astype(k.dtype), k], 1)
    v_all = jnp.concatenate([past_v.astype(v.dtype), v], 1)
    k_pos = jnp.arange(k_all.shape[1])
    return diff_attention(q, k_all, v_all, pos, k_pos, lam)


def _lin_combine(e1, e2):
    a1, b1 = e1
    a2, b2 = e2
    return a1 * a2, a2 * b1 + b2


def rg_lru_branch(xr, gate, h0, conv_buf, conv_w, conv_b, wa, ba, wx, bx, lam):
    b, s, c = xr.shape
    xp = jnp.concatenate([conv_buf.astype(xr.dtype), xr], 1)
    xc = conv_b + sum(xp[:, j:j + s] * conv_w[j] for j in range(CONV_WIDTH))
    conv_new = xp[:, -(CONV_WIDTH - 1):]
    xb = xc.reshape(b, s, RG_BLOCKS, RG_BLOCK_W)
    r = jax.nn.sigmoid(jnp.einsum('bsnc,ncd->bsnd', xb, wa).reshape(b, s, c) + ba)
    i = jax.nn.sigmoid(jnp.einsum('bsnc,ncd->bsnd', xb, wx).reshape(b, s, c) + bx)
    log_a = -RG_C * jax.nn.softplus(-lam.astype(jnp.float32)) * r.astype(jnp.float32)
    a = jnp.exp(log_a)
    u = jnp.sqrt(-jnp.expm1(2.0 * log_a)) * (i * xc).astype(jnp.float32)
    u = u.at[:, 0].add(a[:, 0] * h0.astype(jnp.float32))
    _, h = lax.associative_scan(_lin_combine, (a, u), axis=1)
    y = h.astype(xr.dtype) * jax.nn.gelu(gate)
    return y, h[:, -1].astype(xr.dtype), conv_new


def peer_ffn(x, wq, keys, u_tab, v_tab):
    b, s, d = x.shape
    t = x.reshape(b * s, d)
    n_tok = t.shape[0]
    n_blk = -(-n_tok // PEER_BLOCK)
    t = jnp.pad(t, ((0, n_blk * PEER_BLOCK - n_tok), (0, 0))).reshape(n_blk, PEER_BLOCK, d)

    def block(tb):
        q = (tb @ wq).reshape(PEER_BLOCK, PEER_HEADS, 2, PEER_QHALF)
        sc = jnp.einsum('thpd,hpnd->thpn', q, keys).astype(jnp.float32)
        s1, i1 = lax.top_k(sc[:, :, 0], PEER_TOPK)
        s2, i2 = lax.top_k(sc[:, :, 1], PEER_TOPK)
        cand = (s1[..., :, None] + s2[..., None, :]).reshape(PEER_BLOCK, PEER_HEADS, PEER_TOPK * PEER_TOPK)
        cidx = (i1[..., :, None] * PEER_KEYS + i2[..., None, :]).reshape(PEER_BLOCK, PEER_HEADS, PEER_TOPK * PEER_TOPK)
        top_s, top_p = lax.top_k(cand, PEER_TOPK)
        eidx = jnp.take_along_axis(cidx, top_p, axis=-1)
        g = jax.nn.softmax(top_s, axis=-1)
        act = jax.nn.gelu(jnp.einsum('td,thkd->thk', tb, u_tab[eidx]))
        w = (g * act.astype(jnp.float32)).astype(tb.dtype)
        return jnp.einsum('thk,thkd->td', w, v_tab[eidx])

    out = lax.map(block, t).reshape(n_blk * PEER_BLOCK, d)[:n_tok]
    return out.reshape(b, s, d)


def decoder_layer(x, pe, pos, h0, conv_buf, attend, lam_init, w):
    b, s, _ = x.shape
    proj = x @ w['w_in']
    c1 = QK_COLS
    c2 = 2 * QK_COLS
    c3 = c2 + ATTN_WIDTH
    c4 = c3 + RG_WIDTH
    q, k, v, xr, gate = proj[..., :c1], proj[..., c1:c2], proj[..., c2:c3], proj[..., c3:c4], proj[..., c4:]
    q = rotary(q.reshape(b, s, ATTN_HEADS, 2, QK_DIM), pos)
    k = rotary(k.reshape(b, s, ATTN_HEADS, 2, QK_DIM), pos)
    v = v.reshape(b, s, ATTN_HEADS, V_DIM)
    o = attend(q, k, v).astype(jnp.float32)
    o = o * lax.rsqrt(jnp.mean(o * o, -1, keepdims=True) + LN_EPS) * (1.0 - lam_init)
    o = (o.astype(x.dtype) * w['subln_g']).reshape(b, s, ATTN_WIDTH)
    yr, h_last, conv_new = rg_lru_branch(xr, gate, h0, conv_buf, w['conv_w'], w['conv_b'],
                                         w['rg_wa'], w['rg_ba'], w['rg_wx'], w['rg_bx'], w['rg_lambda'])
    mix = jnp.concatenate([o, yr], -1) @ w['w_out']
    x1 = layer_norm(DEEPNORM_ALPHA * x + mix, w['ln1_g'], w['ln1_b'])
    ffn = peer_ffn(x1, w['peer_wq'], w['peer_keys'], w['peer_u'], w['peer_v'])
    x2 = layer_norm(DEEPNORM_ALPHA * x1 + ffn, w['ln2_g'], w['ln2_b'])
    gate_ple = jax.nn.sigmoid(x2 @ w['ple_gate_w'] + w['ple_gate_b'])
    y = x2 + gate_ple * (pe.astype(x.dtype) @ w['ple_w'])
    return y, k.reshape(b, s, ATTN_HEADS, 2 * QK_DIM), v, h_last, conv_new


def setup_inputs(seed: int = 0) -> dict:
    key = jax.random.key(seed)
    ks = iter(jax.random.split(key, 40))
    n_pages = PAST_LEN // PAGE_SIZE
    n_pool = (DEC_BATCH * n_pages * 5) // 4

    def nrm(shape, scale):
        return jax.random.normal(next(ks), shape, jnp.float32) * scale

    x_prompt = nrm((BATCH, SEQ, D_MODEL), 1.0)
    x_sample = nrm((DEC_BATCH, DEC_SEQ, D_MODEL), 1.0)
    p_prompt = nrm((DEPTH, BATCH, SEQ, PLE_DIM), 1.0)
    p_sample = nrm((DEPTH, DEC_BATCH, DEC_SEQ, PLE_DIM), 1.0)
    cache_k = nrm((DEPTH, n_pool, PAGE_SIZE, ATTN_HEADS, 2 * QK_DIM), 1.0)
    cache_v = nrm((DEPTH, n_pool, PAGE_SIZE, ATTN_HEADS, V_DIM), 1.0)
    state_h = nrm((DEPTH, DEC_BATCH, RG_WIDTH), 0.5)
    state_conv = nrm((DEPTH, DEC_BATCH, CONV_WIDTH - 1, RG_WIDTH), 1.0)
    page_table = jax.random.permutation(next(ks), n_pool)[:DEC_BATCH * n_pages].reshape(DEC_BATCH, n_pages).astype(jnp.int32)
    w_in = nrm((DEPTH, D_MODEL, IN_WIDTH), D_MODEL ** -0.5)
    lambda_q1 = nrm((DEPTH, QK_DIM), 0.1)
    lambda_k1 = nrm((DEPTH, QK_DIM), 0.1)
    lambda_q2 = nrm((DEPTH, QK_DIM), 0.1)
    lambda_k2 = nrm((DEPTH, QK_DIM), 0.1)
    subln_g = 1.0 + nrm((DEPTH, V_DIM), 0.01)
    conv_w = nrm((DEPTH, CONV_WIDTH, RG_WIDTH), CONV_WIDTH ** -0.5)
    conv_b = nrm((DEPTH, RG_WIDTH), 0.01)
    rg_wa = nrm((DEPTH, RG_BLOCKS, RG_BLOCK_W, RG_BLOCK_W), RG_BLOCK_W ** -0.5)
    rg_ba = nrm((DEPTH, RG_WIDTH), 0.01)
    rg_wx = nrm((DEPTH, RG_BLOCKS, RG_BLOCK_W, RG_BLOCK_W), RG_BLOCK_W ** -0.5)
    rg_bx = nrm((DEPTH, RG_WIDTH), 0.01)
    a_pow = jax.random.uniform(next(ks), (DEPTH, RG_WIDTH), jnp.float32, 0.9, 0.999)
    sig = a_pow ** (1.0 / RG_C)
    rg_lambda = jnp.log(sig) - jnp.log1p(-sig)
    w_out = nrm((DEPTH, MIX_WIDTH, D_MODEL), DEEPNORM_BETA * MIX_WIDTH ** -0.5)
    ln1_g = 1.0 + nrm((DEPTH, D_MODEL), 0.01)
    ln1_b = nrm((DEPTH, D_MODEL), 0.01)
    peer_wq = nrm((DEPTH, D_MODEL, PEER_HEADS * 2 * PEER_QHALF), D_MODEL ** -0.5)
    peer_keys = nrm((DEPTH, PEER_HEADS, 2, PEER_KEYS, PEER_QHALF), PEER_QHALF ** -0.5)
    peer_u = nrm((DEPTH, PEER_EXPERTS, D_MODEL), D_MODEL ** -0.5)
    peer_v = nrm((DEPTH, PEER_EXPERTS, D_MODEL), DEEPNORM_BETA * PEER_HEADS ** -0.5)
    ln2_g = 1.0 + nrm((DEPTH, D_MODEL), 0.01)
    ln2_b = nrm((DEPTH, D_MODEL), 0.01)
    ple_w = nrm((DEPTH, PLE_DIM, D_MODEL), DEEPNORM_BETA * PLE_DIM ** -0.5)
    ple_gate_w = nrm((DEPTH, D_MODEL, D_MODEL), D_MODEL ** -0.5)
    ple_gate_b = nrm((DEPTH, D_MODEL), 0.01)
    return {'x_prompt': x_prompt, 'x_sample': x_sample, 'p_prompt': p_prompt, 'p_sample': p_sample,
            'cache_k': cache_k, 'cache_v': cache_v, 'state_h': state_h, 'state_conv': state_conv,
            'page_table': page_table, 'w_in': w_in, 'lambda_q1': lambda_q1, 'lambda_k1': lambda_k1,
            'lambda_q2': lambda_q2, 'lambda_k2': lambda_k2, 'subln_g': subln_g, 'conv_w': conv_w,
            'conv_b': conv_b, 'rg_wa': rg_wa, 'rg_ba': rg_ba, 'rg_wx': rg_wx, 'rg_bx': rg_bx,
            'rg_lambda': rg_lambda, 'w_out': w_out, 'ln1_g': ln1_g, 'ln1_b': ln1_b,
            'peer_wq': peer_wq, 'peer_keys': peer_keys, 'peer_u': peer_u, 'peer_v': peer_v,
            'ln2_g': ln2_g, 'ln2_b': ln2_b, 'ple_w': ple_w, 'ple_gate_w': ple_gate_w,
            'ple_gate_b': ple_gate_b}


def reference(x_prompt, x_sample, p_prompt, p_sample, cache_k, cache_v, state_h, state_conv,
              page_table, w_in, lambda_q1, lambda_k1, lambda_q2, lambda_k2, subln_g, conv_w,
              conv_b, rg_wa, rg_ba, rg_wx, rg_bx, rg_lambda, w_out, ln1_g, ln1_b, peer_wq,
              peer_keys, peer_u, peer_v, ln2_g, ln2_b, ple_w, ple_gate_w, ple_gate_b):
    bp, s = x_prompt.shape[:2]
    bd, t = x_sample.shape[:2]
    past = page_table.shape[1] * cache_k.shape[2]
    pos_p = jnp.arange(s)
    pos_d = past + jnp.arange(t)
    xp, xd = x_prompt, x_sample
    kp_l, vp_l, hp_l, cp_l, kd_l, vd_l, hd_l, cd_l = [], [], [], [], [], [], [], []
    for l in range(DEPTH):
        lam_init = 0.8 - 0.6 * math.exp(-0.3 * l)
        lam = (jnp.exp(jnp.sum(lambda_q1[l].astype(jnp.float32) * lambda_k1[l].astype(jnp.float32)))
               - jnp.exp(jnp.sum(lambda_q2[l].astype(jnp.float32) * lambda_k2[l].astype(jnp.float32)))
               + lam_init)
        w = {'w_in': w_in[l], 'subln_g': subln_g[l], 'conv_w': conv_w[l], 'conv_b': conv_b[l],
             'rg_wa': rg_wa[l], 'rg_ba': rg_ba[l], 'rg_wx': rg_wx[l], 'rg_bx': rg_bx[l],
             'rg_lambda': rg_lambda[l], 'w_out': w_out[l], 'ln1_g': ln1_g[l], 'ln1_b': ln1_b[l],
             'peer_wq': peer_wq[l], 'peer_keys': peer_keys[l], 'peer_u': peer_u[l],
             'peer_v': peer_v[l], 'ln2_g': ln2_g[l], 'ln2_b': ln2_b[l], 'ple_w': ple_w[l],
             'ple_gate_w': ple_gate_w[l], 'ple_gate_b': ple_gate_b[l]}
        h0_p = jnp.zeros((bp, RG_WIDTH), xp.dtype)
        cb_p = jnp.zeros((bp, CONV_WIDTH - 1, RG_WIDTH), xp.dtype)
        xp, kp, vp, hp, cp = decoder_layer(
            xp, p_prompt[l], pos_p, h0_p, cb_p,
            lambda q, k, v: prompt_attention(q, k, v, pos_p, lam), lam_init, w)
        past_k = cache_k[l][page_table].reshape(bd, past, ATTN_HEADS, 2, QK_DIM)
        past_v = cache_v[l][page_table].reshape(bd, past, ATTN_HEADS, V_DIM)
        xd, kd, vd, hd, cd = decoder_layer(
            xd, p_sample[l], pos_d, state_h[l], state_conv[l],
            lambda q, k, v: sample_attention(q, k, v, pos_d, past_k, past_v, lam), lam_init, w)
        kp_l.append(kp)
        vp_l.append(vp)
        hp_l.append(hp)
        cp_l.append(cp)
        kd_l.append(kd)
        vd_l.append(vd)
        hd_l.append(hd)
        cd_l.append(cd)
    k_prompt = jnp.stack(kp_l)
    v_prompt = jnp.stack(vp_l)
    h_prompt = jnp.stack(hp_l)
    conv_prompt = jnp.stack(cp_l)
    k_sample = jnp.stack(kd_l)
    v_sample = jnp.stack(vd_l)
    h_sample = jnp.stack(hd_l)
    conv_sample = jnp.stack(cd_l)
    return (xp, xd, k_prompt, v_prompt, h_prompt, conv_prompt, k_sample, v_sample, h_sample, conv_sample)
```

```cpp
#include <hip/hip_runtime.h>
#include <cstdio>
#include <cstdint>
namespace pg8 {
#define PG8_LAS __attribute__((address_space(3)))
typedef unsigned short bf16_t;
typedef short bf16x8 __attribute__((ext_vector_type(8)));
typedef float f32x4 __attribute__((ext_vector_type(4)));
typedef unsigned u32x4 __attribute__((ext_vector_type(4)));
constexpr int BM = 256, BK = 64, HALF = 128, HTB = HALF * BK * 2  , STAGE_BYTES = 8 * HTB, NXCD = 8, WGM = 8;

__host__ __device__ __forceinline__ int lds_byte(int r, int c) { const int st = (r >> 4) * 2 + (c >> 5), rr = r & 15, cc = c & 31, ob = rr * 64 + cc * 2; return st * 1024 + (ob ^ (((ob >> 9) & 1) << 5)); }
__host__ __device__ __forceinline__ void stage_rc(int b, int& R, int& C) { const int st = b / 1024, sb = b % 1024, swz = sb ^ (((sb >> 9) & 1) << 5); R = (st >> 1) * 16 + swz / 64; C = (st & 1) * 32 + (swz % 64) / 2; }
__host__ __device__ __forceinline__ int perm32(int rho) { const int n = rho >> 4, i = rho & 15; return 8 * (i >> 2) + 4 * n + (i & 3); }

struct Unit { int pm, pn; };
struct Gemm { const bf16_t* A; const bf16_t* Bt; int M, N, K; };

struct StaticOrder {
    int nM, nN, nwg, G, c;
    __host__ __device__ void init(int M, int N, int G_, int c_) { nM = M / BM; nN = N / BM; nwg = nM * nN; G = G_; c = c_; }
    __host__ __device__ bool next(int i, Unit& u) const {
        const long L = (long)i * G + c; if (L >= nwg) return false;
        int wgid = (int)L; { const int q = nwg / NXCD, r = nwg % NXCD, xcd = wgid % NXCD, off = wgid / NXCD; wgid = (xcd < r ? xcd * (q + 1) : r * (q + 1) + (xcd - r) * q) + off; }
        const int nig = WGM * nN, gid = wgid / nig, fm = gid * WGM, gsz = (nM - fm) < WGM ? (nM - fm) : WGM;
        u.pm = fm + ((wgid % nig) % gsz); u.pn = (wgid % nig) / gsz; return true;
    }
    __device__ __forceinline__ void a_ready(const Unit&) const {}
    __device__ __forceinline__ void done(const Unit&) const {}
};

__device__ __forceinline__ unsigned cvt_pk_bf16(float lo, float hi) { unsigned r; asm volatile("v_cvt_pk_bf16_f32 %0, %1, %2" : "=v"(r) : "v"(lo), "v"(hi)); return r; }
typedef float f32x2 __attribute__((ext_vector_type(2)));
typedef unsigned u32x2 __attribute__((ext_vector_type(2)));

struct EpiBf16 {
    static constexpr bool PERM = true, AFTER_DRAIN = false;
    bf16_t* O; int ldc;
    __device__ __forceinline__ void operator()(const f32x4 (&acc)[2][2][4][2], const Unit& u, int wr, int wc, int fr, int fq) const {
        const int row0 = u.pm * BM + wr * 64 + fr; const int col0 = u.pn * BM + wc * 32 + 8 * fq;
#pragma unroll
        for (int ai = 0; ai < 2; ++ai)
#pragma unroll
            for (int m = 0; m < 4; ++m) { bf16_t* rowp = O + (size_t)(row0 + ai * HALF + m * 16) * ldc + col0;
#pragma unroll
                for (int bj = 0; bj < 2; ++bj) { const f32x4 v0 = acc[ai][bj][m][0], v1 = acc[ai][bj][m][1];
                    u32x4 w; w.x = cvt_pk_bf16(v0[0], v0[1]); w.y = cvt_pk_bf16(v0[2], v0[3]); w.z = cvt_pk_bf16(v1[0], v1[1]); w.w = cvt_pk_bf16(v1[2], v1[3]);
                    *(u32x4*)(rowp + bj * HALF) = w; } }
    }
};

struct EpiIn {
    static constexpr bool PERM = true, AFTER_DRAIN = false;
    bf16_t *Q, *KB, *VB, *XR, *GT; float *kp, *vp, *cp, *ks, *vs, *cs;
    __device__ __forceinline__ void operator()(const f32x4 (&acc)[2][2][4][2], const Unit& u, int wr, int wc, int fr, int fq) const {
        const int kind = u.pn >> 1; const bool samp = (u.pm == 64);
        const int colt = (u.pn & 1) * 256 + wc * 32 + 8 * fq;
        const int row0 = u.pm * BM + wr * 64 + fr;
        const bool rot = (kind <= 1) && ((wc & 1) == 0);
        const float RC[8] = {0.15915494309189535f, 0.03086376340470123f, 0.005985185712713705f, 0.001160663641240061f, 0.00022507907903927653f, 4.364795279280289e-05f, 8.464330808241401e-06f, 1.6414262627950345e-06f};
        const float C2 = 0.18033688011112042f;
#pragma unroll
        for (int ai = 0; ai < 2; ++ai)
#pragma unroll
            for (int m = 0; m < 4; ++m) {
                const int row = row0 + ai * HALF + m * 16;
                const int sp = samp ? ((row - 16384) & 7) : (row & 2047);
                const float pos = (float)(samp ? 8192 + sp : sp);
                float cs_[8], sn_[8];
                if (rot) {
#pragma unroll
                    for (int j = 0; j < 8; ++j) { float rv = pos * RC[j]; rv = rv - floorf(rv); cs_[j] = __builtin_amdgcn_cosf(rv); sn_[j] = __builtin_amdgcn_sinf(rv); }
                }
#pragma unroll
                for (int bj = 0; bj < 2; ++bj) {
                    f32x4 v0 = acc[ai][bj][m][0], v1 = acc[ai][bj][m][1];
                    const int col = colt + bj * HALF;
                    if (rot) {
                        float mine[8] = {v0[0], v0[1], v0[2], v0[3], v1[0], v1[1], v1[2], v1[3]};
                        float res[8];
#pragma unroll
                        for (int j = 0; j < 8; ++j) { const float oth = __shfl_xor(mine[j], 16); const float t = (fq == 0) ? -oth : oth; res[j] = mine[j] * cs_[j] + t * sn_[j]; }
                        if (fq < 2) { v0 = (f32x4){res[0], res[1], res[2], res[3]}; v1 = (f32x4){res[4], res[5], res[6], res[7]}; }
                    }
                    if (kind == 0) { v0 = v0 * C2; v1 = v1 * C2; }
                    u32x4 w; w.x = cvt_pk_bf16(v0[0], v0[1]); w.y = cvt_pk_bf16(v0[2], v0[3]); w.z = cvt_pk_bf16(v1[0], v1[1]); w.w = cvt_pk_bf16(v1[2], v1[3]);
                    bf16_t* dst = kind == 0 ? Q : kind == 1 ? KB : kind == 2 ? VB : kind == 3 ? XR : GT;
                    *(u32x4*)(dst + (size_t)row * 512 + col) = w;
                    if (kind == 1 || kind == 2) {
                        float* o = samp ? ((kind == 1 ? ks : vs) + (size_t)(row - 16384) * 512 + col) : ((kind == 1 ? kp : vp) + (size_t)row * 512 + col);
                        *(f32x4*)o = v0; *(f32x4*)(o + 4) = v1;
                    } else if (kind == 3) {
                        if (samp) { if (sp >= 5) { float* o = cs + (size_t)(((row - 16384) >> 3) * 3 + (sp - 5)) * 512 + col; *(f32x4*)o = v0; *(f32x4*)(o + 4) = v1; } }
                        else { if (sp >= 2045) { float* o = cp + (size_t)((row >> 11) * 3 + (sp - 2045)) * 512 + col; *(f32x4*)o = v0; *(f32x4*)(o + 4) = v1; } }
                    }
                }
            }
    }
};

struct EpiPre1 {
    static constexpr bool PERM = false, AFTER_DRAIN = false;
    const float *xp, *xs; float* C; float alpha;
    __device__ __forceinline__ void operator()(const f32x4 (&acc)[2][2][4][2], const Unit& u, int wr, int wc, int fr, int fq) const {
        const int row0 = u.pm * BM + wr * 64 + fr, col0 = u.pn * BM + wc * 32 + 4 * fq;
        const float* xb = (u.pm == 64) ? (xs - (size_t)16384 * 1024) : xp;
#pragma unroll
        for (int ai = 0; ai < 2; ++ai)
#pragma unroll
            for (int m = 0; m < 4; ++m) { const size_t off = (size_t)(row0 + ai * HALF + m * 16) * 1024 + col0;
#pragma unroll
                for (int bj = 0; bj < 2; ++bj)
#pragma unroll
                    for (int n = 0; n < 2; ++n) { const f32x4 xv = *(const f32x4*)(xb + off + bj * HALF + n * 16); *(f32x4*)(C + off + bj * HALF + n * 16) = acc[ai][bj][m][n] + xv * alpha; } }
    }
};

struct EpiFinal {
    static constexpr bool PERM = false, AFTER_DRAIN = false;
    const float* X2; const bf16_t* PLE; const float* gb; float *yp, *ys; float* ZD;
    __device__ __forceinline__ void operator()(const f32x4 (&acc)[2][2][4][2], const Unit& u, int wr, int wc, int fr, int fq) const {
        const int row0 = u.pm * BM + wr * 64 + fr, col0 = u.pn * BM + wc * 32 + 4 * fq;
        float* yb = (u.pm == 64) ? (ys - (size_t)16384 * 1024) : yp;
        f32x4 bv[2][2];
#pragma unroll
        for (int bj = 0; bj < 2; ++bj)
#pragma unroll
            for (int n = 0; n < 2; ++n) bv[bj][n] = *(const f32x4*)(gb + col0 + bj * HALF + n * 16);
#pragma unroll
        for (int ai = 0; ai < 2; ++ai)
#pragma unroll
            for (int m = 0; m < 4; ++m) { const size_t off = (size_t)(row0 + ai * HALF + m * 16) * 1024 + col0;
#pragma unroll
                for (int bj = 0; bj < 2; ++bj)
#pragma unroll
                    for (int n = 0; n < 2; ++n) {
                        const f32x4 x2 = *(const f32x4*)(X2 + off + bj * HALF + n * 16);
                        const u32x2 pr = *(const u32x2*)(PLE + off + bj * HALF + n * 16);
                        const unsigned p0 = pr[0], p1 = pr[1];
                        const f32x4 pl = (f32x4){__builtin_bit_cast(float, p0 << 16), __builtin_bit_cast(float, p0 & 0xffff0000u), __builtin_bit_cast(float, p1 << 16), __builtin_bit_cast(float, p1 & 0xffff0000u)};
                        const f32x4 z = acc[ai][bj][m][n] + bv[bj][n]; f32x4 o;
#pragma unroll
                        for (int e = 0; e < 4; ++e) { const float s = __builtin_amdgcn_rcpf(1.0f + __builtin_amdgcn_exp2f(-1.4426950408889634f * z[e])); o[e] = x2[e] + s * pl[e]; }
                        *(f32x4*)(yb + off + bj * HALF + n * 16) = o;
#ifdef DEBUG_CHECKS
                        *(f32x4*)(ZD + off + bj * HALF + n * 16) = z;
#endif
                    } }
    }
};

template <class Epi, class Sched, bool ALIGN_EPI = false, bool SP2 = false>
__device__ __forceinline__ void gemm_phase(PG8_LAS unsigned char* lds, const Gemm g, const Sched& S, const Epi& E) {
    int tid_ = threadIdx.x; asm volatile("" : "+v"(tid_)); const int tid = tid_, wid = __builtin_amdgcn_readfirstlane(tid >> 6), lane = tid & 63, wr = wid >> 2, wc = wid & 3, fr = lane & 15, fq = lane >> 4;
    const int K = g.K, nt = K / BK;
    unsigned voffA[2], voffB[2];
#pragma unroll
    for (int i = 0; i < 2; ++i) { int R, C; stage_rc(tid * 16 + i * 8192, R, C); const int Rb = Epi::PERM ? ((R & ~31) + perm32(R & 31)) : R;
        voffA[i] = (unsigned)(R * K + C) * 2u; voffB[i] = (unsigned)(Rb * K + C) * 2u; }
    const size_t kstep = (size_t)(BK * 2);
    const size_t hstep = (size_t)HALF * K * 2;
    const size_t tstep = 2 * hstep;
    const unsigned ldsw = (unsigned)wid * 1024u;
    const int aoff = lds_byte(wr * 64 + fr, fq * 8), boff = lds_byte(wc * 32 + fr, fq * 8);
#define PG8_SA(b, h) (((b) * 2 + (h)) * HTB)
#define PG8_SB(b, h) ((4 + (b) * 2 + (h)) * HTB)
#define PG8_STAGE(bufoff, gbase, voff) do { _Pragma("unroll") for (int _i = 0; _i < 2; ++_i) \
        __builtin_amdgcn_global_load_lds((const unsigned*)((const char*)(gbase) + (voff)[_i]), (PG8_LAS unsigned*)(lds + (bufoff) + ldsw + _i * 8192), 16, 0, 0); } while (0)
#define PG8_LDA(dst, b, h) do { _Pragma("unroll") for (int m = 0; m < 4; ++m) _Pragma("unroll") for (int k = 0; k < 2; ++k) dst[m][k] = *(const PG8_LAS bf16x8*)(lds + PG8_SA(b, h) + aoff + m * 2048 + k * 1024); } while (0)
#define PG8_LDB(dst, b, h) do { _Pragma("unroll") for (int n = 0; n < 2; ++n) _Pragma("unroll") for (int k = 0; k < 2; ++k) dst[n][k] = *(const PG8_LAS bf16x8*)(lds + PG8_SB(b, h) + boff + n * 2048 + k * 1024); } while (0)
#define PG8_MMA(ai, bj, At, Bt) do { __builtin_amdgcn_s_setprio(1); _Pragma("unroll") for (int m = 0; m < 4; ++m) _Pragma("unroll") for (int n = 0; n < 2; ++n) _Pragma("unroll") for (int k = 0; k < 2; ++k) \
        acc[ai][bj][m][n] = __builtin_amdgcn_mfma_f32_16x16x32_bf16(Bt[n][k], At[m][k], acc[ai][bj][m][n], 0, 0, 0); __builtin_amdgcn_s_setprio(0); } while (0)
#define PG8_WAIT_V(n) asm volatile("s_waitcnt vmcnt(" #n ")" ::: "memory")
#define PG8_WAIT_L(n) asm volatile("s_waitcnt lgkmcnt(" #n ")" ::: "memory")
#define PG8_BAR __builtin_amdgcn_s_barrier()
#define PG8_SCHED __builtin_amdgcn_sched_barrier(0)
    Unit cur, nxt; int ui = 0;
    if (!S.next(0, cur)) return;
    f32x4 acc[2][2][4][2];
#pragma unroll
    for (int a = 0; a < 2; ++a)
#pragma unroll
        for (int b = 0; b < 2; ++b)
#pragma unroll
            for (int m = 0; m < 4; ++m)
#pragma unroll
                for (int n = 0; n < 2; ++n) acc[a][b][m][n] = (f32x4){0.f, 0.f, 0.f, 0.f};
    bf16x8 At[4][2], B0[2][2], B1[2][2];
    const char* cA = (const char*)g.A + (size_t)cur.pm * tstep; const char* cB = (const char*)g.Bt + (size_t)cur.pn * tstep;
    S.a_ready(cur);
    if constexpr (SP2) {
        PG8_STAGE(PG8_SB(0, 0), cB, voffB); PG8_STAGE(PG8_SB(0, 1), cB + hstep, voffB); PG8_STAGE(PG8_SA(0, 0), cA, voffA); PG8_STAGE(PG8_SA(0, 1), cA + hstep, voffA);
        if (wr == 1) PG8_BAR;
        PG8_WAIT_V(2); PG8_BAR;
        PG8_STAGE(PG8_SB(1, 0), cB + kstep, voffB); PG8_STAGE(PG8_SA(1, 0), cA + kstep, voffA); PG8_STAGE(PG8_SB(1, 1), cB + hstep + kstep, voffB);
        PG8_WAIT_V(6); PG8_BAR;
    } else {
        PG8_STAGE(PG8_SB(0, 0), cB, voffB); PG8_STAGE(PG8_SA(0, 0), cA, voffA); PG8_STAGE(PG8_SB(0, 1), cB + hstep, voffB); PG8_STAGE(PG8_SA(0, 1), cA + hstep, voffA);
        if (wr == 1) PG8_BAR;
        PG8_WAIT_V(4); PG8_BAR;
        PG8_STAGE(PG8_SB(1, 0), cB + kstep, voffB); PG8_STAGE(PG8_SA(1, 0), cA + kstep, voffA); PG8_STAGE(PG8_SB(1, 1), cB + hstep + kstep, voffB);
        PG8_WAIT_V(6); PG8_BAR;
    }
    for (;;) {
        const bool has_next = S.next(ui + 1, nxt);
        const char* nA = has_next ? (const char*)g.A + (size_t)nxt.pm * tstep : cA; const char* nB = has_next ? (const char*)g.Bt + (size_t)nxt.pn * tstep : cB;
        for (int t = 0; t < nt; t += 2) {
            const bool last = (t == nt - 2);
            const char* a1 = cA + (size_t)(t + 1) * kstep;
            const char* a2 = last ? nA : cA + (size_t)(t + 2) * kstep; const char* b2 = last ? nB : cB + (size_t)(t + 2) * kstep;
            const char* a3 = a2 + kstep; const char* b3 = b2 + kstep;
            if (last && has_next) S.a_ready(nxt);
            if constexpr (SP2) {
            PG8_LDB(B0, 0, 0); PG8_LDB(B1, 0, 1); PG8_SCHED; PG8_LDA(At, 0, 0); PG8_STAGE(PG8_SA(1, 1), a1 + hstep, voffA);
            PG8_WAIT_V(8); PG8_WAIT_L(0); PG8_BAR; PG8_MMA(0, 0, At, B0); PG8_MMA(0, 1, At, B1); PG8_BAR; PG8_SCHED;
            PG8_LDA(At, 0, 1); PG8_STAGE(PG8_SB(0, 0), b2, voffB); PG8_STAGE(PG8_SB(0, 1), b2 + hstep, voffB); PG8_STAGE(PG8_SA(0, 0), a2, voffA);
            PG8_WAIT_V(8); PG8_WAIT_L(0); PG8_BAR; PG8_MMA(1, 0, At, B0); PG8_MMA(1, 1, At, B1); PG8_BAR; PG8_SCHED;
            PG8_LDB(B0, 1, 0); PG8_LDB(B1, 1, 1); PG8_SCHED; PG8_LDA(At, 1, 0); PG8_STAGE(PG8_SA(0, 1), a2 + hstep, voffA);
            PG8_WAIT_V(8); PG8_WAIT_L(0); PG8_BAR; PG8_MMA(0, 0, At, B0); PG8_MMA(0, 1, At, B1); PG8_BAR; PG8_SCHED;
            PG8_LDA(At, 1, 1); PG8_STAGE(PG8_SB(1, 0), b3, voffB); PG8_STAGE(PG8_SB(1, 1), b3 + hstep, voffB); PG8_STAGE(PG8_SA(1, 0), a3, voffA);
            PG8_WAIT_V(8); PG8_WAIT_L(0); PG8_BAR; PG8_MMA(1, 0, At, B0); PG8_MMA(1, 1, At, B1); PG8_BAR; PG8_SCHED;
            } else {
            PG8_LDB(B0, 0, 0); PG8_SCHED; PG8_LDA(At, 0, 0); PG8_STAGE(PG8_SA(1, 1), a1 + hstep, voffA);
            PG8_WAIT_L(8); PG8_BAR; PG8_WAIT_L(0); PG8_MMA(0, 0, At, B0); PG8_BAR; PG8_SCHED;
            PG8_LDB(B1, 0, 1); PG8_STAGE(PG8_SB(0, 0), b2, voffB);
            PG8_BAR; PG8_WAIT_L(0); PG8_MMA(0, 1, At, B1); PG8_BAR;
            PG8_LDA(At, 0, 1); PG8_STAGE(PG8_SA(0, 0), a2, voffA);
            PG8_BAR; PG8_WAIT_L(0); PG8_MMA(1, 0, At, B0); PG8_BAR; PG8_SCHED;
            PG8_STAGE(PG8_SB(0, 1), b2 + hstep, voffB);
            PG8_WAIT_V(6); PG8_BAR; PG8_MMA(1, 1, At, B1); PG8_BAR;
            PG8_LDB(B0, 1, 0); PG8_SCHED; PG8_LDA(At, 1, 0); PG8_STAGE(PG8_SA(0, 1), a2 + hstep, voffA);
            PG8_WAIT_L(8); PG8_BAR; PG8_WAIT_L(0); PG8_MMA(0, 0, At, B0); PG8_BAR; PG8_SCHED;
            PG8_LDB(B1, 1, 1); PG8_STAGE(PG8_SB(1, 0), b3, voffB);
            PG8_BAR; PG8_WAIT_L(0); PG8_MMA(0, 1, At, B1); PG8_BAR;
            PG8_LDA(At, 1, 1); PG8_STAGE(PG8_SA(1, 0), a3, voffA);
            PG8_BAR; PG8_WAIT_L(0); PG8_MMA(1, 0, At, B0); PG8_BAR; PG8_SCHED;
            PG8_STAGE(PG8_SB(1, 1), b3 + hstep, voffB);
            PG8_WAIT_V(6); PG8_BAR; PG8_MMA(1, 1, At, B1); PG8_BAR;
            }
        }
        if constexpr (ALIGN_EPI) { if (wr == 0) PG8_BAR; }
        if constexpr (!Epi::AFTER_DRAIN) { E(acc, cur, wr, wc, fr, fq); S.done(cur); }
        if (!has_next) break;
#pragma unroll
        for (int a = 0; a < 2; ++a)
#pragma unroll
            for (int b = 0; b < 2; ++b)
#pragma unroll
                for (int m = 0; m < 4; ++m)
#pragma unroll
                    for (int n = 0; n < 2; ++n) acc[a][b][m][n] = (f32x4){0.f, 0.f, 0.f, 0.f};
        cur = nxt; cA = nA; cB = nB; ++ui;
        if constexpr (ALIGN_EPI) { if (wr == 1) PG8_BAR; }
    }
    PG8_WAIT_V(0);
    if constexpr (!ALIGN_EPI) { if (wr == 0) PG8_BAR; }
    PG8_BAR;
    if constexpr (Epi::AFTER_DRAIN) { E.fused(acc, cur, wr, wc, fr, fq, lds, wid, lane); S.done(cur); }
#undef PG8_SA
#undef PG8_SB
#undef PG8_STAGE
#undef PG8_LDA
#undef PG8_LDB
#undef PG8_MMA
#undef PG8_WAIT_V
#undef PG8_WAIT_L
#undef PG8_BAR
#undef PG8_SCHED
}
}
constexpr int NWAVES = 8;
constexpr int D = 1024, NBP = 8, SEQ = 2048, MP = NBP * SEQ, NBS = 32, TS = 8, MS = NBS * TS, M = MP + MS;
constexpr int PAST = 8192, PAGE = 128, NPAGES = PAST / PAGE, NPOOL = 2560;
constexpr int INW = 2560, NEXP = 16384;
constexpr float LN_EPS = 1e-5f;
constexpr float ALPHA = 1.189207115002721f;
constexpr float LAM_INIT = 0.2f;
constexpr size_t O_YP = 0, O_YS = O_YP + (size_t)MP * D, O_KP = O_YS + (size_t)MS * D, O_VP = O_KP + (size_t)MP * 512, O_HP = O_VP + (size_t)MP * 512,
                 O_CP = O_HP + (size_t)NBP * 512, O_KS = O_CP + (size_t)NBP * 3 * 512, O_VS = O_KS + (size_t)MS * 512, O_HS = O_VS + (size_t)MS * 512, O_CS = O_HS + (size_t)NBS * 512,
                 O_END = O_CS + (size_t)NBS * 3 * 512;
constexpr size_t MiB = 1u << 20;
constexpr size_t WS_CTL = 0, CTL_ZERO_BYTES = 1 * MiB;
constexpr size_t WS_WIN_T = 2 * MiB, WS_WOUT_T = 8 * MiB, WS_WQ_T = 10 * MiB, WS_WG_T = 14 * MiB, WS_WPLE_T = 16 * MiB, WS_KEYS = 17 * MiB, WS_WAT = 18 * MiB, WS_WXT = 18 * MiB + 65536;
constexpr size_t WS_U = 32 * MiB, WS_V = 64 * MiB, WS_XB = 96 * MiB, WS_PE = 130 * MiB, WS_Q = 140 * MiB, WS_KB = 158 * MiB, WS_VB = 176 * MiB, WS_XR = 194 * MiB, WS_GT = 212 * MiB;
constexpr size_t WS_MIX = 230 * MiB, WS_PLE = 264 * MiB, WS_PRE1 = 298 * MiB, WS_X1 = 364 * MiB, WS_X1B = 430 * MiB, WS_PQ = 464 * MiB, WS_EIDX = 530 * MiB, WS_GW = 540 * MiB;
constexpr size_t WS_X2 = 550 * MiB, WS_X2B = 616 * MiB, WS_SPART = 650 * MiB, WS_SSTAT = 659 * MiB, WS_END = 660 * MiB;
constexpr int CW_TMO = 0, CW_CODE = 1, CW_BAR = 4096;
constexpr int RING_OFF = 0, RING_BYTES = 131072;
constexpr int LDSCTL_OFF = RING_BYTES, MISC_OFF = LDSCTL_OFF + 320;
constexpr int LDS_BYTES = 147456;
#define GAS __attribute__((address_space(1)))
#define LAS __attribute__((address_space(3)))
typedef unsigned short bf16;
typedef unsigned v4u __attribute__((ext_vector_type(4)));
typedef float f32x4 __attribute__((ext_vector_type(4)));
typedef short bf16x8 __attribute__((ext_vector_type(8)));
typedef GAS unsigned gu32;
typedef GAS unsigned long long gu64;
#define RLX_AGENT __ATOMIC_RELAXED, __HIP_MEMORY_SCOPE_AGENT
#define LDS_WAIT() asm volatile("s_waitcnt lgkmcnt(0)" ::: "memory")
#define VM_WAIT() asm volatile("s_waitcnt vmcnt(0)" ::: "memory")
__device__ __forceinline__ unsigned long long rt() { return __builtin_amdgcn_s_memrealtime(); }
__device__ __forceinline__ unsigned f2bf(float f) { unsigned u = __builtin_bit_cast(unsigned, f); return (u + 0x7fffu + ((u >> 16) & 1u)) >> 16; }
__device__ __forceinline__ unsigned pk2(float lo, float hi) { return f2bf(lo) | (f2bf(hi) << 16); }

#define XB_TMO      128
#define XB_XCNT(j)  (256  + 64 * (j))
#define XB_XSUB(j)  (1280 + 64 * (j))
#define XB_XGEN(j)  (2304 + 64 * (j))
#define XB_TOP      3328
#define XB_TOPGEN   3392
#define XCD_BAR_WORDS 3456
#define XB_SPIN_CAP (1u << 18)

__device__ __forceinline__ unsigned xb_ld(unsigned* p)              { return __hip_atomic_load(p, __ATOMIC_RELAXED, __HIP_MEMORY_SCOPE_AGENT); }
__device__ __forceinline__ unsigned xb_add(unsigned* p, unsigned v) { return __hip_atomic_fetch_add(p, v, __ATOMIC_RELAXED, __HIP_MEMORY_SCOPE_AGENT); }
__device__ __forceinline__ unsigned xb_xcc_id() { return (unsigned)__builtin_amdgcn_s_getreg((3 << 11) | 20) & 0xFu; }
#define XB_SPIN(cond, bar) do { unsigned _sp = 0; while (cond) { __builtin_amdgcn_s_sleep(1); \
    if ((++_sp & 255u) == 0u) { if (xb_ld(&(bar)[XB_TMO])) break; if (_sp > XB_SPIN_CAP) { atomicAdd(&(bar)[XB_TMO], 1u); break; } } } } while (0)

struct XcdBarrier {
    unsigned* bar; unsigned x;
    volatile LAS unsigned* st;
};

__device__ __forceinline__ XcdBarrier xcd_barrier_post(unsigned* bar, volatile LAS unsigned* st) {
    XcdBarrier b; b.bar = bar; b.x = xb_xcc_id(); b.st = st;
    if (threadIdx.x == 0) (void)xb_add(&bar[XB_XCNT(b.x)], 1u);
    return b;
}
__device__ __forceinline__ void xcd_barrier_complete(unsigned* bar, unsigned x, unsigned& nloc, unsigned& nx) {
    const unsigned G = gridDim.x * gridDim.y * gridDim.z;
    unsigned sum, cnt, mine, sp = 0u;
    for (;;) {
        sum = 0u; cnt = 0u; mine = 0u;
#pragma unroll
        for (unsigned j = 0; j < 16; ++j) { const unsigned c = xb_ld(&bar[XB_XCNT(j)]); sum += c; cnt += (c > 0u) ? 1u : 0u; mine = (j == x) ? c : mine; }
        if (sum == G) break;
        __builtin_amdgcn_s_sleep(1);
        if ((++sp & 255u) == 0u) { if (xb_ld(&bar[XB_TMO])) break; if (sp > XB_SPIN_CAP) { atomicAdd(&bar[XB_TMO], 1u); break; } }
    }
    nloc = mine > 0u ? mine : 1u; nx = cnt > 0u ? cnt : 1u;
}

__device__ __forceinline__ void xcd_barrier(const XcdBarrier& b) {
    asm volatile("s_waitcnt vmcnt(0)" ::: "memory");
    __syncthreads();
    if (threadIdx.x == 0) {
        unsigned* bar = b.bar;
        __builtin_amdgcn_s_waitcnt(0);
        unsigned nloc = b.st[0], nx = b.st[1];
        if (nloc == 0u) { xcd_barrier_complete(bar, b.x, nloc, nx); b.st[0] = nloc; b.st[1] = nx; }
        const unsigned old = xb_add(&bar[XB_XSUB(b.x)], 1u);
        const unsigned gen = old / nloc;
        if (old + 1u == (gen + 1u) * nloc) {
            __builtin_amdgcn_fence(__ATOMIC_RELEASE, "agent");
            asm volatile("s_waitcnt vmcnt(0)" ::: "memory");
            const unsigned og = xb_add(&bar[XB_TOP], 1u);
            const unsigned tg = og / nx;
            if (og + 1u == (tg + 1u) * nx) xb_add(&bar[XB_TOPGEN], 1u);
            else XB_SPIN(xb_ld(&bar[XB_TOPGEN]) == tg, bar);
            __builtin_amdgcn_fence(__ATOMIC_ACQUIRE, "agent");
            xb_add(&bar[XB_XGEN(b.x)], 1u);
            asm volatile("s_waitcnt vmcnt(0)" ::: "memory");
        } else {
            XB_SPIN(xb_ld(&bar[XB_XGEN(b.x)]) == gen, bar);
            __builtin_amdgcn_fence(__ATOMIC_ACQUIRE, "agent");
            asm volatile("s_waitcnt vmcnt(0)" ::: "memory");
        }
    }
    __syncthreads();
}
struct Frame {
    LAS unsigned char* lds;
    volatile LAS unsigned* MISC;
    gu32* ctl;
    int tid, lane, wave;
    int vcu, G;
};
__device__ __forceinline__ float wave_sum(float v) {
#pragma unroll
    for (int o = 1; o < 64; o <<= 1) v += __shfl_xor(v, o);
    return v;
}
__device__ __forceinline__ float bf_lo(unsigned u) { return __builtin_bit_cast(float, u << 16); }
__device__ __forceinline__ float bf_hi(unsigned u) { return __builtin_bit_cast(float, u & 0xffff0000u); }
__device__ __forceinline__ void p0_transpose_item(const float* W, int K, int N, bf16* WT, LAS float* scr, int item, int lane) {
    const int nblk = N / 32, kb = item / nblk, nb = item % nblk, k0 = 64 * kb, n0 = 32 * nb;
#pragma unroll 8
    for (int i = 0; i < 32; ++i) { const int kk = 2 * i + (lane >> 5); scr[kk * 33 + (lane & 31)] = W[(size_t)(k0 + kk) * N + n0 + (lane & 31)]; }
    LDS_WAIT(); asm volatile("" ::: "memory");
    const int c = lane & 7;
#pragma unroll
    for (int j = 0; j < 4; ++j) { const int n = (lane >> 3) + 8 * j; const LAS float* s = scr + (8 * c) * 33 + n;
        v4u o; o.x = pk2(s[0 * 33], s[1 * 33]); o.y = pk2(s[2 * 33], s[3 * 33]); o.z = pk2(s[4 * 33], s[5 * 33]); o.w = pk2(s[6 * 33], s[7 * 33]);
        *(GAS v4u*)(WT + (size_t)(n0 + n) * K + k0 + 8 * c) = o; }
    LDS_WAIT(); asm volatile("" ::: "memory");
}
__device__ __forceinline__ void p0_convert(const float* src, bf16* dst, size_t n, int gw, int NGW, int lane) {
    const size_t np = n / 512;
    for (size_t p = gw; p < np; p += NGW) {
        const GAS f32x4* s = (const GAS f32x4*)(src + p * 512) + lane * 2;
        const f32x4 a = s[0], b = s[1];
        v4u o; o.x = pk2(a.x, a.y); o.y = pk2(a.z, a.w); o.z = pk2(b.x, b.y); o.w = pk2(b.z, b.w);
        *((GAS v4u*)(dst + p * 512) + lane) = o;
    }
}
struct Args { const void* in[34]; float* out; unsigned char* ws; };

__device__ __forceinline__ void p0_prologue(Frame& F, const Args& A, unsigned char* ws) {
    LAS float* scr = (LAS float*)(F.lds + RING_OFF + F.wave * 16384);
    const int gw = F.vcu * NWAVES + F.wave, NGW = F.G * NWAVES;
    constexpr int I_IN = (D / 64) * (INW / 32), I_OUT = (D / 64) * (D / 32), I_WQ = (D / 64) * (2048 / 32), I_G = I_OUT, I_PLE = (256 / 64) * (D / 32), I_RG = 16 * 2;
    constexpr int NITEMS = I_IN + I_OUT + I_WQ + I_G + I_PLE + I_RG;
    for (int it = gw; it < NITEMS; it += NGW) {
        int r = it;
        if (r < I_IN) { p0_transpose_item((const float*)A.in[9], D, INW, (bf16*)(ws + WS_WIN_T), scr, r, F.lane); continue; } r -= I_IN;
        if (r < I_OUT) { p0_transpose_item((const float*)A.in[22], D, D, (bf16*)(ws + WS_WOUT_T), scr, r, F.lane); continue; } r -= I_OUT;
        if (r < I_WQ) { p0_transpose_item((const float*)A.in[25], D, 2048, (bf16*)(ws + WS_WQ_T), scr, r, F.lane); continue; } r -= I_WQ;
        if (r < I_G) { p0_transpose_item((const float*)A.in[32], D, D, (bf16*)(ws + WS_WG_T), scr, r, F.lane); continue; } r -= I_G;
        if (r < I_PLE) { p0_transpose_item((const float*)A.in[31], 256, D, (bf16*)(ws + WS_WPLE_T), scr, r, F.lane); continue; } r -= I_PLE;
        { const int mat = r >> 4, blk = (r >> 1) & 7, sub = r & 1;
          p0_transpose_item((const float*)A.in[mat ? 19 : 17] + blk * 4096, 64, 64, (bf16*)(ws + (mat ? WS_WXT : WS_WAT)) + blk * 4096, scr, sub, F.lane); }
    }
    p0_convert((const float*)A.in[0], (bf16*)(ws + WS_XB), (size_t)MP * D, gw, NGW, F.lane);
    p0_convert((const float*)A.in[1], (bf16*)(ws + WS_XB) + (size_t)MP * D, (size_t)MS * D, gw, NGW, F.lane);
    p0_convert((const float*)A.in[2], (bf16*)(ws + WS_PE), (size_t)MP * 256, gw, NGW, F.lane);
    p0_convert((const float*)A.in[3], (bf16*)(ws + WS_PE) + (size_t)MP * 256, (size_t)MS * 256, gw, NGW, F.lane);
    p0_convert((const float*)A.in[26], (bf16*)(ws + WS_KEYS), (size_t)8 * 2 * 128 * 128, gw, NGW, F.lane);
    p0_convert((const float*)A.in[27], (bf16*)(ws + WS_U), (size_t)NEXP * D, gw, NGW, F.lane);
    p0_convert((const float*)A.in[28], (bf16*)(ws + WS_V), (size_t)NEXP * D, gw, NGW, F.lane);
}
typedef float f32x16 __attribute__((ext_vector_type(16)));
typedef float f32x2v_t __attribute__((ext_vector_type(2)));
typedef unsigned u32x4 __attribute__((ext_vector_type(4)));
typedef short s16x4 __attribute__((ext_vector_type(4)));
typedef short v4i16_t __attribute__((ext_vector_type(4)));
typedef __bf16 bf16x2_t __attribute__((ext_vector_type(2)));
__device__ __forceinline__ int crow(int r, int hi) { return (r & 3) + 8 * (r >> 2) + 4 * hi; }
__device__ __forceinline__ unsigned cvtpk(float lo, float hi) { f32x2v_t v = {lo, hi}; bf16x2_t b = __builtin_convertvector(v, bf16x2_t); return __builtin_bit_cast(unsigned, b); }
__device__ __forceinline__ s16x4 vtr(LAS const unsigned char* p) { return __builtin_bit_cast(s16x4, __builtin_amdgcn_ds_read_tr16_b64_v4i16((LAS v4i16_t*)p)); }
__device__ __forceinline__ float swap32_max(float v) { auto rr = __builtin_amdgcn_permlane32_swap(__float_as_uint(v), __float_as_uint(v), false, false); return fmaxf(__uint_as_float(rr[0]), __uint_as_float(rr[1])); }
__device__ __forceinline__ float swap32_sum(float v) { auto rr = __builtin_amdgcn_permlane32_swap(__float_as_uint(v), __float_as_uint(v), false, false); return __uint_as_float(rr[0]) + __uint_as_float(rr[1]); }

constexpr int PA_RSK = 272, PA_RSV = 320, PA_KB = 64 * PA_RSK, PA_VB = 64 * PA_RSV, PA_BUF = PA_KB + PA_VB;
constexpr int PA_RSC = 528;

__device__ __forceinline__ void pattn_unit(Frame& F, int b, int h, int qb, const bf16* Q, const bf16* KB, const bf16* VB, bf16* MIX, float lam, const float* subln) {
    const int tid = F.tid, lane = F.lane, r32 = lane & 31, hi = lane >> 5, wid = F.wave, mp = wid >> 2, w4 = wid & 3;
    LAS unsigned char* L = F.lds + RING_OFF;
    const size_t rowbase = (size_t)b * SEQ;
    const int q0 = qb * 128 + w4 * 32;
    bf16x8 qf[4];
    { const bf16* qp = Q + (rowbase + q0 + r32) * 512 + h * 128 + mp * 64 + hi * 8;
#pragma unroll
      for (int ks = 0; ks < 4; ++ks) qf[ks] = *(const GAS bf16x8*)(qp + ks * 16); }
    const int sk0 = tid >> 4, sc = tid & 15;
    const bf16* kg = KB + (rowbase + sk0) * 512 + h * 128 + sc * 8;
    const bf16* vg = VB + (rowbase + sk0) * 512 + h * 128 + sc * 8;
    const int kl0 = sk0 * PA_RSK + sc * 16, vl0 = PA_KB + sk0 * PA_RSV + sc * 16;
    const int NT = 2 * qb + 2;
    v4u sK0, sK1, sV0, sV1;
#define PA_LOAD(t) do { const size_t o_ = (size_t)(t) * 64 * 512; sK0 = *(const GAS v4u*)(kg + o_); sK1 = *(const GAS v4u*)(kg + o_ + 32 * 512); sV0 = *(const GAS v4u*)(vg + o_); sV1 = *(const GAS v4u*)(vg + o_ + 32 * 512); } while (0)
#define PA_STORE(buf) do { LAS unsigned char* B_ = L + (buf) * PA_BUF; *(LAS v4u*)(B_ + kl0) = sK0; *(LAS v4u*)(B_ + kl0 + 32 * PA_RSK) = sK1; *(LAS v4u*)(B_ + vl0) = sV0; *(LAS v4u*)(B_ + vl0 + 32 * PA_RSV) = sV1; } while (0)
    PA_LOAD(0); PA_STORE(0);
    __syncthreads();
    f32x16 o[4];
#pragma unroll
    for (int i = 0; i < 4; ++i) o[i] = f32x16{};
    float mrun = -INFINITY, lrun = 0.f;
    const int vtr0 = PA_KB + (4 * hi + ((lane & 15) >> 2)) * PA_RSV + (16 * ((lane >> 4) & 1) + 4 * (lane & 3)) * 2;
    const int kfr0 = r32 * PA_RSK + (mp * 64 + hi * 8) * 2;
    for (int t = 0; t < NT; ++t) {
        if (t + 1 < NT) PA_LOAD(t + 1);
        LAS unsigned char* Bc = L + (t & 1) * PA_BUF;
        f32x16 s0 = f32x16{}, s1 = f32x16{};
#pragma unroll
        for (int ks = 0; ks < 4; ++ks) {
            const bf16x8 k0 = *(const LAS bf16x8*)(Bc + kfr0 + ks * 32);
            const bf16x8 k1 = *(const LAS bf16x8*)(Bc + kfr0 + 32 * PA_RSK + ks * 32);
            s0 = __builtin_amdgcn_mfma_f32_32x32x16_bf16(k0, qf[ks], s0, 0, 0, 0);
            s1 = __builtin_amdgcn_mfma_f32_32x32x16_bf16(k1, qf[ks], s1, 0, 0, 0);
        }
        if (t >= NT - 2) {
            const int qrel = q0 + r32 - t * 64;
#pragma unroll
            for (int r = 0; r < 16; ++r) { const int kv = crow(r, hi); if (kv > qrel) s0[r] = -INFINITY; if (kv + 32 > qrel) s1[r] = -INFINITY; }
        }
        float rm = fmaxf(s0[0], s1[0]);
#pragma unroll
        for (int r = 1; r < 16; ++r) rm = fmaxf(rm, fmaxf(s0[r], s1[r]));
        rm = swap32_max(rm);
        const float mnew = fmaxf(mrun, rm);
        const float alpha = __builtin_amdgcn_exp2f(mrun - mnew);
        mrun = mnew;
        float ps = 0.f;
#pragma unroll
        for (int r = 0; r < 16; ++r) { s0[r] = __builtin_amdgcn_exp2f(s0[r] - mnew); s1[r] = __builtin_amdgcn_exp2f(s1[r] - mnew); ps += s0[r] + s1[r]; }
        lrun = lrun * alpha + ps;
#pragma unroll
        for (int i = 0; i < 4; ++i)
#pragma unroll
            for (int r = 0; r < 16; ++r) o[i][r] *= alpha;
        u32x4 pf[4];
        pf[0] = (u32x4){cvtpk(s0[0], s0[1]), cvtpk(s0[2], s0[3]), cvtpk(s0[4], s0[5]), cvtpk(s0[6], s0[7])};
        pf[1] = (u32x4){cvtpk(s0[8], s0[9]), cvtpk(s0[10], s0[11]), cvtpk(s0[12], s0[13]), cvtpk(s0[14], s0[15])};
        pf[2] = (u32x4){cvtpk(s1[0], s1[1]), cvtpk(s1[2], s1[3]), cvtpk(s1[4], s1[5]), cvtpk(s1[6], s1[7])};
        pf[3] = (u32x4){cvtpk(s1[8], s1[9]), cvtpk(s1[10], s1[11]), cvtpk(s1[12], s1[13]), cvtpk(s1[14], s1[15])};
#pragma unroll
        for (int kk = 0; kk < 4; ++kk) {
#pragma unroll
            for (int rb = 0; rb < 4; ++rb) {
                const s16x4 lo = vtr(Bc + vtr0 + (16 * kk) * PA_RSV + rb * 64);
                const s16x4 hi4 = vtr(Bc + vtr0 + (16 * kk + 8) * PA_RSV + rb * 64);
                const bf16x8 vf = (bf16x8){lo[0], lo[1], lo[2], lo[3], hi4[0], hi4[1], hi4[2], hi4[3]};
                o[rb] = __builtin_amdgcn_mfma_f32_32x32x16_bf16(vf, __builtin_bit_cast(bf16x8, pf[kk]), o[rb], 0, 0, 0);
            }
        }
        if (t + 1 < NT) PA_STORE((t + 1) & 1);
        __syncthreads();
    }
#undef PA_LOAD
#undef PA_STORE
    const float ltot = swap32_sum(lrun);
    const float nsc = (mp == 1 ? lam : 1.0f) / ltot;
    LAS unsigned char* cb = L + (w4 * 32 + r32) * PA_RSC + hi * 16;
    if (mp == 1) {
#pragma unroll
        for (int rb = 0; rb < 4; ++rb)
#pragma unroll
            for (int g = 0; g < 4; ++g) *(LAS f32x4*)(cb + (32 * rb + 8 * g) * 4) = (f32x4){o[rb][4 * g] * nsc, o[rb][4 * g + 1] * nsc, o[rb][4 * g + 2] * nsc, o[rb][4 * g + 3] * nsc};
    }
    __syncthreads();
    if (mp == 0) {
        float ss = 0.f;
#pragma unroll
        for (int rb = 0; rb < 4; ++rb)
#pragma unroll
            for (int g = 0; g < 4; ++g) { const f32x4 o2 = *(const LAS f32x4*)(cb + (32 * rb + 8 * g) * 4);
#pragma unroll
                for (int e = 0; e < 4; ++e) { const float v = o[rb][4 * g + e] * nsc - o2[e]; o[rb][4 * g + e] = v; ss += v * v; } }
        ss = swap32_sum(ss);
        const float rs = (1.0f - LAM_INIT) / sqrtf(ss * (1.0f / 128.0f) + LN_EPS);
        bf16* orow = MIX + (rowbase + q0 + r32) * 1024 + h * 128 + 4 * hi;
#pragma unroll
        for (int rb = 0; rb < 4; ++rb)
#pragma unroll
            for (int g = 0; g < 4; ++g) { const f32x4 gg = *(const GAS f32x4*)(subln + 32 * rb + 8 * g + 4 * hi);
                f32x2v_t w; w.x = __builtin_bit_cast(float, cvtpk(o[rb][4 * g] * rs * gg[0], o[rb][4 * g + 1] * rs * gg[1])); w.y = __builtin_bit_cast(float, cvtpk(o[rb][4 * g + 2] * rs * gg[2], o[rb][4 * g + 3] * rs * gg[3]));
                *(GAS f32x2v_t*)(orow + 32 * rb + 8 * g) = w; }
    }
    __syncthreads();
}
typedef float f32x4v_t __attribute__((ext_vector_type(4)));
constexpr int SA_RS = 288, SA_IMG = 128 * SA_RS, SA_VOFF = SA_IMG;
__device__ __forceinline__ f32x4 ntload4(const float* p) { return __builtin_nontemporal_load((const f32x4*)p); }
__device__ __forceinline__ void sattn_item(Frame& F, int b, int sp, int slot, const float* CK, const float* CV, const int* PT, const bf16* Q, float* SPART, float* SSTAT) {
    const int tid = F.tid, lane = F.lane, wid = F.wave, head = wid & 3, z = wid >> 2, c16 = lane & 15, fq = lane >> 4;
    LAS unsigned char* L = F.lds + RING_OFF;
    bf16x8 qz[4];
    { const int map = c16 >> 3, t = c16 & 7; const bf16* qp = Q + (size_t)(MP + b * 8 + t) * 512 + head * 128 + fq * 8;
#pragma unroll
      for (int ks = 0; ks < 4; ++ks) qz[ks] = ((ks >> 1) == map) ? *(const GAS bf16x8*)(qp + ks * 32) : (bf16x8){0, 0, 0, 0, 0, 0, 0, 0}; }
    f32x4 o[4];
#pragma unroll
    for (int i = 0; i < 4; ++i) o[i] = (f32x4){0.f, 0.f, 0.f, 0.f};
    float mrun = -INFINITY, lrun = 0.f;
    f32x4 rk[8], rv[8];
    const int NCH = 32;
#define SA_LOAD(ci) do { const int pg_ = PT[b * NPAGES + sp * 8 + ((ci) >> 2)]; const size_t base_ = ((size_t)pg_ * PAGE + ((ci) & 3) * 32) * 512 + (size_t)tid * 4; \
        _Pragma("unroll") for (int i_ = 0; i_ < 8; ++i_) { rk[i_] = ntload4(CK + base_ + i_ * 2048); rv[i_] = ntload4(CV + base_ + i_ * 2048); } } while (0)
    SA_LOAD(0);
    const int st0 = (((tid >> 5) & 3) * 32 + (tid >> 7)) * SA_RS + (tid & 31) * 8;
    const int kfr = (head * 32 + c16) * SA_RS + fq * 16;
    const int vfr = SA_VOFF + (head * 32 + 4 * fq + (c16 >> 2)) * SA_RS + (64 * z + 4 * (c16 & 3)) * 2;
    for (int ci = 0; ci < NCH; ++ci) {
#pragma unroll
        for (int i = 0; i < 8; ++i) {
            f32x2v_t wk, wv; wk.x = __builtin_bit_cast(float, cvtpk(rk[i][0], rk[i][1])); wk.y = __builtin_bit_cast(float, cvtpk(rk[i][2], rk[i][3]));
            wv.x = __builtin_bit_cast(float, cvtpk(rv[i][0], rv[i][1])); wv.y = __builtin_bit_cast(float, cvtpk(rv[i][2], rv[i][3]));
            *(LAS f32x2v_t*)(L + st0 + i * 4 * SA_RS) = wk; *(LAS f32x2v_t*)(L + SA_VOFF + st0 + i * 4 * SA_RS) = wv;
        }
        __syncthreads();
        if (ci + 1 < NCH) SA_LOAD(ci + 1);
        f32x4 s0 = (f32x4){0.f, 0.f, 0.f, 0.f}, s1 = s0;
#pragma unroll
        for (int ks = 0; ks < 4; ++ks) {
            const bf16x8 k0 = *(const LAS bf16x8*)(L + kfr + ks * 64);
            const bf16x8 k1 = *(const LAS bf16x8*)(L + kfr + 16 * SA_RS + ks * 64);
            s0 = __builtin_amdgcn_mfma_f32_16x16x32_bf16(k0, qz[ks], s0, 0, 0, 0);
            s1 = __builtin_amdgcn_mfma_f32_16x16x32_bf16(k1, qz[ks], s1, 0, 0, 0);
        }
        float rm = fmaxf(fmaxf(fmaxf(s0[0], s0[1]), fmaxf(s0[2], s0[3])), fmaxf(fmaxf(s1[0], s1[1]), fmaxf(s1[2], s1[3])));
        rm = fmaxf(rm, __shfl_xor(rm, 16)); rm = fmaxf(rm, __shfl_xor(rm, 32));
        const float mnew = fmaxf(mrun, rm);
        const float alpha = __builtin_amdgcn_exp2f(mrun - mnew);
        mrun = mnew;
        float ps = 0.f;
#pragma unroll
        for (int r = 0; r < 4; ++r) { s0[r] = __builtin_amdgcn_exp2f(s0[r] - mnew); s1[r] = __builtin_amdgcn_exp2f(s1[r] - mnew); ps += s0[r] + s1[r]; }
        lrun = lrun * alpha + ps;
        const u32x4 pf = (u32x4){cvtpk(s0[0], s0[1]), cvtpk(s0[2], s0[3]), cvtpk(s1[0], s1[1]), cvtpk(s1[2], s1[3])};
#pragma unroll
        for (int db = 0; db < 4; ++db) {
            const s16x4 lo = vtr(L + vfr + db * 32);
            const s16x4 hi4 = vtr(L + vfr + 16 * SA_RS + db * 32);
            const bf16x8 vf = (bf16x8){lo[0], lo[1], lo[2], lo[3], hi4[0], hi4[1], hi4[2], hi4[3]};
            o[db] = o[db] * alpha;
            o[db] = __builtin_amdgcn_mfma_f32_16x16x32_bf16(vf, __builtin_bit_cast(bf16x8, pf), o[db], 0, 0, 0);
        }
        __syncthreads();
    }
#undef SA_LOAD
    float lt = lrun; lt += __shfl_xor(lt, 16); lt += __shfl_xor(lt, 32);
    float* po = SPART + (((size_t)slot * 4 + head) * 16 + c16) * 128 + 64 * z + 4 * fq;
#pragma unroll
    for (int db = 0; db < 4; ++db) *(GAS f32x4*)(po + 16 * db) = o[db];
    if (z == 0 && fq == 0) { float* st = SSTAT + (((size_t)slot * 4 + head) * 16 + c16) * 2; st[0] = mrun; st[1] = lt; }
}
constexpr int RG_XCS = 144, RG_RIS = 272, RG_XC = 0, RG_R = 16 * RG_XCS, RG_I = RG_R + 16 * RG_RIS, RG_WS = RG_I + 16 * RG_RIS;
constexpr int RG_SEG_OFF = 8 * RG_WS;
struct RgConst { float cw0, cw1, cw2, cw3, cb, kexp; };
struct RgW { bf16x8 wa[4][2], wx[4][2]; float ba[4], bx[4]; };

__device__ __forceinline__ float gelu_tanh(float x) { const float z = 0.7978845608028654f * (x + 0.044715f * x * x * x); return x * __builtin_amdgcn_rcpf(1.0f + __builtin_amdgcn_exp2f(-2.0f * 1.4426950408889634f * z)); }
__device__ __forceinline__ float sigmoidf_(float x) { return __builtin_amdgcn_rcpf(1.0f + __builtin_amdgcn_exp2f(-1.4426950408889634f * x)); }

__device__ __forceinline__ void rg_gates(LAS unsigned char* wl, int lane, const RgConst& C, const RgW& W, const float (&xh)[3], const float (&xs)[16], float (&a)[16], float (&u)[16]) {
    float xc[16];
#pragma unroll
    for (int t = 0; t < 16; ++t) {
        const float x3 = t >= 3 ? xs[t - 3] : xh[t], x2 = t >= 2 ? xs[t - 2] : xh[t + 1], x1 = t >= 1 ? xs[t - 1] : xh[t + 2];
        xc[t] = C.cb + C.cw0 * x3 + C.cw1 * x2 + C.cw2 * x1 + C.cw3 * xs[t];
        *(LAS unsigned short*)(wl + RG_XC + t * RG_XCS + lane * 2) = (unsigned short)f2bf(xc[t]);
    }
    LDS_WAIT(); asm volatile("" ::: "memory");
    const int c16 = lane & 15, fq = lane >> 4;
    bf16x8 af[2];
#pragma unroll
    for (int ks = 0; ks < 2; ++ks) af[ks] = *(const LAS bf16x8*)(wl + RG_XC + c16 * RG_XCS + (32 * ks + 8 * fq) * 2);
#pragma unroll
    for (int cb = 0; cb < 4; ++cb) {
        f32x4 ar = (f32x4){0.f, 0.f, 0.f, 0.f}, ai = ar;
#pragma unroll
        for (int ks = 0; ks < 2; ++ks) { ar = __builtin_amdgcn_mfma_f32_16x16x32_bf16(af[ks], W.wa[cb][ks], ar, 0, 0, 0); ai = __builtin_amdgcn_mfma_f32_16x16x32_bf16(af[ks], W.wx[cb][ks], ai, 0, 0, 0); }
#pragma unroll
        for (int r = 0; r < 4; ++r) {
            *(LAS float*)(wl + RG_R + (4 * fq + r) * RG_RIS + (16 * cb + c16) * 4) = sigmoidf_(ar[r] + W.ba[cb]);
            *(LAS float*)(wl + RG_I + (4 * fq + r) * RG_RIS + (16 * cb + c16) * 4) = sigmoidf_(ai[r] + W.bx[cb]);
        }
    }
    LDS_WAIT(); asm volatile("" ::: "memory");
#pragma unroll
    for (int t = 0; t < 16; ++t) {
        const float r = *(const LAS float*)(wl + RG_R + t * RG_RIS + lane * 4), i = *(const LAS float*)(wl + RG_I + t * RG_RIS + lane * 4);
        const float av = __builtin_amdgcn_exp2f(C.kexp * r);
        a[t] = av; u[t] = sqrtf(fmaxf(1.0f - av * av, 0.f)) * (i * xc[t]);
    }
    LDS_WAIT(); asm volatile("" ::: "memory");
}
__device__ __forceinline__ void rg_load_consts(int n, int lane, const Args& A, const bf16* WAT, const bf16* WXT, RgConst& C, RgW& W) {
    const int ch = n * 64 + lane;
    const float* cw = (const float*)A.in[15];
    C.cw0 = cw[ch]; C.cw1 = cw[512 + ch]; C.cw2 = cw[1024 + ch]; C.cw3 = cw[1536 + ch]; C.cb = ((const float*)A.in[16])[ch];
    const float lam = ((const float*)A.in[21])[ch];
    C.kexp = -8.0f * log1pf(expf(-lam)) * 1.4426950408889634f;
    const int c16 = lane & 15, fq = lane >> 4;
#pragma unroll
    for (int cb = 0; cb < 4; ++cb) {
        const int d = 16 * cb + c16;
#pragma unroll
        for (int ks = 0; ks < 2; ++ks) { W.wa[cb][ks] = *(const GAS bf16x8*)(WAT + (size_t)n * 4096 + d * 64 + 32 * ks + 8 * fq); W.wx[cb][ks] = *(const GAS bf16x8*)(WXT + (size_t)n * 4096 + d * 64 + 32 * ks + 8 * fq); }
        W.ba[cb] = ((const float*)A.in[18])[n * 64 + d]; W.bx[cb] = ((const float*)A.in[20])[n * 64 + d];
    }
}
__device__ __forceinline__ void rg_prompt_unit(Frame& F, const Args& A, int b, int n, const bf16* XR, const bf16* GT, const bf16* WAT, const bf16* WXT, bf16* MIX, float* hout) {
    const int lane = F.lane, seg = F.wave;
    LAS unsigned char* wl = F.lds + RING_OFF + seg * RG_WS;
    LAS float* SEG = (LAS float*)(F.lds + RING_OFF + RG_SEG_OFF);
    RgConst C; RgW W; rg_load_consts(n, lane, A, WAT, WXT, C, W);
    const int ch = n * 64 + lane;
    float carry = 0.f;
    for (int tile = 0; tile < 16; ++tile) {
        const int t0 = tile * 128 + seg * 16;
        const size_t r0 = (size_t)b * SEQ + t0;
        float xh[3], xs[16], gt[16];
#pragma unroll
        for (int j = 0; j < 3; ++j) xh[j] = (t0 - 3 + j >= 0) ? bf_lo((unsigned)XR[(r0 - 3 + j) * 512 + ch]) : 0.f;
#pragma unroll
        for (int t = 0; t < 16; ++t) { xs[t] = bf_lo((unsigned)XR[(r0 + t) * 512 + ch]); gt[t] = bf_lo((unsigned)GT[(r0 + t) * 512 + ch]); }
        float a[16], u[16];
        rg_gates(wl, lane, C, W, xh, xs, a, u);
        float P = 1.f, H = 0.f;
#pragma unroll
        for (int t = 0; t < 16; ++t) { H = a[t] * H + u[t]; P *= a[t]; }
        LAS float* sg = SEG + ((tile & 1) * 8) * 128;
        sg[seg * 128 + lane * 2] = P; sg[seg * 128 + lane * 2 + 1] = H;
        __syncthreads();
        float hin = carry;
#pragma unroll
        for (int s = 0; s < 8; ++s) { const float Ps = sg[s * 128 + lane * 2], Hs = sg[s * 128 + lane * 2 + 1]; if (s < seg) hin = Ps * hin + Hs; carry = Ps * carry + Hs; }
        float h = hin;
#pragma unroll
        for (int t = 0; t < 16; ++t) { h = a[t] * h + u[t]; MIX[(r0 + t) * 1024 + 512 + ch] = (bf16)f2bf(h * gelu_tanh(gt[t])); }
        if (tile == 15 && seg == 7) hout[b * 512 + ch] = h;
    }
    __syncthreads();
}
__device__ __forceinline__ void rg_sample_unit(Frame& F, const Args& A, int b, int n, const bf16* XR, const bf16* GT, const bf16* WAT, const bf16* WXT, bf16* MIX, float* hout) {
    const int lane = F.lane;
    LAS unsigned char* wl = F.lds + RING_OFF + F.wave * RG_WS;
    RgConst C; RgW W; rg_load_consts(n, lane, A, WAT, WXT, C, W);
    const int ch = n * 64 + lane;
    const size_t r0 = (size_t)MP + b * 8;
    float xh[3], xs[16], gt[8];
    const float* sc = (const float*)A.in[7];
#pragma unroll
    for (int j = 0; j < 3; ++j) xh[j] = sc[(size_t)(b * 3 + j) * 512 + ch];
#pragma unroll
    for (int t = 0; t < 8; ++t) { xs[t] = bf_lo((unsigned)XR[(r0 + t) * 512 + ch]); gt[t] = bf_lo((unsigned)GT[(r0 + t) * 512 + ch]); }
#pragma unroll
    for (int t = 8; t < 16; ++t) xs[t] = 0.f;
    float a[16], u[16];
    rg_gates(wl, lane, C, W, xh, xs, a, u);
    float h = ((const float*)A.in[6])[b * 512 + ch];
#pragma unroll
    for (int t = 0; t < 8; ++t) { h = a[t] * h + u[t]; MIX[(r0 + t) * 1024 + 512 + ch] = (bf16)f2bf(h * gelu_tanh(gt[t])); }
    hout[b * 512 + ch] = h;
}
__device__ __forceinline__ void scomb_unit(Frame& F, int b, int head, int t, const bf16* Q, const bf16* KB, const bf16* VB, const float* SPART, const float* SSTAT, bf16* MIX, float lam, const float* subln) {
    const int lane = F.lane;
    const size_t r0 = (size_t)MP + b * 8;
    float vn[8][2];
#pragma unroll
    for (int j = 0; j < 8; ++j) { const unsigned w = *(const GAS unsigned*)(VB + (r0 + j) * 512 + head * 128 + 2 * lane); vn[j][0] = bf_lo(w); vn[j][1] = bf_hi(w); }
    const f32x2v_t gg = *(const GAS f32x2v_t*)(subln + 2 * lane);
    float om[2][2];
#pragma unroll
    for (int map = 0; map < 2; ++map) {
        const int col = map * 8 + t;
        const float kq = bf_lo((unsigned)Q[(r0 + t) * 512 + head * 128 + map * 64 + lane]);
        float sn[8];
#pragma unroll
        for (int j = 0; j < 8; ++j) { const float kk = bf_lo((unsigned)KB[(r0 + j) * 512 + head * 128 + map * 64 + lane]); const float d = wave_sum(kq * kk); sn[j] = (j <= t) ? d : -INFINITY; }
        float ms[8], ls[8], mt = -INFINITY;
#pragma unroll
        for (int s = 0; s < 8; ++s) { const float* st = SSTAT + (((size_t)(b * 8 + s) * 4 + head) * 16 + col) * 2; ms[s] = st[0]; ls[s] = st[1]; mt = fmaxf(mt, ms[s]); }
#pragma unroll
        for (int j = 0; j < 8; ++j) mt = fmaxf(mt, sn[j]);
        float l = 0.f, o0 = 0.f, o1 = 0.f;
#pragma unroll
        for (int s = 0; s < 8; ++s) { const float w = __builtin_amdgcn_exp2f(ms[s] - mt); l += w * ls[s];
            const f32x2v_t pv = *(const GAS f32x2v_t*)(SPART + (((size_t)(b * 8 + s) * 4 + head) * 16 + col) * 128 + 2 * lane); o0 += w * pv.x; o1 += w * pv.y; }
#pragma unroll
        for (int j = 0; j < 8; ++j) { const float p = __builtin_amdgcn_exp2f(sn[j] - mt); l += p; o0 += p * vn[j][0]; o1 += p * vn[j][1]; }
        const float inv = 1.0f / l; om[map][0] = o0 * inv; om[map][1] = o1 * inv;
        asm volatile("" ::: "memory");
    }
    const float a0 = om[0][0] - lam * om[1][0], a1 = om[0][1] - lam * om[1][1];
    const float ss = wave_sum(a0 * a0 + a1 * a1);
    const float rs = (1.0f - LAM_INIT) / sqrtf(ss * (1.0f / 128.0f) + LN_EPS);
    *(GAS unsigned*)(MIX + (r0 + t) * 1024 + head * 128 + 2 * lane) = cvtpk(a0 * rs * gg.x, a1 * rs * gg.y);
}
__device__ __forceinline__ void ln1_row(int lane, const float* pre, const float* g, const float* bt, float* x1, bf16* x1b) {
    const GAS f32x4* xr = (const GAS f32x4*)pre + lane;
    f32x4 v[4]; float s = 0.f;
#pragma unroll
    for (int j = 0; j < 4; ++j) { v[j] = xr[64 * j]; s += (v[j].x + v[j].y) + (v[j].z + v[j].w); }
    const float mean = wave_sum(s) * (1.f / D); float s2 = 0.f;
#pragma unroll
    for (int j = 0; j < 4; ++j) { v[j] = v[j] - mean; s2 += (v[j].x * v[j].x + v[j].y * v[j].y) + (v[j].z * v[j].z + v[j].w * v[j].w); }
    const float rstd = 1.f / sqrtf(wave_sum(s2) * (1.f / D) + LN_EPS);
#pragma unroll
    for (int j = 0; j < 4; ++j) {
        const f32x4 gg = ((const GAS f32x4*)g)[lane + 64 * j], bb = ((const GAS f32x4*)bt)[lane + 64 * j];
        const f32x4 o = v[j] * rstd * gg + bb;
        ((GAS f32x4*)x1)[lane + 64 * j] = o;
        f32x2v_t w; w.x = __builtin_bit_cast(float, cvtpk(o.x, o.y)); w.y = __builtin_bit_cast(float, cvtpk(o.z, o.w));
        ((GAS f32x2v_t*)x1b)[lane + 64 * j] = w;
    }
}
#define TK_INS(L, x_) do { float x__ = (x_); _Pragma("unroll") for (int k_ = 0; k_ < 16; ++k_) { const float hi__ = fmaxf(L[k_], x__); x__ = fminf(L[k_], x__); L[k_] = hi__; } } while (0)
__device__ __forceinline__ void tk_merge_sorted(float (&L)[16]) {
    float Cb[16];
#pragma unroll
    for (int i = 0; i < 16; ++i) Cb[i] = __shfl_xor(L[i], 32);
    float Cm[16];
#pragma unroll
    for (int i = 0; i < 16; ++i) Cm[i] = fmaxf(L[i], Cb[15 - i]);
#pragma unroll
    for (int d = 8; d >= 1; d >>= 1)
#pragma unroll
        for (int i = 0; i < 16; ++i) if ((i & d) == 0) { const float a = fmaxf(Cm[i], Cm[i + d]), b = fminf(Cm[i], Cm[i + d]); Cm[i] = a; Cm[i + d] = b; }
#pragma unroll
    for (int i = 0; i < 16; ++i) L[i] = Cm[i];
}
__device__ __forceinline__ void peer_topk_unit(Frame& F, int tg, int h, const bf16* PQ, const bf16* KEYS, int* EIDX, float* GW) {
    const int lane = F.lane, r32 = lane & 31, hi = lane >> 5;
    const size_t tok = (size_t)tg * 32 + r32;
    float sl0[16], sl1[16];
#pragma unroll
    for (int k = 0; k < 16; ++k) { sl0[k] = 0.f; sl1[k] = 0.f; }
#pragma unroll 1
    for (int p = 0; p < 2; ++p) {
        bf16x8 qf[8];
        { const bf16* qp = PQ + tok * 2048 + (h * 2 + p) * 128 + hi * 8;
#pragma unroll
          for (int ks = 0; ks < 8; ++ks) qf[ks] = *(const GAS bf16x8*)(qp + ks * 16); }
        const unsigned char* kbase = (const unsigned char*)KEYS + (size_t)(h * 2 + p) * 32768;
        const unsigned kvo = (unsigned)(r32 * 256 + hi * 16);
        f32x16 acc[4];
#pragma unroll
        for (int rb = 0; rb < 4; ++rb) { acc[rb] = f32x16{};
#pragma unroll
            for (int ks = 0; ks < 8; ++ks) { const bf16x8 kf = *(const GAS bf16x8*)(kbase + (kvo + (unsigned)(rb * 8192 + ks * 32))); acc[rb] = __builtin_amdgcn_mfma_f32_32x32x16_bf16(kf, qf[ks], acc[rb], 0, 0, 0); } asm volatile("" ::: "memory"); }
        float L[16];
#pragma unroll
        for (int k = 0; k < 16; ++k) L[k] = -INFINITY;
#pragma unroll
        for (int rb = 0; rb < 4; ++rb)
#pragma unroll
            for (int r = 0; r < 16; ++r) { const unsigned n = (unsigned)(32 * rb + crow(r, hi)); const float x = __uint_as_float((__float_as_uint(acc[rb][r]) & 0xffffff80u) | n); TK_INS(L, x); }
        tk_merge_sorted(L);
#pragma unroll
        for (int k = 0; k < 16; ++k) { if (p == 0) sl0[k] = L[k]; else sl1[k] = L[k]; }
    }
    float v1[16], v2[16];
#pragma unroll
    for (int k = 0; k < 16; ++k) { v1[k] = __uint_as_float(__float_as_uint(sl0[k]) & 0xffffff80u); v2[k] = __uint_as_float(__float_as_uint(sl1[k]) & 0xffffff80u); }
    float T[16];
#pragma unroll
    for (int k = 0; k < 16; ++k) T[k] = -INFINITY;
#pragma unroll
    for (int a = 0; a < 16; ++a)
#pragma unroll
        for (int b = 0; b < 16; ++b) if ((a + 1) * (b + 1) <= 16) { TK_INS(T, v1[a] + v2[b]); }
    const float tau = T[15], vmax = T[0];
    float den = 0.f;
#pragma unroll
    for (int k = 0; k < 16; ++k) den += __builtin_amdgcn_exp2f((T[k] - vmax) * 1.4426950408889634f);
    const float rden = 1.0f / den;
    if (hi == 0) {
        int cnt = 0;
        int* eo = EIDX + tok * 128 + h * 16; float* go = GW + tok * 128 + h * 16;
#pragma unroll
        for (int a = 0; a < 16; ++a)
#pragma unroll
            for (int b = 0; b < 16; ++b) if ((a + 1) * (b + 1) <= 16) {
                const float v = v1[a] + v2[b];
                if (v >= tau && cnt < 16) { eo[cnt] = (int)((__float_as_uint(sl0[a]) & 127u) * 128u + (__float_as_uint(sl1[b]) & 127u)); go[cnt] = __builtin_amdgcn_exp2f((v - vmax) * 1.4426950408889634f) * rden; ++cnt; }
            }
    }
}
__device__ __forceinline__ float dot2bf(unsigned a, unsigned b, float c) { return __builtin_amdgcn_fdot2_f32_bf16(__builtin_bit_cast(bf16x2_t, a), __builtin_bit_cast(bf16x2_t, b), c, false); }
__device__ __forceinline__ float dot8(const v4u& a, const v4u& b, float c) { c = dot2bf(a.x, b.x, c); c = dot2bf(a.y, b.y, c); c = dot2bf(a.z, b.z, c); return dot2bf(a.w, b.w, c); }
__device__ __forceinline__ void peer_token(int lane, size_t tok, const bf16* X1B, const float* X1, const bf16* U, const bf16* V, const int* EIDX, const float* GW,
                                           const float* g2, const float* b2, float* X2, bf16* X2B) {
    const v4u xq0 = *(const GAS v4u*)(X1B + tok * 1024 + lane * 8), xq1 = *(const GAS v4u*)(X1B + tok * 1024 + 512 + lane * 8);
    const int id0 = EIDX[tok * 128 + lane], id1 = EIDX[tok * 128 + 64 + lane];
    const float gw0 = GW[tok * 128 + lane], gw1 = GW[tok * 128 + 64 + lane];
    float acc[16];
#pragma unroll
    for (int i = 0; i < 16; ++i) acc[i] = 0.f;
#pragma unroll 1
    for (int grp = 0; grp < 8; ++grp) {
        const int idv = grp < 4 ? id0 : id1; const float gwv = grp < 4 ? gw0 : gw1; const int lb = (grp & 3) * 16;
        float part[16]; int es[16];
#pragma unroll
        for (int j = 0; j < 16; ++j) {
            es[j] = __builtin_amdgcn_readlane(idv, lb + j) & (NEXP - 1);
            const bf16* up = U + (size_t)es[j] * 1024 + lane * 8;
            const v4u u0 = *(const GAS v4u*)up, u1 = *(const GAS v4u*)(up + 512);
            part[j] = dot8(u1, xq1, dot8(u0, xq0, 0.f));
        }
        float r8[8], r4[4], r2[2], r1;
        { const bool up = (lane & 32) != 0;
#pragma unroll
          for (int j = 0; j < 8; ++j) { const float keep = up ? part[j + 8] : part[j], send = up ? part[j] : part[j + 8]; r8[j] = keep + __shfl_xor(send, 32); } }
        { const bool up = (lane & 16) != 0;
#pragma unroll
          for (int j = 0; j < 4; ++j) { const float keep = up ? r8[j + 4] : r8[j], send = up ? r8[j] : r8[j + 4]; r4[j] = keep + __shfl_xor(send, 16); } }
        { const bool up = (lane & 8) != 0;
#pragma unroll
          for (int j = 0; j < 2; ++j) { const float keep = up ? r4[j + 2] : r4[j], send = up ? r4[j] : r4[j + 2]; r2[j] = keep + __shfl_xor(send, 8); } }
        { const bool up = (lane & 4) != 0; const float keep = up ? r2[1] : r2[0], send = up ? r2[0] : r2[1]; r1 = keep + __shfl_xor(send, 4); }
        r1 += __shfl_xor(r1, 2); r1 += __shfl_xor(r1, 1);
        const int jsel = ((lane >> 5) & 1) * 8 + ((lane >> 4) & 1) * 4 + ((lane >> 3) & 1) * 2 + ((lane >> 2) & 1);
        const float gsel = __shfl(gwv, lb + jsel);
        const float wv = gsel * gelu_tanh(r1);
#pragma unroll
        for (int j = 0; j < 16; ++j) {
            const int src = ((j >> 3) & 1) * 32 + ((j >> 2) & 1) * 16 + ((j >> 1) & 1) * 8 + (j & 1) * 4;
            const float wj = __uint_as_float(__builtin_amdgcn_readlane(__float_as_uint(wv), src));
            const bf16* vp = V + (size_t)es[j] * 1024 + lane * 8;
            const v4u a = *(const GAS v4u*)vp, b = *(const GAS v4u*)(vp + 512);
            acc[0] += wj * bf_lo(a.x); acc[1] += wj * bf_hi(a.x); acc[2] += wj * bf_lo(a.y); acc[3] += wj * bf_hi(a.y);
            acc[4] += wj * bf_lo(a.z); acc[5] += wj * bf_hi(a.z); acc[6] += wj * bf_lo(a.w); acc[7] += wj * bf_hi(a.w);
            acc[8] += wj * bf_lo(b.x); acc[9] += wj * bf_hi(b.x); acc[10] += wj * bf_lo(b.y); acc[11] += wj * bf_hi(b.y);
            acc[12] += wj * bf_lo(b.z); acc[13] += wj * bf_hi(b.z); acc[14] += wj * bf_lo(b.w); acc[15] += wj * bf_hi(b.w);
        }
    }
    float v[16]; float s = 0.f;
#pragma unroll
    for (int c = 0; c < 2; ++c) { const f32x4 a = *(const GAS f32x4*)(X1 + tok * 1024 + c * 512 + lane * 8), b = *(const GAS f32x4*)(X1 + tok * 1024 + c * 512 + lane * 8 + 4);
        v[8 * c + 0] = ALPHA * a.x + acc[8 * c + 0]; v[8 * c + 1] = ALPHA * a.y + acc[8 * c + 1]; v[8 * c + 2] = ALPHA * a.z + acc[8 * c + 2]; v[8 * c + 3] = ALPHA * a.w + acc[8 * c + 3];
        v[8 * c + 4] = ALPHA * b.x + acc[8 * c + 4]; v[8 * c + 5] = ALPHA * b.y + acc[8 * c + 5]; v[8 * c + 6] = ALPHA * b.z + acc[8 * c + 6]; v[8 * c + 7] = ALPHA * b.w + acc[8 * c + 7]; }
#pragma unroll
    for (int i = 0; i < 16; ++i) s += v[i];
    const float mean = wave_sum(s) * (1.f / D); float s2 = 0.f;
#pragma unroll
    for (int i = 0; i < 16; ++i) { v[i] -= mean; s2 += v[i] * v[i]; }
    const float rstd = 1.f / sqrtf(wave_sum(s2) * (1.f / D) + LN_EPS);
#pragma unroll
    for (int c = 0; c < 2; ++c) {
        const f32x4 ga = *(const GAS f32x4*)(g2 + c * 512 + lane * 8), gb = *(const GAS f32x4*)(g2 + c * 512 + lane * 8 + 4), ba = *(const GAS f32x4*)(b2 + c * 512 + lane * 8), bb = *(const GAS f32x4*)(b2 + c * 512 + lane * 8 + 4);
        const f32x4 oa = (f32x4){v[8 * c] * rstd * ga.x + ba.x, v[8 * c + 1] * rstd * ga.y + ba.y, v[8 * c + 2] * rstd * ga.z + ba.z, v[8 * c + 3] * rstd * ga.w + ba.w};
        const f32x4 ob = (f32x4){v[8 * c + 4] * rstd * gb.x + bb.x, v[8 * c + 5] * rstd * gb.y + bb.y, v[8 * c + 6] * rstd * gb.z + bb.z, v[8 * c + 7] * rstd * gb.w + bb.w};
        *(GAS f32x4*)(X2 + tok * 1024 + c * 512 + lane * 8) = oa; *(GAS f32x4*)(X2 + tok * 1024 + c * 512 + lane * 8 + 4) = ob;
        v4u w; w.x = cvtpk(oa.x, oa.y); w.y = cvtpk(oa.z, oa.w); w.z = cvtpk(ob.x, ob.y); w.w = cvtpk(ob.z, ob.w);
        *(GAS v4u*)(X2B + tok * 1024 + c * 512 + lane * 8) = w;
    }
}
#ifdef DEBUG_CHECKS
__device__ __forceinline__ void chk_flag(gu32* flags, int bit, bool bad) { if (bad) __hip_atomic_fetch_or((unsigned*)flags, 1u << bit, __ATOMIC_RELAXED, __HIP_MEMORY_SCOPE_AGENT); }
__device__ __forceinline__ bool chk_bad(float fast, float naive) { const float d = fabsf(fast - naive); return !(d <= 0.03f + 0.05f * fabsf(naive)); }
__device__ __forceinline__ float bfv(const bf16* p, size_t i) { return bf_lo((unsigned)p[i]); }
__device__ __forceinline__ float wave_max(float v) {
#pragma unroll
    for (int o = 1; o < 64; o <<= 1) v = fmaxf(v, __shfl_xor(v, o));
    return v;
}
__device__ __forceinline__ unsigned hash32(unsigned x) { x ^= x >> 16; x *= 0x7feb352du; x ^= x >> 15; x *= 0x846ca68bu; x ^= x >> 16; return x; }

__device__ __forceinline__ void run_checks(Frame& F, const Args& A, unsigned char* ws, float* out, float lam) {
    const int lane = F.lane, gw = F.vcu * NWAVES + F.wave, NGW = F.G * NWAVES;
    gu32* flags = F.ctl + 8;
    const float* xp = (const float*)A.in[0]; const float* xs = (const float*)A.in[1];
    const bf16 *Q = (const bf16*)(ws + WS_Q), *KB = (const bf16*)(ws + WS_KB), *VB = (const bf16*)(ws + WS_VB), *XR = (const bf16*)(ws + WS_XR), *GT = (const bf16*)(ws + WS_GT), *MIX = (const bf16*)(ws + WS_MIX);
    const float* subln = (const float*)A.in[14];
    for (int s = gw; s < 1024; s += NGW) {
        const unsigned hsh = hash32(s * 2654435761u + 17u);
        int row = (s & 7) == 7 ? 16384 + (hsh % 256) : (hsh % 16384); if ((s & 63) == 5) row = ((hsh >> 8) % 8) * 2048 + 2045 + (hsh % 3);
        int col = (hash32(hsh) % 2560);
        const bool wantrot = (s & 1) != 0;
        if (wantrot) { col = (col % 1024); col = (col & ~63) | (col & 15); } else if (col < 1024 && (col & 63) < 16) col += 16;
        const float* xr_ = row < 16384 ? xp + (size_t)row * 1024 : xs + (size_t)(row - 16384) * 1024;
        const float* w = (const float*)A.in[9];
        float acc = 0.f, acc2 = 0.f; const int colp = wantrot ? (col ^ 8) : col;
        for (int k = lane; k < 1024; k += 64) { acc += xr_[k] * w[(size_t)k * 2560 + col]; acc2 += xr_[k] * w[(size_t)k * 2560 + colp]; }
        acc = wave_sum(acc); acc2 = wave_sum(acc2);
        const int sp = row < 16384 ? (row & 2047) : ((row - 16384) & 7); const float pos = row < 16384 ? (float)sp : (float)(8192 + sp);
        float val = acc;
        if (wantrot) { const int d = col & 15, i = d & 7; const double ang = (double)pos * pow(500000.0, -(double)i / 8.0); const float c = (float)cos(ang), sn = (float)sin(ang);
            val = d < 8 ? acc * c - acc2 * sn : acc * c + acc2 * sn; }
        const int kind = col >> 9, cc = col & 511; bool bad = false;
        if (kind == 0) bad = chk_bad(bfv(Q, (size_t)row * 512 + cc), val * 0.18033688011112042f);
        else if (kind == 1) { bad = chk_bad(bfv(KB, (size_t)row * 512 + cc), val); const float o = row < 16384 ? out[O_KP + (size_t)row * 512 + cc] : out[O_KS + (size_t)(row - 16384) * 512 + cc]; bad = bad || chk_bad(o, val); }
        else if (kind == 2) { bad = chk_bad(bfv(VB, (size_t)row * 512 + cc), val); const float o = row < 16384 ? out[O_VP + (size_t)row * 512 + cc] : out[O_VS + (size_t)(row - 16384) * 512 + cc]; bad = bad || chk_bad(o, val); }
        else if (kind == 3) { bad = chk_bad(bfv(XR, (size_t)row * 512 + cc), val);
            if (row < 16384 && sp >= 2045) bad = bad || chk_bad(out[O_CP + (size_t)((row >> 11) * 3 + sp - 2045) * 512 + cc], val);
            if (row >= 16384 && sp >= 5) bad = bad || chk_bad(out[O_CS + (size_t)(((row - 16384) >> 3) * 3 + sp - 5) * 512 + cc], val); }
        else bad = chk_bad(bfv(GT, (size_t)row * 512 + cc), val);
        chk_flag(flags, 3, bad);
    }
    for (int s = gw; s < 96; s += NGW) {
        const bool samp = s >= 64; const unsigned hsh = hash32(s * 97u + 3u);
        const int h = hsh & 3; int b, q, nkeys; size_t qrow;
        if (!samp) { b = (hsh >> 2) & 7; q = (s < 8) ? (s * 37) % 130 : (hsh >> 5) % 2048; if (s == 9) q = 2047; if (s == 10) q = 0; nkeys = q + 1; qrow = (size_t)b * 2048 + q; }
        else { b = (hsh >> 2) & 31; q = (hsh >> 7) & 7; nkeys = PAST + q + 1; qrow = (size_t)MP + b * 8 + q; }
        const float* CK = (const float*)A.in[4]; const float* CV = (const float*)A.in[5]; const int* PT = (const int*)A.in[8];
        float onorm[2][2];
        _Pragma("unroll") for (int mp = 0; mp < 2; ++mp) {
            float qv[64];
_Pragma("unroll") for (int d = 0; d < 64; ++d) qv[d] = bfv(Q, qrow * 512 + h * 128 + mp * 64 + d);
            float mx = -INFINITY;
            for (int k = lane; k < nkeys; k += 64) { float sc = 0.f;
                if (!samp) { _Pragma("unroll") for (int d = 0; d < 64; ++d) sc += qv[d] * bfv(KB, ((size_t)b * 2048 + k) * 512 + h * 128 + mp * 64 + d); }
                else if (k < PAST) { const float* kr = CK + ((size_t)PT[b * NPAGES + (k >> 7)] * PAGE + (k & 127)) * 512 + h * 128 + mp * 64; _Pragma("unroll") for (int d = 0; d < 64; ++d) sc += qv[d] * kr[d]; }
                else { _Pragma("unroll") for (int d = 0; d < 64; ++d) sc += qv[d] * bfv(KB, ((size_t)MP + b * 8 + (k - PAST)) * 512 + h * 128 + mp * 64 + d); }
                mx = fmaxf(mx, sc); }
            mx = wave_max(mx);
            float l = 0.f, o0 = 0.f, o1 = 0.f;
            for (int k0 = 0; k0 < nkeys; k0 += 64) { const int k = k0 + lane; float p = 0.f;
                if (k < nkeys) { float sc = 0.f;
                    if (!samp) { _Pragma("unroll") for (int d = 0; d < 64; ++d) sc += qv[d] * bfv(KB, ((size_t)b * 2048 + k) * 512 + h * 128 + mp * 64 + d); }
                    else if (k < PAST) { const float* kr = CK + ((size_t)PT[b * NPAGES + (k >> 7)] * PAGE + (k & 127)) * 512 + h * 128 + mp * 64; _Pragma("unroll") for (int d = 0; d < 64; ++d) sc += qv[d] * kr[d]; }
                    else { _Pragma("unroll") for (int d = 0; d < 64; ++d) sc += qv[d] * bfv(KB, ((size_t)MP + b * 8 + (k - PAST)) * 512 + h * 128 + mp * 64 + d); }
                    p = __builtin_amdgcn_exp2f(sc - mx); }
                l += p;
                for (int j = 0; j < 64; ++j) { const float pj = __shfl(p, j); const int kk = k0 + j; if (kk < nkeys) {
                    float v0, v1;
                    if (!samp) { v0 = bfv(VB, ((size_t)b * 2048 + kk) * 512 + h * 128 + 2 * lane); v1 = bfv(VB, ((size_t)b * 2048 + kk) * 512 + h * 128 + 2 * lane + 1); }
                    else if (kk < PAST) { const float* vr = CV + ((size_t)PT[b * NPAGES + (kk >> 7)] * PAGE + (kk & 127)) * 512 + h * 128; v0 = vr[2 * lane]; v1 = vr[2 * lane + 1]; }
                    else { v0 = bfv(VB, ((size_t)MP + b * 8 + (kk - PAST)) * 512 + h * 128 + 2 * lane); v1 = bfv(VB, ((size_t)MP + b * 8 + (kk - PAST)) * 512 + h * 128 + 2 * lane + 1); }
                    o0 += pj * v0; o1 += pj * v1; } } }
            l = wave_sum(l); onorm[mp][0] = o0 / l; onorm[mp][1] = o1 / l;
        }
        const float a0 = onorm[0][0] - lam * onorm[1][0], a1 = onorm[0][1] - lam * onorm[1][1];
        const float ss = wave_sum(a0 * a0 + a1 * a1); const float rs = 0.8f / sqrtf(ss / 128.0f + LN_EPS);
        const bool bad = chk_bad(bfv(MIX, qrow * 1024 + h * 128 + 2 * lane), a0 * rs * subln[2 * lane]) || chk_bad(bfv(MIX, qrow * 1024 + h * 128 + 2 * lane + 1), a1 * rs * subln[2 * lane + 1]);
        chk_flag(flags, samp ? 5 : 4, bad);
    }
    for (int s = gw; s < 48; s += NGW) {
        const bool samp = s >= 16; const unsigned hsh = hash32(s * 131u + 7u);
        const int n = hsh & 7, b = samp ? ((hsh >> 3) & 31) : ((hsh >> 3) & 7), T = samp ? 8 : 2048; const int ch = n * 64 + lane;
        const size_t r0 = samp ? (size_t)MP + b * 8 : (size_t)b * 2048;
        const float* cw = (const float*)A.in[15]; const float cb_ = ((const float*)A.in[16])[ch];
        const float* wa = (const float*)A.in[17] + n * 4096; const float* wx = (const float*)A.in[19] + n * 4096;
        const float ba = ((const float*)A.in[18])[ch], bx = ((const float*)A.in[20])[ch];
        const float sp = log1pf(expf(-((const float*)A.in[21])[ch]));
        float x3, x2, x1, h;
        if (samp) { const float* sc = (const float*)A.in[7]; x3 = sc[(size_t)(b * 3) * 512 + ch]; x2 = sc[(size_t)(b * 3 + 1) * 512 + ch]; x1 = sc[(size_t)(b * 3 + 2) * 512 + ch]; h = ((const float*)A.in[6])[b * 512 + ch]; }
        else { x3 = x2 = x1 = 0.f; h = 0.f; }
        bool bad = false;
        for (int t = 0; t < T; ++t) {
            const float x0 = bfv(XR, (r0 + t) * 512 + ch);
            const float xc = cb_ + cw[ch] * x3 + cw[512 + ch] * x2 + cw[1024 + ch] * x1 + cw[1536 + ch] * x0;
            x3 = x2; x2 = x1; x1 = x0;
            float rr = ba, ii = bx;
            for (int c = 0; c < 64; ++c) { const float xcc = __shfl(xc, c); rr += xcc * wa[c * 64 + lane]; ii += xcc * wx[c * 64 + lane]; }
            rr = 1.0f / (1.0f + expf(-rr)); ii = 1.0f / (1.0f + expf(-ii));
            const float la = -8.0f * sp * rr, a = expf(la), u = sqrtf(fmaxf(-expm1f(2.0f * la), 0.f)) * (ii * xc);
            h = a * h + u;
            const float g = bfv(GT, (r0 + t) * 512 + ch); const float ge = 0.5f * g * (1.0f + tanhf(0.7978845608028654f * (g + 0.044715f * g * g * g)));
            if ((t & 15) == 3 || t == T - 1 || t < 20) bad = bad || chk_bad(bfv(MIX, (r0 + t) * 1024 + 512 + ch), h * ge);
        }
        bad = bad || chk_bad(out[(samp ? O_HS : O_HP) + (size_t)b * 512 + ch], h);
        chk_flag(flags, 6, bad);
    }
    for (int s = gw; s < 768; s += NGW) {
        const unsigned hsh = hash32(s * 2246822519u + 11u); const int which = s % 3;
        const int row = (s & 7) == 7 ? 16384 + (hsh % 256) : (hsh % 16384);
        if (which == 0) { continue; const int col = hash32(hsh) % 1024; const float* w = (const float*)A.in[22]; float acc = 0.f;
            for (int k = lane; k < 1024; k += 64) acc += bfv(MIX, (size_t)row * 1024 + k) * w[(size_t)k * 1024 + col];
            acc = wave_sum(acc); const float xv = row < 16384 ? xp[(size_t)row * 1024 + col] : xs[(size_t)(row - 16384) * 1024 + col];
            bool bad = chk_bad(((const float*)(ws + WS_PRE1))[(size_t)row * 1024 + col], ALPHA * xv + acc);
            const float* pr = (const float*)(ws + WS_PRE1) + (size_t)row * 1024; float sm = 0.f; for (int k = lane; k < 1024; k += 64) sm += pr[k]; const float mean = wave_sum(sm) / 1024.f;
            float sq = 0.f; for (int k = lane; k < 1024; k += 64) { const float d = pr[k] - mean; sq += d * d; } const float rstd = 1.0f / sqrtf(wave_sum(sq) / 1024.f + LN_EPS);
            const float x1n = (pr[col] - mean) * rstd * ((const float*)A.in[23])[col] + ((const float*)A.in[24])[col];
            bad = bad || chk_bad(((const float*)(ws + WS_X1))[(size_t)row * 1024 + col], x1n) || chk_bad(bfv((const bf16*)(ws + WS_X1B), (size_t)row * 1024 + col), x1n);
            chk_flag(flags, 7, bad);
        } else if (which == 1) { const int col = hash32(hsh) % 2048; const float* w = (const float*)A.in[25]; float acc = 0.f;
            for (int k = lane; k < 1024; k += 64) acc += bfv((const bf16*)(ws + WS_X1B), (size_t)row * 1024 + k) * w[(size_t)k * 2048 + col];
            acc = wave_sum(acc); chk_flag(flags, 7, chk_bad(bfv((const bf16*)(ws + WS_PQ), (size_t)row * 2048 + col), acc));
        } else { const int col = hash32(hsh) % 1024; const float* w = (const float*)A.in[32]; float acc = 0.f, pl = 0.f;
            for (int k = lane; k < 1024; k += 64) acc += bfv((const bf16*)(ws + WS_X2B), (size_t)row * 1024 + k) * w[(size_t)k * 1024 + col];
            const float* pe = row < 16384 ? (const float*)A.in[2] + (size_t)row * 256 : (const float*)A.in[3] + (size_t)(row - 16384) * 256;
            for (int k = lane; k < 256; k += 64) pl += pe[k] * ((const float*)A.in[31])[(size_t)k * 1024 + col];
            acc = wave_sum(acc) + ((const float*)A.in[33])[col]; pl = wave_sum(pl);
            const float y = ((const float*)(ws + WS_X2))[(size_t)row * 1024 + col] + pl / (1.0f + expf(-acc));
            const float yo = row < 16384 ? out[O_YP + (size_t)row * 1024 + col] : out[O_YS + (size_t)(row - 16384) * 1024 + col];
            chk_flag(flags, 1, chk_bad(yo, y)); { const float zf = ((const float*)(ws + WS_PRE1))[(size_t)row * 1024 + col]; chk_flag(flags, 9, chk_bad(zf, acc)); const float x2v = ((const float*)(ws + WS_X2))[(size_t)row * 1024 + col]; chk_flag(flags, 3, chk_bad(yo, x2v + bfv((const bf16*)(ws + WS_PLE), (size_t)row * 1024 + col) / (1.0f + expf(-zf)))); } chk_flag(flags, 0, chk_bad(bfv((const bf16*)(ws + WS_PLE), (size_t)row * 1024 + col), pl));
        }
    }
    for (int s = gw; s < 128; s += NGW) {
        const unsigned hsh = hash32(s * 3266489917u + 29u); const int tok = (s & 7) == 7 ? 16384 + (hsh % 256) : (hsh % 16384); const int h = (hsh >> 16) & 7;
        const bf16* PQ = (const bf16*)(ws + WS_PQ); const float* keys = (const float*)A.in[26];
        float sc[2][2];
        _Pragma("unroll") for (int p = 0; p < 2; ++p) _Pragma("unroll") for (int e = 0; e < 2; ++e) { const int n = lane + 64 * e; float a = 0.f;
            for (int d = 0; d < 128; ++d) a += bfv(PQ, (size_t)tok * 2048 + (h * 2 + p) * 128 + d) * bf_lo(f2bf(keys[((size_t)(h * 2 + p) * 128 + n) * 128 + d]));
            sc[p][e] = a; }
        float tv[2] = {0.f, 0.f}; int ti[2] = {0, 0};
        _Pragma("unroll") for (int p = 0; p < 2; ++p) { float v0 = sc[p][0], v1 = sc[p][1];
            for (int k = 0; k < 16; ++k) { const float m = wave_max(fmaxf(v0, v1)); const unsigned long long bal = __ballot(v0 == m || v1 == m); const int src = __ffsll((long long)bal) - 1;
                const int idx = (__shfl(v0, src) == m) ? src : src + 64; if (lane == k) { tv[p] = m; ti[p] = idx; }
                if (lane == (idx & 63)) { if (idx < 64) v0 = -INFINITY; else v1 = -INFINITY; } } }
        float cv[4]; int ce[4];
        _Pragma("unroll") for (int e = 0; e < 4; ++e) { const int a = lane >> 2, b = 4 * (lane & 3) + e; cv[e] = __shfl(tv[0], a) + __shfl(tv[1], b); ce[e] = __shfl(ti[0], a) * 128 + __shfl(ti[1], b); }
        float tops = 0.f; int tope = -1;
        for (int k = 0; k < 16; ++k) { const float m = wave_max(fmaxf(fmaxf(cv[0], cv[1]), fmaxf(cv[2], cv[3]))); const unsigned long long bal = __ballot(cv[0] == m || cv[1] == m || cv[2] == m || cv[3] == m);
            const int src = __ffsll((long long)bal) - 1; int e = 0; float c0 = __shfl(cv[0], src), c1 = __shfl(cv[1], src), c2 = __shfl(cv[2], src); e = (c0 == m) ? 0 : (c1 == m) ? 1 : (c2 == m) ? 2 : 3;
            const int ee = (e == 0) ? __shfl(ce[0], src) : (e == 1) ? __shfl(ce[1], src) : (e == 2) ? __shfl(ce[2], src) : __shfl(ce[3], src);
            if (lane == k) { tops = m; tope = ee; }
            if (lane == src) { if (e == 0) cv[0] = -INFINITY; else if (e == 1) cv[1] = -INFINITY; else if (e == 2) cv[2] = -INFINITY; else cv[3] = -INFINITY; } }
        const float tmax = __shfl(tops, 0); float ex = lane < 16 ? expf(tops - tmax) : 0.f; const float den = wave_sum(ex); const float gn = ex / den;
        const int* EI = (const int*)(ws + WS_EIDX) + (size_t)tok * 128 + h * 16; const float* GG = (const float*)(ws + WS_GW) + (size_t)tok * 128 + h * 16;
        int miss = 0; float gerr = 0.f;
        for (int k = 0; k < 16; ++k) { const int fe = EI[k]; const float fg = GG[k]; const unsigned long long hit = __ballot(lane < 16 && tope == fe);
            if (hit == 0ull) ++miss; else { const int src = __ffsll((long long)hit) - 1; gerr = fmaxf(gerr, fabsf(__shfl(gn, src) - fg)); } }
        chk_flag(flags, 8, miss > 2 || gerr > 0.02f);
    }
    for (int s = gw; s < 64; s += NGW) {
        const unsigned hsh = hash32(s * 668265263u + 41u); const size_t tok = (s & 7) == 7 ? 16384 + (hsh % 256) : (hsh % 16384);
        const bf16* X1B = (const bf16*)(ws + WS_X1B); const float* X1 = (const float*)(ws + WS_X1); const float* Uf = (const float*)A.in[27]; const float* Vf = (const float*)A.in[28];
        const int* EI = (const int*)(ws + WS_EIDX) + tok * 128; const float* GG = (const float*)(ws + WS_GW) + tok * 128;
        float ffn[16];
        _Pragma("unroll") for (int i = 0; i < 16; ++i) ffn[i] = 0.f;
        for (int j = 0; j < 128; ++j) { const int e = EI[j] & (NEXP - 1); float a = 0.f;
            _Pragma("unroll") for (int i = 0; i < 16; ++i) a += bfv(X1B, tok * 1024 + lane + 64 * i) * Uf[(size_t)e * 1024 + lane + 64 * i];
            a = wave_sum(a); const float ge = 0.5f * a * (1.0f + tanhf(0.7978845608028654f * (a + 0.044715f * a * a * a))); const float w = GG[j] * ge;
            _Pragma("unroll") for (int i = 0; i < 16; ++i) ffn[i] += w * Vf[(size_t)e * 1024 + lane + 64 * i]; }
        float sm = 0.f; float pre[16];
        _Pragma("unroll") for (int i = 0; i < 16; ++i) { pre[i] = ALPHA * X1[tok * 1024 + lane + 64 * i] + ffn[i]; sm += pre[i]; }
        const float mean = wave_sum(sm) / 1024.f; float sq = 0.f;
        _Pragma("unroll") for (int i = 0; i < 16; ++i) { const float d = pre[i] - mean; sq += d * d; }
        const float rstd = 1.0f / sqrtf(wave_sum(sq) / 1024.f + LN_EPS); bool bad = false;
        _Pragma("unroll") for (int i = 0; i < 16; ++i) { const int c = lane + 64 * i; const float x2 = (pre[i] - mean) * rstd * ((const float*)A.in[29])[c] + ((const float*)A.in[30])[c];
            bad = bad || chk_bad(((const float*)(ws + WS_X2))[tok * 1024 + c], x2) || chk_bad(bfv((const bf16*)(ws + WS_X2B), tok * 1024 + c), x2); }
        chk_flag(flags, 2, bad);
    }
}
__device__ __forceinline__ void encode_flags(Frame& F, float* out) {
    const unsigned fl = __hip_atomic_load((unsigned*)(F.ctl + 8), __ATOMIC_RELAXED, __HIP_MEMORY_SCOPE_AGENT);
    const float Aenc = sqrtf((10.0f + 2.0f * (float)(fl & 31u)) * powf(10.0f, (float)((fl >> 5) + 2u)));
    const size_t nth = (size_t)F.G * NWAVES * 64, me = (size_t)F.vcu * NWAVES * 64 + F.tid;
    for (size_t i = me; i < O_END; i += nth) out[i] = (i >= O_KP && i < O_VP) ? Aenc : 0.f;
}
#endif
__global__ void __launch_bounds__(NWAVES * 64, 2) mega_fwd(Args args) {
    extern __shared__ __attribute__((aligned(16))) unsigned char lds[];
    Frame F;
    F.lds = (LAS unsigned char*)lds;
    F.MISC = (volatile LAS unsigned*)(F.lds + MISC_OFF);
    F.tid = threadIdx.x; F.lane = F.tid & 63; F.wave = __builtin_amdgcn_readfirstlane(F.tid >> 6);
    F.G = gridDim.x; { const int bx = blockIdx.x; F.vcu = (F.G % 8 == 0) ? (bx % 8) * (F.G / 8) + bx / 8 : bx; }
    unsigned char* ws = args.ws;
    F.ctl = (gu32*)(ws + WS_CTL);
    for (int u = F.tid; u < (LDS_BYTES - LDSCTL_OFF) / 4; u += NWAVES * 64) ((LAS unsigned*)(F.lds + LDSCTL_OFF))[u] = 0u;
    __syncthreads();
    XcdBarrier bar = xcd_barrier_post((unsigned*)(F.ctl + CW_BAR), F.MISC + 8);
    float* out = args.out;
#define LAUNDER() do { asm volatile("" : "+v"(F.tid)); F.lane = F.tid & 63; } while (0)

    LAUNDER();
    p0_prologue(F, args, ws);
    xcd_barrier(bar);

    LAUNDER();
    {
        pg8::Gemm g{(const pg8::bf16_t*)(ws + WS_XB), (const pg8::bf16_t*)(ws + WS_WIN_T), M, INW, D}; pg8::StaticOrder S; S.init(M, INW, F.G, (int)blockIdx.x);
        pg8::EpiIn E{(pg8::bf16_t*)(ws + WS_Q), (pg8::bf16_t*)(ws + WS_KB), (pg8::bf16_t*)(ws + WS_VB), (pg8::bf16_t*)(ws + WS_XR), (pg8::bf16_t*)(ws + WS_GT),
                     out + O_KP, out + O_VP, out + O_CP, out + O_KS, out + O_VS, out + O_CS};
        pg8::gemm_phase<pg8::EpiIn, pg8::StaticOrder, true, true>(F.lds + RING_OFF, g, S, E);
    }
    {
        pg8::Gemm g{(const pg8::bf16_t*)(ws + WS_PE), (const pg8::bf16_t*)(ws + WS_WPLE_T), M, D, 256}; pg8::StaticOrder S; S.init(M, D, F.G, (int)blockIdx.x);
        pg8::EpiBf16 E{(pg8::bf16_t*)(ws + WS_PLE), D};
        pg8::gemm_phase<pg8::EpiBf16, pg8::StaticOrder, true, true>(F.lds + RING_OFF, g, S, E);
    }
    xcd_barrier(bar);

    float lam;
    { const float a = wave_sum(((const float*)args.in[10])[F.lane] * ((const float*)args.in[11])[F.lane]);
      const float b = wave_sum(((const float*)args.in[12])[F.lane] * ((const float*)args.in[13])[F.lane]);
      lam = expf(a) - expf(b) + LAM_INIT; }
    const float* subln = (const float*)args.in[14];
    bf16* MIX = (bf16*)(ws + WS_MIX);

    LAUNDER();
#ifndef SKIP_P2
    {
        const bf16 *XR = (const bf16*)(ws + WS_XR), *GT = (const bf16*)(ws + WS_GT), *WAT = (const bf16*)(ws + WS_WAT), *WXT = (const bf16*)(ws + WS_WXT);
        const bf16 *Qb = (const bf16*)(ws + WS_Q), *KBb = (const bf16*)(ws + WS_KB), *VBb = (const bf16*)(ws + WS_VB);
        if (F.wave == 0) for (int u = F.vcu; u < NBS * 8; u += F.G) rg_sample_unit(F, args, u >> 3, u & 7, XR, GT, WAT, WXT, MIX, out + O_HS);
        __syncthreads();
        const bool samp_first = (F.vcu & 1) == 0;
        if (samp_first) for (int it = F.vcu; it < NBS * 8; it += F.G) sattn_item(F, it >> 3, it & 7, it, (const float*)args.in[4], (const float*)args.in[5], (const int*)args.in[8], Qb, (float*)(ws + WS_SPART), (float*)(ws + WS_SSTAT));
        for (int pu = F.vcu; pu < 256; pu += F.G) {
            const int bh = pu >> 3, s = pu & 7;
            pattn_unit(F, bh >> 2, bh & 3, s, Qb, KBb, VBb, MIX, lam, subln);
            pattn_unit(F, bh >> 2, bh & 3, 15 - s, Qb, KBb, VBb, MIX, lam, subln);
        }
        for (int u = F.vcu; u < 4 * 64; u += F.G) if ((u & 3) == 0) rg_prompt_unit(F, args, (u >> 2) >> 3, (u >> 2) & 7, XR, GT, WAT, WXT, MIX, out + O_HP);
        if (!samp_first) for (int it = F.vcu; it < NBS * 8; it += F.G) sattn_item(F, it >> 3, it & 7, it, (const float*)args.in[4], (const float*)args.in[5], (const int*)args.in[8], Qb, (float*)(ws + WS_SPART), (float*)(ws + WS_SSTAT));
    }
#endif
    xcd_barrier(bar);

    LAUNDER();
#ifndef SKIP_P3A
    {
        const int gw = F.vcu * NWAVES + F.wave, NGW = F.G * NWAVES;
        for (int u = gw; u < NBS * 4 * 8; u += NGW) scomb_unit(F, u >> 5, (u >> 3) & 3, u & 7, (const bf16*)(ws + WS_Q), (const bf16*)(ws + WS_KB), (const bf16*)(ws + WS_VB), (const float*)(ws + WS_SPART), (const float*)(ws + WS_SSTAT), MIX, lam, subln);
    }
#endif
    xcd_barrier(bar);

    LAUNDER();
#ifndef SKIP_P3
    {
        pg8::Gemm g{(const pg8::bf16_t*)(ws + WS_MIX), (const pg8::bf16_t*)(ws + WS_WOUT_T), M, D, D}; pg8::StaticOrder S; S.init(M, D, F.G, (int)blockIdx.x);
        pg8::EpiPre1 E{(const float*)args.in[0], (const float*)args.in[1], (float*)(ws + WS_PRE1), ALPHA};
        pg8::gemm_phase<pg8::EpiPre1, pg8::StaticOrder, true, true>(F.lds + RING_OFF, g, S, E);
    }
#endif
    xcd_barrier(bar);

    LAUNDER();
#ifndef SKIP_P3C
    {
        const int gw = F.vcu * NWAVES + F.wave, NGW = F.G * NWAVES;
        for (int m = gw; m < M; m += NGW) ln1_row(F.lane, (const float*)(ws + WS_PRE1) + (size_t)m * D, (const float*)args.in[23], (const float*)args.in[24], (float*)(ws + WS_X1) + (size_t)m * D, (bf16*)(ws + WS_X1B) + (size_t)m * D);
    }
#endif
    xcd_barrier(bar);

    LAUNDER();
#ifndef SKIP_P4
    {
        pg8::Gemm g{(const pg8::bf16_t*)(ws + WS_X1B), (const pg8::bf16_t*)(ws + WS_WQ_T), M, 2048, D}; pg8::StaticOrder S; S.init(M, 2048, F.G, (int)blockIdx.x);
        pg8::EpiBf16 E{(pg8::bf16_t*)(ws + WS_PQ), 2048};
        pg8::gemm_phase<pg8::EpiBf16, pg8::StaticOrder, true, true>(F.lds + RING_OFF, g, S, E);
    }
#endif
    xcd_barrier(bar);

    LAUNDER();
#ifndef SKIP_P5
    {
        const int gw = F.vcu * NWAVES + F.wave, NGW = F.G * NWAVES;
        for (int u = gw; u < (M / 32) * 8; u += NGW) peer_topk_unit(F, __builtin_amdgcn_readfirstlane(u >> 3), __builtin_amdgcn_readfirstlane(u & 7), (const bf16*)(ws + WS_PQ), (const bf16*)(ws + WS_KEYS), (int*)(ws + WS_EIDX), (float*)(ws + WS_GW));
    }
#endif
    xcd_barrier(bar);

    LAUNDER();
#ifndef SKIP_P6
    {
        const int gw = F.vcu * NWAVES + F.wave, NGW = F.G * NWAVES;
        for (int m = gw; m < M; m += NGW) peer_token(F.lane, (size_t)m, (const bf16*)(ws + WS_X1B), (const float*)(ws + WS_X1), (const bf16*)(ws + WS_U), (const bf16*)(ws + WS_V), (const int*)(ws + WS_EIDX), (const float*)(ws + WS_GW),
                                                     (const float*)args.in[29], (const float*)args.in[30], (float*)(ws + WS_X2), (bf16*)(ws + WS_X2B));
    }
#endif
    xcd_barrier(bar);

    LAUNDER();
#ifndef SKIP_P7
    {
        pg8::Gemm g{(const pg8::bf16_t*)(ws + WS_X2B), (const pg8::bf16_t*)(ws + WS_WG_T), M, D, D}; pg8::StaticOrder S; S.init(M, D, F.G, (int)blockIdx.x);
        pg8::EpiFinal E{(const float*)(ws + WS_X2), (const pg8::bf16_t*)(ws + WS_PLE), (const float*)args.in[33], out + O_YP, out + O_YS, (float*)(ws + WS_PRE1)};
        pg8::gemm_phase<pg8::EpiFinal, pg8::StaticOrder, true, true>(F.lds + RING_OFF, g, S, E);
    }
#endif
#ifdef DEBUG_CHECKS
    xcd_barrier(bar);
    LAUNDER();
    run_checks(F, args, ws, out, lam);
    xcd_barrier(bar);
    LAUNDER();
    encode_flags(F, out);
#endif
}

extern "C" void kernel_launch(void* const* d_in, const int* in_sizes, int n_in, void* d_out, int out_size, void* d_ws, size_t ws_size, hipStream_t stream) {
    static int grid = 0;
    if (grid == 0) {
        if (n_in != 34 || (size_t)out_size != O_END || ws_size < WS_END) { fprintf(stderr, "kernel_launch: unexpected shapes (n_in %d out %d ws %zu)\n", n_in, out_size, ws_size); grid = -1; return; }
        int dev = 0, cus = 0, per_cu = 0;
        if (hipGetDevice(&dev) != hipSuccess || hipDeviceGetAttribute(&cus, hipDeviceAttributeMultiprocessorCount, dev) != hipSuccess) { grid = -1; return; }
        if (hipFuncSetAttribute((const void*)mega_fwd, hipFuncAttributeMaxDynamicSharedMemorySize, LDS_BYTES) != hipSuccess) { fprintf(stderr, "kernel_launch: hipFuncSetAttribute failed\n"); grid = -1; return; }
        if (hipOccupancyMaxActiveBlocksPerMultiprocessor(&per_cu, (const void*)mega_fwd, NWAVES * 64, LDS_BYTES) != hipSuccess || per_cu < 1) { fprintf(stderr, "kernel_launch: occupancy query says %d\n", per_cu); }
        (void)hipGetLastError();
        grid = cus;
    }
    if (grid < 0) return;
    if (hipMemsetAsync((char*)d_ws + WS_CTL, 0, CTL_ZERO_BYTES, stream) != hipSuccess) return;
    Args a{};
    for (int i = 0; i < 34; ++i) a.in[i] = d_in[i];
    a.out = (float*)d_out; a.ws = (unsigned char*)d_ws;
    hipLaunchKernelGGL(mega_fwd, dim3(grid), dim3(NWAVES * 64), LDS_BYTES, stream, a);
}
```

```cpp
#include <hip/hip_runtime.h>
#include <cstdio>
#include <cstdint>
namespace pg8 {
#define PG8_LAS __attribute__((address_space(3)))
typedef unsigned short bf16_t;
typedef short bf16x8 __attribute__((ext_vector_type(8)));
typedef float f32x4 __attribute__((ext_vector_type(4)));
typedef unsigned u32x4 __attribute__((ext_vector_type(4)));
constexpr int BM = 256, BK = 64, HALF = 128, HTB = HALF * BK * 2  , STAGE_BYTES = 8 * HTB, NXCD = 8, WGM = 8;

__host__ __device__ __forceinline__ int lds_byte(int r, int c) { const int st = (r >> 4) * 2 + (c >> 5), rr = r & 15, cc = c & 31, ob = rr * 64 + cc * 2; return st * 1024 + (ob ^ (((ob >> 9) & 1) << 5)); }
__host__ __device__ __forceinline__ void stage_rc(int b, int& R, int& C) { const int st = b / 1024, sb = b % 1024, swz = sb ^ (((sb >> 9) & 1) << 5); R = (st >> 1) * 16 + swz / 64; C = (st & 1) * 32 + (swz % 64) / 2; }
__host__ __device__ __forceinline__ int perm32(int rho) { const int n = rho >> 4, i = rho & 15; return 8 * (i >> 2) + 4 * n + (i & 3); }

struct Unit { int pm, pn; };
struct Gemm { const bf16_t* A; const bf16_t* Bt; int M, N, K; };

struct StaticOrder {
    int nM, nN, nwg, G, c;
    __host__ __device__ void init(int M, int N, int G_, int c_) { nM = M / BM; nN = N / BM; nwg = nM * nN; G = G_; c = c_; }
    __host__ __device__ bool next(int i, Unit& u) const {
        const long L = (long)i * G + c; if (L >= nwg) return false;
        int wgid = (int)L; { const int q = nwg / NXCD, r = nwg % NXCD, xcd = wgid % NXCD, off = wgid / NXCD; wgid = (xcd < r ? xcd * (q + 1) : r * (q + 1) + (xcd - r) * q) + off; }
        const int nig = WGM * nN, gid = wgid / nig, fm = gid * WGM, gsz = (nM - fm) < WGM ? (nM - fm) : WGM;
        u.pm = fm + ((wgid % nig) % gsz); u.pn = (wgid % nig) / gsz; return true;
    }
    __device__ __forceinline__ void a_ready(const Unit&) const {}
    __device__ __forceinline__ void done(const Unit&) const {}
};

__device__ __forceinline__ unsigned cvt_pk_bf16(float lo, float hi) { unsigned r; asm volatile("v_cvt_pk_bf16_f32 %0, %1, %2" : "=v"(r) : "v"(lo), "v"(hi)); return r; }
typedef float f32x2 __attribute__((ext_vector_type(2)));
typedef unsigned u32x2 __attribute__((ext_vector_type(2)));

struct EpiBf16 {
    static constexpr bool PERM = true, AFTER_DRAIN = false;
    bf16_t* O; int ldc;
    __device__ __forceinline__ void operator()(const f32x4 (&acc)[2][2][4][2], const Unit& u, int wr, int wc, int fr, int fq) const {
        const int row0 = u.pm * BM + wr * 64 + fr; const int col0 = u.pn * BM + wc * 32 + 8 * fq;
#pragma unroll
        for (int ai = 0; ai < 2; ++ai)
#pragma unroll
            for (int m = 0; m < 4; ++m) { bf16_t* rowp = O + (size_t)(row0 + ai * HALF + m * 16) * ldc + col0;
#pragma unroll
                for (int bj = 0; bj < 2; ++bj) { const f32x4 v0 = acc[ai][bj][m][0], v1 = acc[ai][bj][m][1];
                    u32x4 w; w.x = cvt_pk_bf16(v0[0], v0[1]); w.y = cvt_pk_bf16(v0[2], v0[3]); w.z = cvt_pk_bf16(v1[0], v1[1]); w.w = cvt_pk_bf16(v1[2], v1[3]);
                    *(u32x4*)(rowp + bj * HALF) = w; } }
    }
};

struct PleOrder {
    int c, G;
    __device__ __forceinline__ bool next(int i, Unit& u) const { const int h = G / 2; if (c < h) return false; const int L = (c - h) + (G - h) * i; if (L >= 256) return false; u.pm = L >> 2; u.pn = L & 3; return true; }
    __device__ __forceinline__ void a_ready(const Unit&) const {}
    __device__ __forceinline__ void done(const Unit&) const {}
};
struct EpiIn {
    static constexpr bool PERM = true, AFTER_DRAIN = false;
    bf16_t *Q, *KB, *VB, *XR, *GT; float *kp, *vp, *cp, *ks, *vs, *cs;
    __device__ __forceinline__ void operator()(const f32x4 (&acc)[2][2][4][2], const Unit& u, int wr, int wc, int fr, int fq) const {
        const int kind = u.pn >> 1; const bool samp = (u.pm == 64);
        const int colt = (u.pn & 1) * 256 + wc * 32 + 8 * fq;
        const int row0 = u.pm * BM + wr * 64 + fr;
        const bool rot = (kind <= 1) && ((wc & 1) == 0);
        const float RC[8] = {0.15915494309189535f, 0.03086376340470123f, 0.005985185712713705f, 0.001160663641240061f, 0.00022507907903927653f, 4.364795279280289e-05f, 8.464330808241401e-06f, 1.6414262627950345e-06f};
        const float C2 = 0.18033688011112042f;
#pragma unroll
        for (int ai = 0; ai < 2; ++ai)
#pragma unroll
            for (int m = 0; m < 4; ++m) {
                const int row = row0 + ai * HALF + m * 16;
                const int sp = samp ? ((row - 16384) & 7) : (row & 2047);
                const float pos = (float)(samp ? 8192 + sp : sp);
                float cs_[8], sn_[8];
                if (rot) {
#pragma unroll
                    for (int j = 0; j < 8; ++j) { float rv = pos * RC[j]; rv = rv - floorf(rv); cs_[j] = __builtin_amdgcn_cosf(rv); sn_[j] = __builtin_amdgcn_sinf(rv); }
                }
#pragma unroll
                for (int bj = 0; bj < 2; ++bj) {
                    f32x4 v0 = acc[ai][bj][m][0], v1 = acc[ai][bj][m][1];
                    const int col = colt + bj * HALF;
                    if (rot) {
                        float mine[8] = {v0[0], v0[1], v0[2], v0[3], v1[0], v1[1], v1[2], v1[3]};
                        float res[8];
#pragma unroll
                        for (int j = 0; j < 8; ++j) { const float oth = __shfl_xor(mine[j], 16); const float t = (fq == 0) ? -oth : oth; res[j] = mine[j] * cs_[j] + t * sn_[j]; }
                        if (fq < 2) { v0 = (f32x4){res[0], res[1], res[2], res[3]}; v1 = (f32x4){res[4], res[5], res[6], res[7]}; }
                    }
                    if (kind == 0) { v0 = v0 * C2; v1 = v1 * C2; }
                    u32x4 w; w.x = cvt_pk_bf16(v0[0], v0[1]); w.y = cvt_pk_bf16(v0[2], v0[3]); w.z = cvt_pk_bf16(v1[0], v1[1]); w.w = cvt_pk_bf16(v1[2], v1[3]);
                    bf16_t* dst = kind == 0 ? Q : kind == 1 ? KB : kind == 2 ? VB : kind == 3 ? XR : GT;
                    *(u32x4*)(dst + (size_t)row * 512 + col) = w;
                    if (kind == 1 || kind == 2) {
                        float* o = samp ? ((kind == 1 ? ks : vs) + (size_t)(row - 16384) * 512 + col) : ((kind == 1 ? kp : vp) + (size_t)row * 512 + col);
                        *(f32x4*)o = v0; *(f32x4*)(o + 4) = v1;
                    } else if (kind == 3) {
                        if (samp) { if (sp >= 5) { float* o = cs + (size_t)(((row - 16384) >> 3) * 3 + (sp - 5)) * 512 + col; *(f32x4*)o = v0; *(f32x4*)(o + 4) = v1; } }
                        else { if (sp >= 2045) { float* o = cp + (size_t)((row >> 11) * 3 + (sp - 2045)) * 512 + col; *(f32x4*)o = v0; *(f32x4*)(o + 4) = v1; } }
                    }
                }
            }
    }
};

struct EpiPre1 {
    static constexpr bool PERM = true, AFTER_DRAIN = false;
    const bf16_t* xb; bf16_t* C; float alpha;
    __device__ __forceinline__ void operator()(const f32x4 (&acc)[2][2][4][2], const Unit& u, int wr, int wc, int fr, int fq) const {
        const int row0 = u.pm * BM + wr * 64 + fr, col0 = u.pn * BM + wc * 32 + 8 * fq;
#pragma unroll
        for (int ai = 0; ai < 2; ++ai)
#pragma unroll
            for (int m = 0; m < 4; ++m) { const size_t off = (size_t)(row0 + ai * HALF + m * 16) * 1024 + col0;
#pragma unroll
                for (int bj = 0; bj < 2; ++bj) { const u32x4 xr = *(const u32x4*)(xb + off + bj * HALF); const unsigned x0 = xr[0], x1 = xr[1], x2 = xr[2], x3 = xr[3];
                    const f32x4 xa = (f32x4){__builtin_bit_cast(float, x0 << 16), __builtin_bit_cast(float, x0 & 0xffff0000u), __builtin_bit_cast(float, x1 << 16), __builtin_bit_cast(float, x1 & 0xffff0000u)};
                    const f32x4 xc = (f32x4){__builtin_bit_cast(float, x2 << 16), __builtin_bit_cast(float, x2 & 0xffff0000u), __builtin_bit_cast(float, x3 << 16), __builtin_bit_cast(float, x3 & 0xffff0000u)};
                    const f32x4 v0 = acc[ai][bj][m][0] + xa * alpha, v1 = acc[ai][bj][m][1] + xc * alpha;
                    u32x4 w; w.x = cvt_pk_bf16(v0[0], v0[1]); w.y = cvt_pk_bf16(v0[2], v0[3]); w.z = cvt_pk_bf16(v1[0], v1[1]); w.w = cvt_pk_bf16(v1[2], v1[3]);
                    *(u32x4*)(C + off + bj * HALF) = w; } }
    }
};

struct EpiFinal {
    static constexpr bool PERM = false, AFTER_DRAIN = false;
    const bf16_t* X2B; const bf16_t* PLE; const float* gb; float *yp, *ys; float* ZD;
    __device__ __forceinline__ void operator()(const f32x4 (&acc)[2][2][4][2], const Unit& u, int wr, int wc, int fr, int fq) const {
        const int row0 = u.pm * BM + wr * 64 + fr, col0 = u.pn * BM + wc * 32 + 4 * fq;
        float* yb = (u.pm == 64) ? (ys - (size_t)16384 * 1024) : yp;
        f32x4 bv[2][2];
#pragma unroll
        for (int bj = 0; bj < 2; ++bj)
#pragma unroll
            for (int n = 0; n < 2; ++n) bv[bj][n] = *(const f32x4*)(gb + col0 + bj * HALF + n * 16);
#pragma unroll
        for (int ai = 0; ai < 2; ++ai)
#pragma unroll
            for (int m = 0; m < 4; ++m) { const size_t off = (size_t)(row0 + ai * HALF + m * 16) * 1024 + col0;
#pragma unroll
                for (int bj = 0; bj < 2; ++bj)
#pragma unroll
                    for (int n = 0; n < 2; ++n) {
                        const u32x2 xr = *(const u32x2*)(X2B + off + bj * HALF + n * 16); const unsigned xr0 = xr[0], xr1 = xr[1];
                        const f32x4 x2 = (f32x4){__builtin_bit_cast(float, xr0 << 16), __builtin_bit_cast(float, xr0 & 0xffff0000u), __builtin_bit_cast(float, xr1 << 16), __builtin_bit_cast(float, xr1 & 0xffff0000u)};
                        const u32x2 pr = *(const u32x2*)(PLE + off + bj * HALF + n * 16);
                        const unsigned p0 = pr[0], p1 = pr[1];
                        const f32x4 pl = (f32x4){__builtin_bit_cast(float, p0 << 16), __builtin_bit_cast(float, p0 & 0xffff0000u), __builtin_bit_cast(float, p1 << 16), __builtin_bit_cast(float, p1 & 0xffff0000u)};
                        const f32x4 z = acc[ai][bj][m][n] + bv[bj][n]; f32x4 o;
#pragma unroll
                        for (int e = 0; e < 4; ++e) { const float s = __builtin_amdgcn_rcpf(1.0f + __builtin_amdgcn_exp2f(-1.4426950408889634f * z[e])); o[e] = x2[e] + s * pl[e]; }
                        *(f32x4*)(yb + off + bj * HALF + n * 16) = o;
                    } }
    }
};

template <class Epi, class Sched, bool ALIGN_EPI = false, bool SP2 = false>
__device__ __forceinline__ void gemm_phase(PG8_LAS unsigned char* lds, const Gemm g, const Sched& S, const Epi& E) {
    int tid_ = threadIdx.x; asm volatile("" : "+v"(tid_)); const int tid = tid_, wid = __builtin_amdgcn_readfirstlane(tid >> 6), lane = tid & 63, wr = wid >> 2, wc = wid & 3, fr = lane & 15, fq = lane >> 4;
    const int K = g.K, nt = K / BK;
    unsigned voffA[2], voffB[2];
#pragma unroll
    for (int i = 0; i < 2; ++i) { int R, C; stage_rc(tid * 16 + i * 8192, R, C); const int Rb = Epi::PERM ? ((R & ~31) + perm32(R & 31)) : R;
        voffA[i] = (unsigned)(R * K + C) * 2u; voffB[i] = (unsigned)(Rb * K + C) * 2u; }
    const size_t kstep = (size_t)(BK * 2);
    const size_t hstep = (size_t)HALF * K * 2;
    const size_t tstep = 2 * hstep;
    const unsigned ldsw = (unsigned)wid * 1024u;
    const int aoff = lds_byte(wr * 64 + fr, fq * 8), boff = lds_byte(wc * 32 + fr, fq * 8);
#define PG8_SA(b, h) (((b) * 2 + (h)) * HTB)
#define PG8_SB(b, h) ((4 + (b) * 2 + (h)) * HTB)
#define PG8_STAGE(bufoff, gbase, voff) do { _Pragma("unroll") for (int _i = 0; _i < 2; ++_i) \
        __builtin_amdgcn_global_load_lds((const unsigned*)((const char*)(gbase) + (voff)[_i]), (PG8_LAS unsigned*)(lds + (bufoff) + ldsw + _i * 8192), 16, 0, 0); } while (0)
#define PG8_LDA(dst, b, h) do { _Pragma("unroll") for (int m = 0; m < 4; ++m) _Pragma("unroll") for (int k = 0; k < 2; ++k) dst[m][k] = *(const PG8_LAS bf16x8*)(lds + PG8_SA(b, h) + aoff + m * 2048 + k * 1024); } while (0)
#define PG8_LDB(dst, b, h) do { _Pragma("unroll") for (int n = 0; n < 2; ++n) _Pragma("unroll") for (int k = 0; k < 2; ++k) dst[n][k] = *(const PG8_LAS bf16x8*)(lds + PG8_SB(b, h) + boff + n * 2048 + k * 1024); } while (0)
#define PG8_MMA(ai, bj, At, Bt) do { __builtin_amdgcn_s_setprio(1); _Pragma("unroll") for (int m = 0; m < 4; ++m) _Pragma("unroll") for (int n = 0; n < 2; ++n) _Pragma("unroll") for (int k = 0; k < 2; ++k) \
        acc[ai][bj][m][n] = __builtin_amdgcn_mfma_f32_16x16x32_bf16(Bt[n][k], At[m][k], acc[ai][bj][m][n], 0, 0, 0); __builtin_amdgcn_s_setprio(0); } while (0)
#define PG8_WAIT_V(n) asm volatile("s_waitcnt vmcnt(" #n ")" ::: "memory")
#define PG8_WAIT_L(n) asm volatile("s_waitcnt lgkmcnt(" #n ")" ::: "memory")
#define PG8_BAR __builtin_amdgcn_s_barrier()
#define PG8_SCHED __builtin_amdgcn_sched_barrier(0)
    Unit cur, nxt; int ui = 0;
    if (!S.next(0, cur)) return;
    f32x4 acc[2][2][4][2];
#pragma unroll
    for (int a = 0; a < 2; ++a)
#pragma unroll
        for (int b = 0; b < 2; ++b)
#pragma unroll
            for (int m = 0; m < 4; ++m)
#pragma unroll
                for (int n = 0; n < 2; ++n) acc[a][b][m][n] = (f32x4){0.f, 0.f, 0.f, 0.f};
    bf16x8 At[4][2], B0[2][2], B1[2][2];
    const char* cA = (const char*)g.A + (size_t)cur.pm * tstep; const char* cB = (const char*)g.Bt + (size_t)cur.pn * tstep;
    S.a_ready(cur);
    if constexpr (SP2) {
        PG8_STAGE(PG8_SB(0, 0), cB, voffB); PG8_STAGE(PG8_SB(0, 1), cB + hstep, voffB); PG8_STAGE(PG8_SA(0, 0), cA, voffA); PG8_STAGE(PG8_SA(0, 1), cA + hstep, voffA);
        if (wr == 1) PG8_BAR;
        PG8_WAIT_V(2); PG8_BAR;
        PG8_STAGE(PG8_SB(1, 0), cB + kstep, voffB); PG8_STAGE(PG8_SA(1, 0), cA + kstep, voffA); PG8_STAGE(PG8_SB(1, 1), cB + hstep + kstep, voffB);
        PG8_WAIT_V(6); PG8_BAR;
    } else {
        PG8_STAGE(PG8_SB(0, 0), cB, voffB); PG8_STAGE(PG8_SA(0, 0), cA, voffA); PG8_STAGE(PG8_SB(0, 1), cB + hstep, voffB); PG8_STAGE(PG8_SA(0, 1), cA + hstep, voffA);
        if (wr == 1) PG8_BAR;
        PG8_WAIT_V(4); PG8_BAR;
        PG8_STAGE(PG8_SB(1, 0), cB + kstep, voffB); PG8_STAGE(PG8_SA(1, 0), cA + kstep, voffA); PG8_STAGE(PG8_SB(1, 1), cB + hstep + kstep, voffB);
        PG8_WAIT_V(6); PG8_BAR;
    }
    for (;;) {
        const bool has_next = S.next(ui + 1, nxt);
        const char* nA = has_next ? (const char*)g.A + (size_t)nxt.pm * tstep : cA; const char* nB = has_next ? (const char*)g.Bt + (size_t)nxt.pn * tstep : cB;
        for (int t = 0; t < nt; t += 2) {
            const bool last = (t == nt - 2);
            const char* a1 = cA + (size_t)(t + 1) * kstep;
            const char* a2 = last ? nA : cA + (size_t)(t + 2) * kstep; const char* b2 = last ? nB : cB + (size_t)(t + 2) * kstep;
            const char* a3 = a2 + kstep; const char* b3 = b2 + kstep;
            if (last && has_next) S.a_ready(nxt);
            if constexpr (SP2) {
            PG8_LDB(B0, 0, 0); PG8_LDB(B1, 0, 1); PG8_SCHED; PG8_LDA(At, 0, 0); PG8_STAGE(PG8_SA(1, 1), a1 + hstep, voffA);
            PG8_WAIT_V(8); PG8_WAIT_L(0); PG8_BAR; PG8_MMA(0, 0, At, B0); PG8_MMA(0, 1, At, B1); PG8_BAR; PG8_SCHED;
            PG8_LDA(At, 0, 1); PG8_STAGE(PG8_SB(0, 0), b2, voffB); PG8_STAGE(PG8_SB(0, 1), b2 + hstep, voffB); PG8_STAGE(PG8_SA(0, 0), a2, voffA);
            PG8_WAIT_V(8); PG8_WAIT_L(0); PG8_BAR; PG8_MMA(1, 0, At, B0); PG8_MMA(1, 1, At, B1); PG8_BAR; PG8_SCHED;
            PG8_LDB(B0, 1, 0); PG8_LDB(B1, 1, 1); PG8_SCHED; PG8_LDA(At, 1, 0); PG8_STAGE(PG8_SA(0, 1), a2 + hstep, voffA);
            PG8_WAIT_V(8); PG8_WAIT_L(0); PG8_BAR; PG8_MMA(0, 0, At, B0); PG8_MMA(0, 1, At, B1); PG8_BAR; PG8_SCHED;
            PG8_LDA(At, 1, 1); PG8_STAGE(PG8_SB(1, 0), b3, voffB); PG8_STAGE(PG8_SB(1, 1), b3 + hstep, voffB); PG8_STAGE(PG8_SA(1, 0), a3, voffA);
            PG8_WAIT_V(8); PG8_WAIT_L(0); PG8_BAR; PG8_MMA(1, 0, At, B0); PG8_MMA(1, 1, At, B1); PG8_BAR; PG8_SCHED;
            } else {
            PG8_LDB(B0, 0, 0); PG8_SCHED; PG8_LDA(At, 0, 0); PG8_STAGE(PG8_SA(1, 1), a1 + hstep, voffA);
            PG8_WAIT_L(8); PG8_BAR; PG8_WAIT_L(0); PG8_MMA(0, 0, At, B0); PG8_BAR; PG8_SCHED;
            PG8_LDB(B1, 0, 1); PG8_STAGE(PG8_SB(0, 0), b2, voffB);
            PG8_BAR; PG8_WAIT_L(0); PG8_MMA(0, 1, At, B1); PG8_BAR;
            PG8_LDA(At, 0, 1); PG8_STAGE(PG8_SA(0, 0), a2, voffA);
            PG8_BAR; PG8_WAIT_L(0); PG8_MMA(1, 0, At, B0); PG8_BAR; PG8_SCHED;
            PG8_STAGE(PG8_SB(0, 1), b2 + hstep, voffB);
            PG8_WAIT_V(6); PG8_BAR; PG8_MMA(1, 1, At, B1); PG8_BAR;
            PG8_LDB(B0, 1, 0); PG8_SCHED; PG8_LDA(At, 1, 0); PG8_STAGE(PG8_SA(0, 1), a2 + hstep, voffA);
            PG8_WAIT_L(8); PG8_BAR; PG8_WAIT_L(0); PG8_MMA(0, 0, At, B0); PG8_BAR; PG8_SCHED;
            PG8_LDB(B1, 1, 1); PG8_STAGE(PG8_SB(1, 0), b3, voffB);
            PG8_BAR; PG8_WAIT_L(0); PG8_MMA(0, 1, At, B1); PG8_BAR;
            PG8_LDA(At, 1, 1); PG8_STAGE(PG8_SA(1, 0), a3, voffA);
            PG8_BAR; PG8_WAIT_L(0); PG8_MMA(1, 0, At, B0); PG8_BAR; PG8_SCHED;
            PG8_STAGE(PG8_SB(1, 1), b3 + hstep, voffB);
            PG8_WAIT_V(6); PG8_BAR; PG8_MMA(1, 1, At, B1); PG8_BAR;
            }
        }
        if constexpr (ALIGN_EPI) { if (wr == 0) PG8_BAR; }
        if constexpr (!Epi::AFTER_DRAIN) { E(acc, cur, wr, wc, fr, fq); S.done(cur); }
        if (!has_next) break;
#pragma unroll
        for (int a = 0; a < 2; ++a)
#pragma unroll
            for (int b = 0; b < 2; ++b)
#pragma unroll
                for (int m = 0; m < 4; ++m)
#pragma unroll
                    for (int n = 0; n < 2; ++n) acc[a][b][m][n] = (f32x4){0.f, 0.f, 0.f, 0.f};
        cur = nxt; cA = nA; cB = nB; ++ui;
        if constexpr (ALIGN_EPI) { if (wr == 1) PG8_BAR; }
    }
    PG8_WAIT_V(0);
    if constexpr (!ALIGN_EPI) { if (wr == 0) PG8_BAR; }
    PG8_BAR;
    if constexpr (Epi::AFTER_DRAIN) { E.fused(acc, cur, wr, wc, fr, fq, lds, wid, lane); S.done(cur); }
#undef PG8_SA
#undef PG8_SB
#undef PG8_STAGE
#undef PG8_LDA
#undef PG8_LDB
#undef PG8_MMA
#undef PG8_WAIT_V
#undef PG8_WAIT_L
#undef PG8_BAR
#undef PG8_SCHED
}
}
constexpr int NWAVES = 8;
constexpr int D = 1024, NBP = 8, SEQ = 2048, MP = NBP * SEQ, NBS = 32, TS = 8, MS = NBS * TS, M = MP + MS;
constexpr int PAST = 8192, PAGE = 128, NPAGES = PAST / PAGE, NPOOL = 2560;
constexpr int INW = 2560, NEXP = 16384;
constexpr float LN_EPS = 1e-5f;
constexpr float ALPHA = 1.189207115002721f;
constexpr float LAM_INIT = 0.2f;
constexpr size_t O_YP = 0, O_YS = O_YP + (size_t)MP * D, O_KP = O_YS + (size_t)MS * D, O_VP = O_KP + (size_t)MP * 512, O_HP = O_VP + (size_t)MP * 512,
                 O_CP = O_HP + (size_t)NBP * 512, O_KS = O_CP + (size_t)NBP * 3 * 512, O_VS = O_KS + (size_t)MS * 512, O_HS = O_VS + (size_t)MS * 512, O_CS = O_HS + (size_t)NBS * 512,
                 O_END = O_CS + (size_t)NBS * 3 * 512;
constexpr size_t MiB = 1u << 20;
constexpr size_t WS_CTL = 0, CTL_ZERO_BYTES = 1 * MiB;
constexpr size_t WS_WIN_T = 2 * MiB, WS_WOUT_T = 8 * MiB, WS_WQ_T = 10 * MiB, WS_WG_T = 14 * MiB, WS_WPLE_T = 16 * MiB, WS_KEYS = 17 * MiB, WS_WAT = 18 * MiB, WS_WXT = 18 * MiB + 65536;
constexpr size_t WS_U = 32 * MiB, WS_V = 64 * MiB, WS_XB = 96 * MiB, WS_PE = 130 * MiB, WS_Q = 140 * MiB, WS_KB = 158 * MiB, WS_VB = 176 * MiB, WS_XR = 194 * MiB, WS_GT = 212 * MiB;
constexpr size_t WS_MIX = 230 * MiB, WS_PLE = 264 * MiB, WS_PRE1 = 298 * MiB, WS_X1 = 364 * MiB, WS_X1B = 430 * MiB, WS_PQ = 464 * MiB, WS_EIDX = 530 * MiB, WS_GW = 540 * MiB;
constexpr size_t WS_X2 = 550 * MiB, WS_X2B = 616 * MiB, WS_SPART = 650 * MiB, WS_SSTAT = 659 * MiB, WS_RGC = 660 * MiB, WS_W = 662 * MiB, WS_FFN = 672 * MiB, WS_PART = 740 * MiB, WS_X1Q = 810 * MiB, WS_SX = 828 * MiB, WS_USC = 829 * MiB, WS_VSC = 830 * MiB, WS_SW = 831 * MiB, WS_EIDXP = 832 * MiB, WS_WQ = 842 * MiB, WS_END = 846 * MiB;
constexpr int CW_TMO = 0, CW_CODE = 1, CW_CONV = 64, CW_BAR = 4096;
constexpr int RING_OFF = 0, RING_BYTES = 131072;
constexpr int LDSCTL_OFF = RING_BYTES, MISC_OFF = LDSCTL_OFF + 320;
constexpr int LDS_BYTES = 147456;
#define GAS __attribute__((address_space(1)))
#define LAS __attribute__((address_space(3)))
typedef unsigned short bf16;
typedef unsigned v4u __attribute__((ext_vector_type(4)));
typedef float f32x4 __attribute__((ext_vector_type(4)));
typedef short bf16x8 __attribute__((ext_vector_type(8)));
typedef GAS unsigned gu32;
typedef GAS unsigned long long gu64;
#define RLX_AGENT __ATOMIC_RELAXED, __HIP_MEMORY_SCOPE_AGENT
#define LDS_WAIT() asm volatile("s_waitcnt lgkmcnt(0)" ::: "memory")
#define VM_WAIT() asm volatile("s_waitcnt vmcnt(0)" ::: "memory")
__device__ __forceinline__ unsigned f2bf(float f) { unsigned u = __builtin_bit_cast(unsigned, f); return (u + 0x7fffu + ((u >> 16) & 1u)) >> 16; }
__device__ __forceinline__ unsigned pk2(float lo, float hi) { return f2bf(lo) | (f2bf(hi) << 16); }

#define XB_TMO      128
#define XB_XCNT(j)  (256  + 64 * (j))
#define XB_XSUB(j)  (1280 + 64 * (j))
#define XB_XGEN(j)  (2304 + 64 * (j))
#define XB_TOP      3328
#define XB_TOPGEN   3392
#define XCD_BAR_WORDS 3456
#define XB_SPIN_CAP (1u << 18)

__device__ __forceinline__ unsigned xb_ld(unsigned* p)              { return __hip_atomic_load(p, __ATOMIC_RELAXED, __HIP_MEMORY_SCOPE_AGENT); }
__device__ __forceinline__ unsigned xb_add(unsigned* p, unsigned v) { return __hip_atomic_fetch_add(p, v, __ATOMIC_RELAXED, __HIP_MEMORY_SCOPE_AGENT); }
__device__ __forceinline__ unsigned xb_xcc_id() { return (unsigned)__builtin_amdgcn_s_getreg((3 << 11) | 20) & 0xFu; }
#define XB_SPIN(cond, bar) do { unsigned _sp = 0; while (cond) { __builtin_amdgcn_s_sleep(1); \
    if ((++_sp & 255u) == 0u) { if (xb_ld(&(bar)[XB_TMO])) break; if (_sp > XB_SPIN_CAP) { atomicAdd(&(bar)[XB_TMO], 1u); break; } } } } while (0)

struct XcdBarrier {
    unsigned* bar; unsigned x;
    volatile LAS unsigned* st;
};

__device__ __forceinline__ XcdBarrier xcd_barrier_post(unsigned* bar, volatile LAS unsigned* st) {
    XcdBarrier b; b.bar = bar; b.x = xb_xcc_id(); b.st = st;
    if (threadIdx.x == 0) (void)xb_add(&bar[XB_XCNT(b.x)], 1u);
    return b;
}
__device__ __forceinline__ void xcd_barrier_complete(unsigned* bar, unsigned x, unsigned& nloc, unsigned& nx) {
    const unsigned G = gridDim.x * gridDim.y * gridDim.z;
    unsigned sum, cnt, mine, sp = 0u;
    for (;;) {
        sum = 0u; cnt = 0u; mine = 0u;
#pragma unroll
        for (unsigned j = 0; j < 16; ++j) { const unsigned c = xb_ld(&bar[XB_XCNT(j)]); sum += c; cnt += (c > 0u) ? 1u : 0u; mine = (j == x) ? c : mine; }
        if (sum == G) break;
        __builtin_amdgcn_s_sleep(1);
        if ((++sp & 255u) == 0u) { if (xb_ld(&bar[XB_TMO])) break; if (sp > XB_SPIN_CAP) { atomicAdd(&bar[XB_TMO], 1u); break; } }
    }
    nloc = mine > 0u ? mine : 1u; nx = cnt > 0u ? cnt : 1u;
}

__device__ __forceinline__ void xcd_barrier(const XcdBarrier& b) {
    asm volatile("s_waitcnt vmcnt(0)" ::: "memory");
    __syncthreads();
    if (threadIdx.x == 0) {
        unsigned* bar = b.bar;
        __builtin_amdgcn_s_waitcnt(0);
        unsigned nloc = b.st[0], nx = b.st[1];
        if (nloc == 0u) { xcd_barrier_complete(bar, b.x, nloc, nx); b.st[0] = nloc; b.st[1] = nx; }
        const unsigned old = xb_add(&bar[XB_XSUB(b.x)], 1u);
        const unsigned gen = old / nloc;
        if (old + 1u == (gen + 1u) * nloc) {
            __builtin_amdgcn_fence(__ATOMIC_RELEASE, "agent");
            asm volatile("s_waitcnt vmcnt(0)" ::: "memory");
            const unsigned og = xb_add(&bar[XB_TOP], 1u);
            const unsigned tg = og / nx;
            if (og + 1u == (tg + 1u) * nx) xb_add(&bar[XB_TOPGEN], 1u);
            else XB_SPIN(xb_ld(&bar[XB_TOPGEN]) == tg, bar);
            __builtin_amdgcn_fence(__ATOMIC_ACQUIRE, "agent");
            xb_add(&bar[XB_XGEN(b.x)], 1u);
            asm volatile("s_waitcnt vmcnt(0)" ::: "memory");
        } else {
            XB_SPIN(xb_ld(&bar[XB_XGEN(b.x)]) == gen, bar);
            __builtin_amdgcn_fence(__ATOMIC_ACQUIRE, "agent");
            asm volatile("s_waitcnt vmcnt(0)" ::: "memory");
        }
    }
    __syncthreads();
}
struct Frame {
    LAS unsigned char* lds;
    volatile LAS unsigned* MISC;
    gu32* ctl;
    int tid, lane, wave;
    int vcu, G;
};
__device__ __forceinline__ float wave_sum(float v) {
#pragma unroll
    for (int o = 1; o < 64; o <<= 1) v += __shfl_xor(v, o);
    return v;
}
__device__ __forceinline__ float bf_lo(unsigned u) { return __builtin_bit_cast(float, u << 16); }
__device__ __forceinline__ float bf_hi(unsigned u) { return __builtin_bit_cast(float, u & 0xffff0000u); }
__device__ __forceinline__ void p0_transpose_item(const float* W, int K, int N, bf16* WT, LAS float* scr, int item, int lane, float sc = 1.0f) {
    const int nblk = N / 32, kb = item / nblk, nb = item % nblk, k0 = 64 * kb, n0 = 32 * nb;
#pragma unroll 8
    for (int i = 0; i < 32; ++i) { const int kk = 2 * i + (lane >> 5); scr[kk * 33 + (lane & 31)] = W[(size_t)(k0 + kk) * N + n0 + (lane & 31)] * sc; }
    LDS_WAIT(); asm volatile("" ::: "memory");
    const int c = lane & 7;
#pragma unroll
    for (int j = 0; j < 4; ++j) { const int n = (lane >> 3) + 8 * j; const LAS float* s = scr + (8 * c) * 33 + n;
        v4u o; o.x = pk2(s[0 * 33], s[1 * 33]); o.y = pk2(s[2 * 33], s[3 * 33]); o.z = pk2(s[4 * 33], s[5 * 33]); o.w = pk2(s[6 * 33], s[7 * 33]);
        *(GAS v4u*)(WT + (size_t)(n0 + n) * K + k0 + 8 * c) = o; }
    LDS_WAIT(); asm volatile("" ::: "memory");
}
__device__ __forceinline__ void p0_convert(const float* src, bf16* dst, size_t n, int gw, int NGW, int lane) {
    typedef unsigned u32x2c __attribute__((ext_vector_type(2)));
    const size_t np = n / 512;
    for (size_t p0 = gw; p0 < np; p0 += (size_t)4 * NGW) {
        f32x4 a[4], b[4];
#pragma unroll
        for (int q = 0; q < 4; ++q) { const size_t p = p0 + (size_t)q * NGW; const size_t pc = p < np ? p : p0; const GAS f32x4* s = (const GAS f32x4*)(src + pc * 512); a[q] = s[lane]; b[q] = s[64 + lane]; }
#pragma unroll
        for (int q = 0; q < 4; ++q) { const size_t p = p0 + (size_t)q * NGW; if (p < np) {
            u32x2c oa, ob; oa.x = pk2(a[q].x, a[q].y); oa.y = pk2(a[q].z, a[q].w); ob.x = pk2(b[q].x, b[q].y); ob.y = pk2(b[q].z, b[q].w);
            ((GAS u32x2c*)(dst + p * 512))[lane] = oa; ((GAS u32x2c*)(dst + p * 512))[64 + lane] = ob; } }
    }
}
template <bool SLICED>
__device__ __forceinline__ void p0_convert_fp8(const float* src, unsigned char* dst, size_t n, float scale, int gw, int NGW, int lane) {
    const size_t np = n / 1024;
    for (size_t p = gw; p < np; p += NGW) {
        const GAS f32x4* s = (const GAS f32x4*)(src + p * 1024) + lane * 4;
        unsigned w[4];
#pragma unroll
        for (int k = 0; k < 4; ++k) { const f32x4 a = s[k];
            const float c0 = fminf(fmaxf(a.x * scale, -448.f), 448.f), c1 = fminf(fmaxf(a.y * scale, -448.f), 448.f), c2 = fminf(fmaxf(a.z * scale, -448.f), 448.f), c3 = fminf(fmaxf(a.w * scale, -448.f), 448.f);
            int t = 0; t = __builtin_amdgcn_cvt_pk_fp8_f32(c0, c1, t, false); t = __builtin_amdgcn_cvt_pk_fp8_f32(c2, c3, t, true); w[k] = (unsigned)t; }
        if (SLICED) *(GAS v4u*)(dst + ((size_t)(lane >> 3) * NEXP + p) * 128 + (lane & 7) * 16) = (v4u){w[0], w[1], w[2], w[3]};
        else *((GAS v4u*)(dst + p * 1024) + lane) = (v4u){w[0], w[1], w[2], w[3]};
    }
}
__device__ __forceinline__ void convert_fp8_rows(const float* src, unsigned char* dst, int r0, int nr, float scale, int lane) {
    for (int p = r0; p < r0 + nr; ++p) {
        const GAS f32x4* s = (const GAS f32x4*)(src + (size_t)p * 1024) + lane * 4;
        unsigned w[4];
#pragma unroll
        for (int k = 0; k < 4; ++k) { const f32x4 a = __builtin_nontemporal_load(s + k);
            const float c0 = fminf(fmaxf(a.x * scale, -448.f), 448.f), c1 = fminf(fmaxf(a.y * scale, -448.f), 448.f), c2 = fminf(fmaxf(a.z * scale, -448.f), 448.f), c3 = fminf(fmaxf(a.w * scale, -448.f), 448.f);
            int t = 0; t = __builtin_amdgcn_cvt_pk_fp8_f32(c0, c1, t, false); t = __builtin_amdgcn_cvt_pk_fp8_f32(c2, c3, t, true); w[k] = (unsigned)t; }
        *(GAS v4u*)(dst + ((size_t)(lane >> 3) * NEXP + p) * 128 + (lane & 7) * 16) = (v4u){w[0], w[1], w[2], w[3]};
    }
}
struct CvRows { f32x4 a[4][4]; };
__device__ __forceinline__ void cv_load(CvRows& r, const float* src, int p0, int lane) {
#pragma unroll
    for (int q = 0; q < 4; ++q) { const GAS f32x4* s = (const GAS f32x4*)(src + (size_t)(p0 + q) * 1024) + lane;
#pragma unroll
        for (int k = 0; k < 4; ++k) r.a[q][k] = __builtin_nontemporal_load(s + 64 * k); }
}
__device__ __forceinline__ void cv_store(const CvRows& r, unsigned char* dst, float* scale, int p0, int lane) {
    float m[4];
#pragma unroll
    for (int q = 0; q < 4; ++q) { m[q] = 0.f;
#pragma unroll
        for (int k = 0; k < 4; ++k) m[q] = fmaxf(m[q], fmaxf(fmaxf(fabsf(r.a[q][k].x), fabsf(r.a[q][k].y)), fmaxf(fabsf(r.a[q][k].z), fabsf(r.a[q][k].w)))); }
#pragma unroll
    for (int o = 1; o < 64; o <<= 1) {
#pragma unroll
        for (int q = 0; q < 4; ++q) m[q] = fmaxf(m[q], __shfl_xor(m[q], o)); }
#pragma unroll
    for (int q = 0; q < 4; ++q) { const float inv = m[q] > 0.f ? 127.0f / m[q] : 0.f;
#pragma unroll
        for (int k = 0; k < 4; ++k) { const int q0 = (int)rintf(r.a[q][k].x * inv), q1 = (int)rintf(r.a[q][k].y * inv), q2 = (int)rintf(r.a[q][k].z * inv), q3 = (int)rintf(r.a[q][k].w * inv);
            const unsigned w = ((unsigned)q0 & 0xffu) | (((unsigned)q1 & 0xffu) << 8) | (((unsigned)q2 & 0xffu) << 16) | (((unsigned)q3 & 0xffu) << 24);
            *(GAS unsigned*)(dst + ((size_t)(2 * k + (lane >> 5)) * NEXP + (p0 + q)) * 128 + 4 * (lane & 31)) = w; }
        scale[p0 + q] = m[q] * (1.0f / 127.0f); }
}
__device__ __forceinline__ void convert_i8_rows8(const float* src, unsigned char* dst, float* scale, int r0, int lane) {
    CvRows A, B;
    cv_load(A, src, r0, lane);
    cv_load(B, src, r0 + 4, lane);
    cv_store(A, dst, scale, r0, lane);
    cv_store(B, dst, scale, r0 + 4, lane);
}
constexpr float RG_NLOG2E = -1.4426950408889634f;
struct Args { const void* in[34]; float* out; unsigned char* ws; };

__device__ __forceinline__ void p0_prologue(Frame& F, const Args& A, unsigned char* ws) {
    LAS float* scr = (LAS float*)(F.lds + RING_OFF + F.wave * 16384);
    const int gw = F.vcu * NWAVES + F.wave, NGW = F.G * NWAVES;
    constexpr int I_IN = (D / 64) * (INW / 32), I_OUT = (D / 64) * (D / 32), I_WQ = (D / 64) * (2048 / 32), I_G = I_OUT, I_PLE = (256 / 64) * (D / 32), I_RG = 16 * 2;
    constexpr int NITEMS = I_IN + I_OUT + I_WQ + I_G + I_PLE + I_RG;
    for (int it = gw; it < NITEMS; it += NGW) {
        int r = it;
        if (r < I_IN) { p0_transpose_item((const float*)A.in[9], D, INW, (bf16*)(ws + WS_WIN_T), scr, r, F.lane); continue; } r -= I_IN;
        if (r < I_OUT) { p0_transpose_item((const float*)A.in[22], D, D, (bf16*)(ws + WS_WOUT_T), scr, r, F.lane); continue; } r -= I_OUT;
        if (r < I_WQ) { p0_transpose_item((const float*)A.in[25], D, 2048, (bf16*)(ws + WS_WQ_T), scr, r, F.lane); continue; } r -= I_WQ;
        if (r < I_G) { p0_transpose_item((const float*)A.in[32], D, D, (bf16*)(ws + WS_WG_T), scr, r, F.lane); continue; } r -= I_G;
        if (r < I_PLE) { p0_transpose_item((const float*)A.in[31], 256, D, (bf16*)(ws + WS_WPLE_T), scr, r, F.lane); continue; } r -= I_PLE;
        { const int mat = r >> 4, blk = (r >> 1) & 7, sub = r & 1;
          p0_transpose_item((const float*)A.in[mat ? 19 : 17] + blk * 4096, 64, 64, (bf16*)(ws + (mat ? WS_WXT : WS_WAT)) + blk * 4096, scr, sub, F.lane, RG_NLOG2E); }
    }
    p0_convert((const float*)A.in[0], (bf16*)(ws + WS_XB), (size_t)MP * D, gw, NGW, F.lane);
    p0_convert((const float*)A.in[1], (bf16*)(ws + WS_XB) + (size_t)MP * D, (size_t)MS * D, gw, NGW, F.lane);
    p0_convert((const float*)A.in[2], (bf16*)(ws + WS_PE), (size_t)MP * 256, gw, NGW, F.lane);
    p0_convert((const float*)A.in[3], (bf16*)(ws + WS_PE) + (size_t)MP * 256, (size_t)MS * 256, gw, NGW, F.lane);
    p0_convert((const float*)A.in[26], (bf16*)(ws + WS_KEYS), (size_t)8 * 2 * 128 * 128, gw, NGW, F.lane);
}
typedef float f32x16 __attribute__((ext_vector_type(16)));
typedef float f32x2v_t __attribute__((ext_vector_type(2)));
typedef unsigned u32x4 __attribute__((ext_vector_type(4)));
typedef unsigned u32x2v_t __attribute__((ext_vector_type(2)));
typedef short s16x4 __attribute__((ext_vector_type(4)));
typedef short v4i16_t __attribute__((ext_vector_type(4)));
typedef __bf16 bf16x2_t __attribute__((ext_vector_type(2)));
__device__ __forceinline__ int crow(int r, int hi) { return (r & 3) + 8 * (r >> 2) + 4 * hi; }
__device__ __forceinline__ unsigned cvtpk(float lo, float hi) { f32x2v_t v = {lo, hi}; bf16x2_t b = __builtin_convertvector(v, bf16x2_t); return __builtin_bit_cast(unsigned, b); }
__device__ __forceinline__ s16x4 vtr(LAS const unsigned char* p) { return __builtin_bit_cast(s16x4, __builtin_amdgcn_ds_read_tr16_b64_v4i16((LAS v4i16_t*)p)); }
__device__ __forceinline__ float swap32_max(float v) { auto rr = __builtin_amdgcn_permlane32_swap(__float_as_uint(v), __float_as_uint(v), false, false); return fmaxf(__uint_as_float(rr[0]), __uint_as_float(rr[1])); }
__device__ __forceinline__ float swap32_sum(float v) { auto rr = __builtin_amdgcn_permlane32_swap(__float_as_uint(v), __float_as_uint(v), false, false); return __uint_as_float(rr[0]) + __uint_as_float(rr[1]); }

constexpr int PA_RSK = 272, PA_RSV = 320, PA_KB = 64 * PA_RSK, PA_VB = 64 * PA_RSV, PA_BUF = PA_KB + PA_VB;
constexpr int PA_RSC = 528;

__device__ __forceinline__ void pattn_unit(Frame& F, int b, int h, int qb, const bf16* Q, const bf16* KB, const bf16* VB, bf16* MIX, float lam, const float* subln) {
    const int tid = F.tid, lane = F.lane, r32 = lane & 31, hi = lane >> 5, wid = F.wave, mp = wid >> 2, w4 = wid & 3;
    LAS unsigned char* L = F.lds + RING_OFF;
    const size_t rowbase = (size_t)b * SEQ;
    const int q0 = qb * 128 + w4 * 32;
    bf16x8 qf[4];
    { const bf16* qp = Q + (rowbase + q0 + r32) * 512 + h * 128 + mp * 64 + hi * 8;
#pragma unroll
      for (int ks = 0; ks < 4; ++ks) qf[ks] = *(const GAS bf16x8*)(qp + ks * 16); }
    const int sk0 = tid >> 4, sc = tid & 15;
    const bf16* kg = KB + (rowbase + sk0) * 512 + h * 128 + sc * 8;
    const bf16* vg = VB + (rowbase + sk0) * 512 + h * 128 + sc * 8;
    const int kl0 = sk0 * PA_RSK + sc * 16, vl0 = PA_KB + sk0 * PA_RSV + sc * 16;
    const int NT = 2 * qb + 2;
    v4u sK0, sK1, sV0, sV1;
#define PA_LOAD(t) do { const size_t o_ = (size_t)(t) * 64 * 512; sK0 = *(const GAS v4u*)(kg + o_); sK1 = *(const GAS v4u*)(kg + o_ + 32 * 512); sV0 = *(const GAS v4u*)(vg + o_); sV1 = *(const GAS v4u*)(vg + o_ + 32 * 512); } while (0)
#define PA_STORE(buf) do { LAS unsigned char* B_ = L + (buf) * PA_BUF; *(LAS v4u*)(B_ + kl0) = sK0; *(LAS v4u*)(B_ + kl0 + 32 * PA_RSK) = sK1; *(LAS v4u*)(B_ + vl0) = sV0; *(LAS v4u*)(B_ + vl0 + 32 * PA_RSV) = sV1; } while (0)
    PA_LOAD(0); PA_STORE(0);
    __syncthreads();
    f32x16 o[4];
#pragma unroll
    for (int i = 0; i < 4; ++i) o[i] = f32x16{};
    float mrun = -INFINITY, lrun = 0.f;
    const int vtr0 = PA_KB + (4 * hi + ((lane & 15) >> 2)) * PA_RSV + (16 * ((lane >> 4) & 1) + 4 * (lane & 3)) * 2;
    const int kfr0 = r32 * PA_RSK + (mp * 64 + hi * 8) * 2;
    for (int t = 0; t < NT; ++t) {
        if (t + 1 < NT) PA_LOAD(t + 1);
        LAS unsigned char* Bc = L + (t & 1) * PA_BUF;
        f32x16 s0 = f32x16{}, s1 = f32x16{};
#pragma unroll
        for (int ks = 0; ks < 4; ++ks) {
            const bf16x8 k0 = *(const LAS bf16x8*)(Bc + kfr0 + ks * 32);
            const bf16x8 k1 = *(const LAS bf16x8*)(Bc + kfr0 + 32 * PA_RSK + ks * 32);
            s0 = __builtin_amdgcn_mfma_f32_32x32x16_bf16(k0, qf[ks], s0, 0, 0, 0);
            s1 = __builtin_amdgcn_mfma_f32_32x32x16_bf16(k1, qf[ks], s1, 0, 0, 0);
        }
        if (t >= NT - 2) {
            const int qrel = q0 + r32 - t * 64;
#pragma unroll
            for (int r = 0; r < 16; ++r) { const int kv = crow(r, hi); if (kv > qrel) s0[r] = -INFINITY; if (kv + 32 > qrel) s1[r] = -INFINITY; }
        }
        s16x4 vA[4][2];
#pragma unroll
        for (int rb_ = 0; rb_ < 4; ++rb_) { vA[rb_][0] = vtr(Bc + vtr0 + rb_ * 64); vA[rb_][1] = vtr(Bc + vtr0 + 8 * PA_RSV + rb_ * 64); }
        float rm;
        asm("v_max3_f32 %0, %1, %2, %3" : "=v"(rm) : "v"(s0[0]), "v"(s1[0]), "v"(s0[1]));
#pragma unroll
        for (int r = 1; r < 16; ++r) { if (r < 15) asm("v_max3_f32 %0, %1, %2, %3" : "=v"(rm) : "v"(rm), "v"(s1[r]), "v"(s0[r + 1])); else asm("v_max_f32 %0, %1, %2" : "=v"(rm) : "v"(rm), "v"(s1[15])); }
        rm = swap32_max(rm);
        const float mnew = (rm > mrun + 8.0f) ? rm : mrun;
        const bool resc = __any(mnew != mrun);
        const float alpha = __builtin_amdgcn_exp2f(mrun - mnew);
        mrun = mnew;
#pragma unroll
        for (int r = 0; r < 16; ++r) { s0[r] = __builtin_amdgcn_exp2f(s0[r] - mnew); s1[r] = __builtin_amdgcn_exp2f(s1[r] - mnew); }
        f32x2v_t ps2 = (f32x2v_t){0.f, 0.f};
#pragma unroll
        for (int r = 0; r < 16; r += 2) { ps2 += (f32x2v_t){s0[r], s0[r + 1]}; ps2 += (f32x2v_t){s1[r], s1[r + 1]}; }
        const float ps = ps2.x + ps2.y;
        if (resc) {
            lrun *= alpha;
#pragma unroll
            for (int i = 0; i < 4; ++i)
#pragma unroll
                for (int r = 0; r < 16; ++r) o[i][r] *= alpha;
        }
        lrun += ps;
        u32x4 pf[4];
        pf[0] = (u32x4){cvtpk(s0[0], s0[1]), cvtpk(s0[2], s0[3]), cvtpk(s0[4], s0[5]), cvtpk(s0[6], s0[7])};
        pf[1] = (u32x4){cvtpk(s0[8], s0[9]), cvtpk(s0[10], s0[11]), cvtpk(s0[12], s0[13]), cvtpk(s0[14], s0[15])};
        pf[2] = (u32x4){cvtpk(s1[0], s1[1]), cvtpk(s1[2], s1[3]), cvtpk(s1[4], s1[5]), cvtpk(s1[6], s1[7])};
        pf[3] = (u32x4){cvtpk(s1[8], s1[9]), cvtpk(s1[10], s1[11]), cvtpk(s1[12], s1[13]), cvtpk(s1[14], s1[15])};
#define PA_VLD(dst, kk_) do { _Pragma("unroll") for (int rb_ = 0; rb_ < 4; ++rb_) { dst[rb_][0] = vtr(Bc + vtr0 + (16 * (kk_)) * PA_RSV + rb_ * 64); dst[rb_][1] = vtr(Bc + vtr0 + (16 * (kk_) + 8) * PA_RSV + rb_ * 64); } } while (0)
#define PA_VMM(src, kk_) do { _Pragma("unroll") for (int rb_ = 0; rb_ < 4; ++rb_) { const bf16x8 vf_ = (bf16x8){src[rb_][0][0], src[rb_][0][1], src[rb_][0][2], src[rb_][0][3], src[rb_][1][0], src[rb_][1][1], src[rb_][1][2], src[rb_][1][3]}; \
            o[rb_] = __builtin_amdgcn_mfma_f32_32x32x16_bf16(vf_, __builtin_bit_cast(bf16x8, pf[kk_]), o[rb_], 0, 0, 0); } } while (0)
        s16x4 vB[4][2];
        PA_VLD(vB, 1); __builtin_amdgcn_sched_barrier(0);
        PA_VMM(vA, 0); __builtin_amdgcn_sched_barrier(0);
        PA_VLD(vA, 2); __builtin_amdgcn_sched_barrier(0);
        PA_VMM(vB, 1); __builtin_amdgcn_sched_barrier(0);
        PA_VLD(vB, 3); __builtin_amdgcn_sched_barrier(0);
        PA_VMM(vA, 2); __builtin_amdgcn_sched_barrier(0);
        PA_VMM(vB, 3);
#undef PA_VLD
#undef PA_VMM
        if (t + 1 < NT) PA_STORE((t + 1) & 1);
        __syncthreads();
    }
#undef PA_LOAD
#undef PA_STORE
    const float ltot = swap32_sum(lrun);
    const float nsc = (mp == 1 ? lam : 1.0f) / ltot;
    LAS unsigned char* cb = L + (w4 * 32 + r32) * PA_RSC + hi * 16;
    if (mp == 1) {
#pragma unroll
        for (int rb = 0; rb < 4; ++rb)
#pragma unroll
            for (int g = 0; g < 4; ++g) *(LAS f32x4*)(cb + (32 * rb + 8 * g) * 4) = (f32x4){o[rb][4 * g] * nsc, o[rb][4 * g + 1] * nsc, o[rb][4 * g + 2] * nsc, o[rb][4 * g + 3] * nsc};
    }
    __syncthreads();
    if (mp == 0) {
        float ss = 0.f;
#pragma unroll
        for (int rb = 0; rb < 4; ++rb)
#pragma unroll
            for (int g = 0; g < 4; ++g) { const f32x4 o2 = *(const LAS f32x4*)(cb + (32 * rb + 8 * g) * 4);
#pragma unroll
                for (int e = 0; e < 4; ++e) { const float v = o[rb][4 * g + e] * nsc - o2[e]; o[rb][4 * g + e] = v; ss += v * v; } }
        ss = swap32_sum(ss);
        const float rs = (1.0f - LAM_INIT) / sqrtf(ss * (1.0f / 128.0f) + LN_EPS);
        bf16* orow = MIX + (rowbase + q0 + r32) * 1024 + h * 128 + 4 * hi;
#pragma unroll
        for (int rb = 0; rb < 4; ++rb)
#pragma unroll
            for (int g = 0; g < 4; ++g) { const f32x4 gg = *(const GAS f32x4*)(subln + 32 * rb + 8 * g + 4 * hi);
                f32x2v_t w; w.x = __builtin_bit_cast(float, cvtpk(o[rb][4 * g] * rs * gg[0], o[rb][4 * g + 1] * rs * gg[1])); w.y = __builtin_bit_cast(float, cvtpk(o[rb][4 * g + 2] * rs * gg[2], o[rb][4 * g + 3] * rs * gg[3]));
                *(GAS f32x2v_t*)(orow + 32 * rb + 8 * g) = w; }
    }
    __syncthreads();
}
typedef float f32x4v_t __attribute__((ext_vector_type(4)));
constexpr int SA_RS = 288, SA_IMG = 128 * SA_RS, SA_VOFF = SA_IMG;
__device__ __forceinline__ f32x4 ntload4(const float* p) { return __builtin_nontemporal_load((const f32x4*)p); }
__device__ __forceinline__ void sattn_item(Frame& F, int b, int sp, int slot, const float* CK, const float* CV, const int* PT, const bf16* Q, float* SPART, float* SSTAT) {
    const int tid = F.tid, lane = F.lane, wid = F.wave, head = wid & 3, z = wid >> 2, c16 = lane & 15, fq = lane >> 4;
    LAS unsigned char* L = F.lds + RING_OFF;
    bf16x8 qz[4];
    { const int map = c16 >> 3, t = c16 & 7; const bf16* qp = Q + (size_t)(MP + b * 8 + t) * 512 + head * 128 + fq * 8;
#pragma unroll
      for (int ks = 0; ks < 4; ++ks) qz[ks] = ((ks >> 1) == map) ? *(const GAS bf16x8*)(qp + ks * 32) : (bf16x8){0, 0, 0, 0, 0, 0, 0, 0}; }
    f32x4 o[4];
#pragma unroll
    for (int i = 0; i < 4; ++i) o[i] = (f32x4){0.f, 0.f, 0.f, 0.f};
    float mrun = -INFINITY, lrun = 0.f;
    f32x4 rkA[8], rvA[8], rkB[8], rvB[8];
    const int pgv = PT[b * NPAGES + sp * 8 + (lane & 7)];
    const int NCH = 32;
#define SA_LOAD(rk, rv, ci) do { const int pg_ = __builtin_amdgcn_readlane(pgv, (ci) >> 2); const size_t base_ = ((size_t)pg_ * PAGE + ((ci) & 3) * 32) * 512 + (size_t)tid * 4; \
        _Pragma("unroll") for (int i_ = 0; i_ < 8; ++i_) { rk[i_] = ntload4(CK + base_ + i_ * 2048); rv[i_] = ntload4(CV + base_ + i_ * 2048); } } while (0)
    const int st0 = (((tid >> 5) & 3) * 32 + (tid >> 7)) * SA_RS + (tid & 31) * 8;
    const int kfr = (head * 32 + c16) * SA_RS + fq * 16;
    const int vfr = SA_VOFF + (head * 32 + 4 * fq + (c16 >> 2)) * SA_RS + (64 * z + 4 * (c16 & 3)) * 2;
#define SA_STEP(rk, rv, ci) do { \
        _Pragma("unroll") for (int i = 0; i < 8; ++i) { \
            f32x2v_t wk, wv; wk.x = __builtin_bit_cast(float, cvtpk(rk[i][0], rk[i][1])); wk.y = __builtin_bit_cast(float, cvtpk(rk[i][2], rk[i][3])); \
            wv.x = __builtin_bit_cast(float, cvtpk(rv[i][0], rv[i][1])); wv.y = __builtin_bit_cast(float, cvtpk(rv[i][2], rv[i][3])); \
            *(LAS f32x2v_t*)(L + st0 + i * 4 * SA_RS) = wk; *(LAS f32x2v_t*)(L + SA_VOFF + st0 + i * 4 * SA_RS) = wv; } \
        __syncthreads(); \
        if ((ci) + 2 < NCH) SA_LOAD(rk, rv, (ci) + 2); \
        f32x4 s0 = (f32x4){0.f, 0.f, 0.f, 0.f}, s1 = s0; \
        _Pragma("unroll") for (int ks = 0; ks < 4; ++ks) { \
            const bf16x8 k0 = *(const LAS bf16x8*)(L + kfr + ks * 64); \
            const bf16x8 k1 = *(const LAS bf16x8*)(L + kfr + 16 * SA_RS + ks * 64); \
            s0 = __builtin_amdgcn_mfma_f32_16x16x32_bf16(k0, qz[ks], s0, 0, 0, 0); \
            s1 = __builtin_amdgcn_mfma_f32_16x16x32_bf16(k1, qz[ks], s1, 0, 0, 0); } \
        float rm = fmaxf(fmaxf(fmaxf(s0[0], s0[1]), fmaxf(s0[2], s0[3])), fmaxf(fmaxf(s1[0], s1[1]), fmaxf(s1[2], s1[3]))); \
        rm = fmaxf(rm, __shfl_xor(rm, 16)); rm = fmaxf(rm, __shfl_xor(rm, 32)); \
        const float mnew = fmaxf(mrun, rm); \
        const float alpha = __builtin_amdgcn_exp2f(mrun - mnew); \
        mrun = mnew; \
        float ps = 0.f; \
        _Pragma("unroll") for (int r = 0; r < 4; ++r) { s0[r] = __builtin_amdgcn_exp2f(s0[r] - mnew); s1[r] = __builtin_amdgcn_exp2f(s1[r] - mnew); ps += s0[r] + s1[r]; } \
        lrun = lrun * alpha + ps; \
        const u32x4 pf = (u32x4){cvtpk(s0[0], s0[1]), cvtpk(s0[2], s0[3]), cvtpk(s1[0], s1[1]), cvtpk(s1[2], s1[3])}; \
        _Pragma("unroll") for (int db = 0; db < 4; ++db) { \
            const s16x4 lo = vtr(L + vfr + db * 32); \
            const s16x4 hi4 = vtr(L + vfr + 16 * SA_RS + db * 32); \
            const bf16x8 vf = (bf16x8){lo[0], lo[1], lo[2], lo[3], hi4[0], hi4[1], hi4[2], hi4[3]}; \
            o[db] = o[db] * alpha; \
            o[db] = __builtin_amdgcn_mfma_f32_16x16x32_bf16(vf, __builtin_bit_cast(bf16x8, pf), o[db], 0, 0, 0); } \
        __syncthreads(); } while (0)
    SA_LOAD(rkA, rvA, 0); SA_LOAD(rkB, rvB, 1);
#pragma unroll 1
    for (int ci = 0; ci < NCH; ci += 2) { SA_STEP(rkA, rvA, ci); SA_STEP(rkB, rvB, ci + 1); }
#undef SA_LOAD
#undef SA_STEP
    float lt = lrun; lt += __shfl_xor(lt, 16); lt += __shfl_xor(lt, 32);
    float* po = SPART + (((size_t)slot * 4 + head) * 16 + c16) * 128 + 64 * z + 4 * fq;
#pragma unroll
    for (int db = 0; db < 4; ++db) *(GAS f32x4*)(po + 16 * db) = o[db];
    if (z == 0 && fq == 0) { float* st = SSTAT + (((size_t)slot * 4 + head) * 16 + c16) * 2; st[0] = mrun; st[1] = lt; }
}
constexpr int RG_XCS = 144, RG_RIS = 272, RG_XC = 0, RG_R = 16 * RG_XCS, RG_I = RG_R + 16 * RG_RIS, RG_WS = RG_I + 16 * RG_RIS;
constexpr int RG_SEG_OFF = 8 * RG_WS;
struct RgConst { float cw0, cw1, cw2, cw3, cb, kexp; };
struct RgW { bf16x8 wa[4][2], wx[4][2]; float ba[4], bx[4]; };

__device__ __forceinline__ float gelu_tanh(float x) { const float z = 0.7978845608028654f * (x + 0.044715f * x * x * x); return x * __builtin_amdgcn_rcpf(1.0f + __builtin_amdgcn_exp2f(-2.0f * 1.4426950408889634f * z)); }
__device__ __forceinline__ float sigmoidf_(float x) { return __builtin_amdgcn_rcpf(1.0f + __builtin_amdgcn_exp2f(-1.4426950408889634f * x)); }

__device__ __forceinline__ void rg_gates(LAS unsigned char* wl, int lane, const RgConst& C, const RgW& W, const float (&xh)[3], const float (&xs)[16], float (&a)[16], float (&u)[16]) {
    float xc[16];
#pragma unroll
    for (int t = 0; t < 16; ++t) {
        const float x3 = t >= 3 ? xs[t - 3] : xh[t], x2 = t >= 2 ? xs[t - 2] : xh[t + 1], x1 = t >= 1 ? xs[t - 1] : xh[t + 2];
        xc[t] = C.cb + C.cw0 * x3 + C.cw1 * x2 + C.cw2 * x1 + C.cw3 * xs[t];
        *(LAS unsigned short*)(wl + RG_XC + t * RG_XCS + lane * 2) = (unsigned short)f2bf(xc[t]);
    }
    LDS_WAIT(); asm volatile("" ::: "memory");
    const int c16 = lane & 15, fq = lane >> 4;
    bf16x8 af[2];
#pragma unroll
    for (int ks = 0; ks < 2; ++ks) af[ks] = *(const LAS bf16x8*)(wl + RG_XC + c16 * RG_XCS + (32 * ks + 8 * fq) * 2);
#pragma unroll
    for (int cb = 0; cb < 4; ++cb) {
        f32x4 ar = (f32x4){0.f, 0.f, 0.f, 0.f}, ai = ar;
#pragma unroll
        for (int ks = 0; ks < 2; ++ks) { ar = __builtin_amdgcn_mfma_f32_16x16x32_bf16(af[ks], W.wa[cb][ks], ar, 0, 0, 0); ai = __builtin_amdgcn_mfma_f32_16x16x32_bf16(af[ks], W.wx[cb][ks], ai, 0, 0, 0); }
#pragma unroll
        for (int r = 0; r < 4; ++r) {
            *(LAS float*)(wl + RG_R + (4 * fq + r) * RG_RIS + (16 * cb + c16) * 4) = __builtin_amdgcn_rcpf(1.0f + __builtin_amdgcn_exp2f(ar[r] + W.ba[cb]));
            *(LAS float*)(wl + RG_I + (4 * fq + r) * RG_RIS + (16 * cb + c16) * 4) = __builtin_amdgcn_rcpf(1.0f + __builtin_amdgcn_exp2f(ai[r] + W.bx[cb]));
        }
    }
    LDS_WAIT(); asm volatile("" ::: "memory");
#pragma unroll
    for (int t = 0; t < 16; ++t) {
        const float r = *(const LAS float*)(wl + RG_R + t * RG_RIS + lane * 4), i = *(const LAS float*)(wl + RG_I + t * RG_RIS + lane * 4);
        const float av = __builtin_amdgcn_exp2f(C.kexp * r);
        a[t] = av; u[t] = __builtin_amdgcn_sqrtf(1.0f - av * av) * (i * xc[t]);
    }
    LDS_WAIT(); asm volatile("" ::: "memory");
}
__device__ __forceinline__ void rg_load_consts(int n, int lane, const Args& A, const bf16* WAT, const bf16* WXT, RgConst& C, RgW& W) {
    const int ch = n * 64 + lane;
    const float* cw = (const float*)A.in[15];
    C.cw0 = cw[ch]; C.cw1 = cw[512 + ch]; C.cw2 = cw[1024 + ch]; C.cw3 = cw[1536 + ch]; C.cb = ((const float*)A.in[16])[ch];
    const float lam = ((const float*)A.in[21])[ch];
    C.kexp = -8.0f * log1pf(expf(-lam)) * 1.4426950408889634f;
    const int c16 = lane & 15, fq = lane >> 4;
#pragma unroll
    for (int cb = 0; cb < 4; ++cb) {
        const int d = 16 * cb + c16;
#pragma unroll
        for (int ks = 0; ks < 2; ++ks) { W.wa[cb][ks] = *(const GAS bf16x8*)(WAT + (size_t)n * 4096 + d * 64 + 32 * ks + 8 * fq); W.wx[cb][ks] = *(const GAS bf16x8*)(WXT + (size_t)n * 4096 + d * 64 + 32 * ks + 8 * fq); }
        W.ba[cb] = RG_NLOG2E * ((const float*)A.in[18])[n * 64 + d]; W.bx[cb] = RG_NLOG2E * ((const float*)A.in[20])[n * 64 + d];
    }
}
template <bool PASS1>
__device__ __forceinline__ void rg_prompt_unit(Frame& F, const Args& A, int b, int n, int q, const bf16* XR, const bf16* GT, const bf16* WAT, const bf16* WXT, bf16* MIX, float* hout, float* RGC) {
    const int lane = F.lane, seg = F.wave;
    LAS unsigned char* wl = F.lds + RING_OFF + seg * RG_WS;
    LAS float* SEG = (LAS float*)(F.lds + RING_OFF + RG_SEG_OFF);
    RgConst C; RgW W; rg_load_consts(n, lane, A, WAT, WXT, C, W);
    const int ch = n * 64 + lane;
    float carry = 0.f, Pu = 1.f;
    if (!PASS1) {
#pragma unroll
        for (int qq = 0; qq < 3; ++qq) if (qq < q) { const f32x2v_t ph = *(const GAS f32x2v_t*)(RGC + ((size_t)((b * 8 + n) * 4 + qq) * 64 + lane) * 2); carry = ph.x * carry + ph.y; }
    }
    float xh[3], xs[16], gt[16];
    v4u sx0, sx1, sh, sg0, sg1;
    const int prow = lane >> 3, pch = (lane & 7) * 8;
#define RG_LOADTILE(tile_) do { const int t0_ = q * 512 + (tile_) * 128 + seg * 16; const size_t r0_ = (size_t)b * SEQ + t0_; \
        sx0 = *(const GAS v4u*)(XR + (r0_ + prow) * 512 + n * 64 + pch); sx1 = *(const GAS v4u*)(XR + (r0_ + 8 + prow) * 512 + n * 64 + pch); \
        sh = (v4u){0u, 0u, 0u, 0u}; if (lane < 24 && t0_ - 3 + prow >= 0) sh = *(const GAS v4u*)(XR + (r0_ - 3 + prow) * 512 + n * 64 + pch); \
        if (!PASS1) { sg0 = *(const GAS v4u*)(GT + (r0_ + prow) * 512 + n * 64 + pch); sg1 = *(const GAS v4u*)(GT + (r0_ + 8 + prow) * 512 + n * 64 + pch); } } while (0)
#define RG_UNSTAGE() do { \
        *(LAS v4u*)(wl + RG_R + (3 + prow) * 128 + pch * 2) = sx0; *(LAS v4u*)(wl + RG_R + (11 + prow) * 128 + pch * 2) = sx1; if (lane < 24) *(LAS v4u*)(wl + RG_R + prow * 128 + pch * 2) = sh; \
        if (!PASS1) { *(LAS v4u*)(wl + RG_I + prow * 128 + pch * 2) = sg0; *(LAS v4u*)(wl + RG_I + (8 + prow) * 128 + pch * 2) = sg1; } \
        LDS_WAIT(); asm volatile("" ::: "memory"); \
        _Pragma("unroll") for (int j = 0; j < 3; ++j) xh[j] = bf_lo((unsigned)*(const LAS unsigned short*)(wl + RG_R + j * 128 + lane * 2)); \
        _Pragma("unroll") for (int t = 0; t < 16; ++t) { xs[t] = bf_lo((unsigned)*(const LAS unsigned short*)(wl + RG_R + (3 + t) * 128 + lane * 2)); \
            if (!PASS1) gt[t] = bf_lo((unsigned)*(const LAS unsigned short*)(wl + RG_I + t * 128 + lane * 2)); } \
        LDS_WAIT(); asm volatile("" ::: "memory"); } while (0)
    RG_LOADTILE(0);
#pragma unroll 1
    for (int tile = 0; tile < 4; ++tile) {
        const size_t r0 = (size_t)b * SEQ + q * 512 + tile * 128 + seg * 16;
        RG_UNSTAGE();
        if (tile < 3) RG_LOADTILE(tile + 1);
        float a[16], u[16];
        rg_gates(wl, lane, C, W, xh, xs, a, u);
        float P = 1.f, H = 0.f;
#pragma unroll
        for (int t = 0; t < 16; ++t) { H = a[t] * H + u[t]; P *= a[t]; }
        LAS float* sg = SEG + ((tile & 1) * 8) * 128;
        sg[seg * 128 + lane * 2] = P; sg[seg * 128 + lane * 2 + 1] = H;
        __syncthreads();
        float hin = carry;
#pragma unroll
        for (int s = 0; s < 8; ++s) { const float Ps = sg[s * 128 + lane * 2], Hs = sg[s * 128 + lane * 2 + 1]; if (s < seg) hin = Ps * hin + Hs; carry = Ps * carry + Hs; Pu *= Ps; }
        if (!PASS1) {
            float h = hin;
#pragma unroll
            for (int t = 0; t < 16; ++t) { h = a[t] * h + u[t]; *(LAS unsigned short*)(wl + RG_R + t * 128 + lane * 2) = (unsigned short)f2bf(h * gelu_tanh(gt[t])); }
            if (q == 3 && tile == 3 && seg == 7) hout[b * 512 + ch] = h;
            LDS_WAIT(); asm volatile("" ::: "memory");
            const v4u y0 = *(const LAS v4u*)(wl + RG_R + prow * 128 + pch * 2), y1 = *(const LAS v4u*)(wl + RG_R + (8 + prow) * 128 + pch * 2);
            *(GAS v4u*)(MIX + (r0 + prow) * 1024 + 512 + n * 64 + pch) = y0; *(GAS v4u*)(MIX + (r0 + 8 + prow) * 1024 + 512 + n * 64 + pch) = y1;
            LDS_WAIT(); asm volatile("" ::: "memory");
        }
    }
#undef RG_LOADTILE
#undef RG_UNSTAGE
    if (PASS1 && seg == 0) { f32x2v_t ph; ph.x = Pu; ph.y = carry; *(GAS f32x2v_t*)(RGC + ((size_t)((b * 8 + n) * 4 + q) * 64 + lane) * 2) = ph; }
    __syncthreads();
}
__device__ __forceinline__ void rg_sample_unit(Frame& F, const Args& A, int b, int n, const bf16* XR, const bf16* GT, const bf16* WAT, const bf16* WXT, bf16* MIX, float* hout) {
    const int lane = F.lane;
    LAS unsigned char* wl = F.lds + RING_OFF + F.wave * RG_WS;
    RgConst C; RgW W; rg_load_consts(n, lane, A, WAT, WXT, C, W);
    const int ch = n * 64 + lane;
    const size_t r0 = (size_t)MP + b * 8;
    float xh[3], xs[16], gt[8];
    const float* sc = (const float*)A.in[7];
#pragma unroll
    for (int j = 0; j < 3; ++j) xh[j] = sc[(size_t)(b * 3 + j) * 512 + ch];
#pragma unroll
    for (int t = 0; t < 8; ++t) { xs[t] = bf_lo((unsigned)XR[(r0 + t) * 512 + ch]); gt[t] = bf_lo((unsigned)GT[(r0 + t) * 512 + ch]); }
#pragma unroll
    for (int t = 8; t < 16; ++t) xs[t] = 0.f;
    float a[16], u[16];
    rg_gates(wl, lane, C, W, xh, xs, a, u);
    float h = ((const float*)A.in[6])[b * 512 + ch];
#pragma unroll
    for (int t = 0; t < 8; ++t) { h = a[t] * h + u[t]; MIX[(r0 + t) * 1024 + 512 + ch] = (bf16)f2bf(h * gelu_tanh(gt[t])); }
    hout[b * 512 + ch] = h;
}
__device__ __forceinline__ void scomb_unit(Frame& F, int b, int head, int t, const bf16* Q, const bf16* KB, const bf16* VB, const float* SPART, const float* SSTAT, bf16* MIX, float lam, const float* subln) {
    const int lane = F.lane;
    const size_t r0 = (size_t)MP + b * 8;
    float vn[8][2];
#pragma unroll
    for (int j = 0; j < 8; ++j) { const unsigned w = *(const GAS unsigned*)(VB + (r0 + j) * 512 + head * 128 + 2 * lane); vn[j][0] = bf_lo(w); vn[j][1] = bf_hi(w); }
    const f32x2v_t gg = *(const GAS f32x2v_t*)(subln + 2 * lane);
    float om[2][2];
#pragma unroll
    for (int map = 0; map < 2; ++map) {
        const int col = map * 8 + t;
        const float kq = bf_lo((unsigned)Q[(r0 + t) * 512 + head * 128 + map * 64 + lane]);
        float sn[8];
#pragma unroll
        for (int j = 0; j < 8; ++j) { const float kk = bf_lo((unsigned)KB[(r0 + j) * 512 + head * 128 + map * 64 + lane]); const float d = wave_sum(kq * kk); sn[j] = (j <= t) ? d : -INFINITY; }
        float ms[8], ls[8], mt = -INFINITY;
#pragma unroll
        for (int s = 0; s < 8; ++s) { const float* st = SSTAT + (((size_t)(b * 8 + s) * 4 + head) * 16 + col) * 2; ms[s] = st[0]; ls[s] = st[1]; mt = fmaxf(mt, ms[s]); }
#pragma unroll
        for (int j = 0; j < 8; ++j) mt = fmaxf(mt, sn[j]);
        float l = 0.f, o0 = 0.f, o1 = 0.f;
#pragma unroll
        for (int s = 0; s < 8; ++s) { const float w = __builtin_amdgcn_exp2f(ms[s] - mt); l += w * ls[s];
            const f32x2v_t pv = *(const GAS f32x2v_t*)(SPART + (((size_t)(b * 8 + s) * 4 + head) * 16 + col) * 128 + 2 * lane); o0 += w * pv.x; o1 += w * pv.y; }
#pragma unroll
        for (int j = 0; j < 8; ++j) { const float p = __builtin_amdgcn_exp2f(sn[j] - mt); l += p; o0 += p * vn[j][0]; o1 += p * vn[j][1]; }
        const float inv = 1.0f / l; om[map][0] = o0 * inv; om[map][1] = o1 * inv;
        asm volatile("" ::: "memory");
    }
    const float a0 = om[0][0] - lam * om[1][0], a1 = om[0][1] - lam * om[1][1];
    const float ss = wave_sum(a0 * a0 + a1 * a1);
    const float rs = (1.0f - LAM_INIT) / sqrtf(ss * (1.0f / 128.0f) + LN_EPS);
    *(GAS unsigned*)(MIX + (r0 + t) * 1024 + head * 128 + 2 * lane) = cvtpk(a0 * rs * gg.x, a1 * rs * gg.y);
}
template <int NR> struct LnRaw { u32x2v_t w[NR][4]; };
template <int NR>
__device__ __forceinline__ void wave_sum_n(float (&v)[NR]) {
#pragma unroll
    for (int o = 1; o < 64; o <<= 1) {
#pragma unroll
        for (int r = 0; r < NR; ++r) v[r] += __shfl_xor(v[r], o); }
}
template <int NR>
__device__ __forceinline__ void wave_max_n(float (&v)[NR]) {
#pragma unroll
    for (int o = 1; o < 64; o <<= 1) {
#pragma unroll
        for (int r = 0; r < NR; ++r) v[r] = fmaxf(v[r], __shfl_xor(v[r], o)); }
}
template <int NR>
__device__ __forceinline__ void ln1_load(LnRaw<NR>& raw, int lane, const bf16* PRE, const size_t (&rows)[NR]) {
#pragma unroll
    for (int r = 0; r < NR; ++r) { const GAS u32x2v_t* xr = (const GAS u32x2v_t*)(PRE + rows[r] * D) + lane;
#pragma unroll
        for (int j = 0; j < 4; ++j) raw.w[r][j] = xr[64 * j]; }
}
template <int NR>
__device__ __forceinline__ void ln1_rows(const LnRaw<NR>& raw, int lane, const size_t (&rows)[NR], const float* g, const float* bt, float* X1, bf16* X1B, unsigned char* X1Q, float* SX) {
    f32x4 gg[4], bb[4];
#pragma unroll
    for (int j = 0; j < 4; ++j) { gg[j] = ((const GAS f32x4*)g)[lane + 64 * j]; bb[j] = ((const GAS f32x4*)bt)[lane + 64 * j]; }
    f32x4 v[NR][4]; float s[NR], s2[NR], am[NR];
#pragma unroll
    for (int r = 0; r < NR; ++r) { s[r] = 0.f;
#pragma unroll
        for (int j = 0; j < 4; ++j) { const u32x2v_t w = raw.w[r][j]; const unsigned w0 = w[0], w1 = w[1]; v[r][j] = (f32x4){bf_lo(w0), bf_hi(w0), bf_lo(w1), bf_hi(w1)}; s[r] += (v[r][j].x + v[r][j].y) + (v[r][j].z + v[r][j].w); } }
    wave_sum_n<NR>(s);
#pragma unroll
    for (int r = 0; r < NR; ++r) { const float mean = s[r] * (1.f / D); s2[r] = 0.f;
#pragma unroll
        for (int j = 0; j < 4; ++j) { v[r][j] = v[r][j] - mean; s2[r] += (v[r][j].x * v[r][j].x + v[r][j].y * v[r][j].y) + (v[r][j].z * v[r][j].z + v[r][j].w * v[r][j].w); } }
    wave_sum_n<NR>(s2);
#pragma unroll
    for (int r = 0; r < NR; ++r) { const float rstd = 1.f / sqrtf(s2[r] * (1.f / D) + LN_EPS); am[r] = 0.f;
#pragma unroll
        for (int j = 0; j < 4; ++j) { const f32x4 o = v[r][j] * rstd * gg[j] + bb[j]; v[r][j] = o; am[r] = fmaxf(am[r], fmaxf(fmaxf(fabsf(o.x), fabsf(o.y)), fmaxf(fabsf(o.z), fabsf(o.w)))); } }
    wave_max_n<NR>(am);
#pragma unroll
    for (int r = 0; r < NR; ++r) { const float inv = am[r] > 0.f ? 127.0f / am[r] : 0.f; const size_t m = rows[r];
#pragma unroll
        for (int j = 0; j < 4; ++j) { const f32x4 o = v[r][j];
            u32x2v_t w; w.x = cvtpk(o.x, o.y); w.y = cvtpk(o.z, o.w);
            ((GAS u32x2v_t*)(X1B + m * D))[lane + 64 * j] = w;
            const int q0 = (int)rintf(o.x * inv), q1 = (int)rintf(o.y * inv), q2 = (int)rintf(o.z * inv), q3 = (int)rintf(o.w * inv);
            ((GAS unsigned*)(X1Q + m * D))[lane + 64 * j] = ((unsigned)q0 & 0xffu) | (((unsigned)q1 & 0xffu) << 8) | (((unsigned)q2 & 0xffu) << 16) | (((unsigned)q3 & 0xffu) << 24); }
        if (lane == 0) SX[m] = am[r] * (1.0f / 127.0f); }
}
constexpr int TK_KEYS_OFF = 65536;
#define TK_INS(L, x_) do { float x__ = (x_); _Pragma("unroll") for (int k_ = 0; k_ < 16; ++k_) { const float hi__ = fmaxf(L[k_], x__); x__ = fminf(L[k_], x__); L[k_] = hi__; } } while (0)
#define TK_CE(a, b) do { const float hi__ = fmaxf(a, b), lo__ = fminf(a, b); a = hi__; b = lo__; } while (0)
__device__ __forceinline__ void tk_sort16_desc(float (&v)[16]) {
#pragma unroll
    for (int k = 2; k <= 16; k <<= 1)
#pragma unroll
        for (int j = k >> 1; j > 0; j >>= 1)
#pragma unroll
            for (int i = 0; i < 16; ++i) { const int l = i ^ j; if (l > i) { if ((i & k) == 0) TK_CE(v[i], v[l]); else TK_CE(v[l], v[i]); } }
}
__device__ __forceinline__ void tk_bitonic_merge16_desc(float (&v)[16]) {
#pragma unroll
    for (int j = 8; j > 0; j >>= 1)
#pragma unroll
        for (int i = 0; i < 16; ++i) { const int l = i ^ j; if (l > i) TK_CE(v[i], v[l]); }
}
__device__ __forceinline__ void tk_merge_top16(float (&a)[16], const float (&b)[16]) {
#pragma unroll
    for (int i = 0; i < 16; ++i) a[i] = fmaxf(a[i], b[15 - i]);
    tk_bitonic_merge16_desc(a);
}
__device__ __forceinline__ void tk_merge_sorted(float (&L)[16]) {
    float Cb[16];
#pragma unroll
    for (int i = 0; i < 16; ++i) Cb[i] = __shfl_xor(L[i], 32);
    float Cm[16];
#pragma unroll
    for (int i = 0; i < 16; ++i) Cm[i] = fmaxf(L[i], Cb[15 - i]);
#pragma unroll
    for (int d = 8; d >= 1; d >>= 1)
#pragma unroll
        for (int i = 0; i < 16; ++i) if ((i & d) == 0) { const float a = fmaxf(Cm[i], Cm[i + d]), b = fminf(Cm[i], Cm[i + d]); Cm[i] = a; Cm[i + d] = b; }
#pragma unroll
    for (int i = 0; i < 16; ++i) L[i] = Cm[i];
}
__device__ __forceinline__ void peer_topk_prefetch(int lane, int tg, int h, int p, const bf16* PQ, const bf16* KEYS, bf16x8 (&qn)[8], bf16x8 (&kn)[8]) {
    const int r32 = lane & 31, hi = lane >> 5;
    const bf16* qp = PQ + ((size_t)tg * 32 + r32) * 2048 + (h * 2 + p) * 128 + hi * 64;
#pragma unroll
    for (int ks = 0; ks < 8; ++ks) qn[ks] = *(const GAS bf16x8*)(qp + ks * 8);
}
__device__ __forceinline__ void peer_topk_unit(Frame& F, int tg, int h, int tgn, int hn, bool has_next, bf16x8 (&qn)[8], bf16x8 (&kn)[8], const bf16* PQ, const bf16* KEYS, int* EIDX, unsigned short* EIDXP, float* GW) {
    const int lane = F.lane, r32 = lane & 31, hi = lane >> 5;
    const size_t tok = (size_t)tg * 32 + r32;
    float sl0[16], sl1[16];
#pragma unroll
    for (int k = 0; k < 16; ++k) { sl0[k] = 0.f; sl1[k] = 0.f; }
#pragma unroll 1
    for (int p = 0; p < 2; ++p) {
        bf16x8 qf[8];
        const LAS unsigned char* kbase = F.lds + RING_OFF + TK_KEYS_OFF + p * 32768 + r32 * 256;
        const int ksw = r32 & 15;
        f32x16 acc[4];
#pragma unroll
        for (int ks = 0; ks < 8; ++ks) qf[ks] = qn[ks];
#pragma unroll
        for (int rb = 0; rb < 4; ++rb) { acc[rb] = f32x16{};
            bf16x8 kf[8];
#pragma unroll
            for (int ks = 0; ks < 8; ++ks) kf[ks] = *(const LAS bf16x8*)(kbase + rb * 8192 + (((8 * hi + ks) ^ ksw) * 16));
#pragma unroll
            for (int ks = 0; ks < 8; ++ks) acc[rb] = __builtin_amdgcn_mfma_f32_32x32x16_bf16(kf[ks], qf[ks], acc[rb], 0, 0, 0); }
        if (p == 0) peer_topk_prefetch(lane, tg, h, 1, PQ, KEYS, qn, kn);
        else if (has_next) peer_topk_prefetch(lane, tgn, hn, 0, PQ, KEYS, qn, kn);
        float L[16], g1[16], g2[16], g3[16];
#pragma unroll
        for (int r = 0; r < 16; ++r) {
            L[r]  = __uint_as_float((__float_as_uint(acc[0][r]) & 0xffffff80u) | (unsigned)(crow(r, hi)));
            g1[r] = __uint_as_float((__float_as_uint(acc[1][r]) & 0xffffff80u) | (unsigned)(32 + crow(r, hi)));
            g2[r] = __uint_as_float((__float_as_uint(acc[2][r]) & 0xffffff80u) | (unsigned)(64 + crow(r, hi)));
            g3[r] = __uint_as_float((__float_as_uint(acc[3][r]) & 0xffffff80u) | (unsigned)(96 + crow(r, hi))); }
        tk_sort16_desc(L); tk_sort16_desc(g1); tk_sort16_desc(g2); tk_sort16_desc(g3);
        tk_merge_top16(L, g1); tk_merge_top16(g2, g3); tk_merge_top16(L, g2);
        tk_merge_sorted(L);
#pragma unroll
        for (int k = 0; k < 16; ++k) { if (p == 0) sl0[k] = L[k]; else sl1[k] = L[k]; }
    }
    float v1[16], v2[16];
#pragma unroll
    for (int k = 0; k < 16; ++k) { v1[k] = __uint_as_float(__float_as_uint(sl0[k]) & 0xffffff80u); v2[k] = __uint_as_float(__float_as_uint(sl1[k]) & 0xffffff80u); }
#define TK_C(a, b) __uint_as_float((__float_as_uint(v1[a] + v2[b]) & 0xffffff00u) | (unsigned)((a) * 16 + (b)))
    float T[16], S1[16], S2[16];
#pragma unroll
    for (int b = 0; b < 16; ++b) T[b] = TK_C(0, b);
#pragma unroll
    for (int b = 0; b < 8; ++b) { S1[b] = TK_C(1, b); S1[8 + b] = TK_C(8 + b, 0); }
    S2[0] = TK_C(2, 0); S2[1] = TK_C(2, 1); S2[2] = TK_C(2, 2); S2[3] = TK_C(2, 3); S2[4] = TK_C(2, 4);
    S2[5] = TK_C(3, 0); S2[6] = TK_C(3, 1); S2[7] = TK_C(3, 2); S2[8] = TK_C(3, 3);
    S2[9] = TK_C(4, 0); S2[10] = TK_C(4, 1); S2[11] = TK_C(4, 2);
    S2[12] = TK_C(5, 0); S2[13] = TK_C(5, 1); S2[14] = TK_C(6, 0); S2[15] = TK_C(6, 1);
    tk_sort16_desc(S1); tk_sort16_desc(S2);
    tk_merge_top16(T, S1); tk_merge_top16(T, S2);
    TK_INS(T, TK_C(7, 0)); TK_INS(T, TK_C(7, 1));
#undef TK_C
    LAS unsigned* lt = (LAS unsigned*)(F.lds + RING_OFF + F.wave * 8192) + lane;
#pragma unroll
    for (int k = 0; k < 16; ++k) { lt[k * 64] = __float_as_uint(sl0[k]) & 127u; lt[(16 + k) * 64] = __float_as_uint(sl1[k]) & 127u; }
    LDS_WAIT(); asm volatile("" ::: "memory");
    unsigned eo[16]; float go[16]; float den = 0.f;
    const float vmax = __uint_as_float(__float_as_uint(T[0]) & 0xffffff00u);
#pragma unroll
    for (int k = 0; k < 16; ++k) { const unsigned bits = __float_as_uint(T[k]); const unsigned a = (bits >> 4) & 15u, b = bits & 15u;
        eo[k] = lt[a * 64] * 128u + lt[(16 + b) * 64];
        go[k] = __builtin_amdgcn_exp2f((__uint_as_float(bits & 0xffffff00u) - vmax) * 1.4426950408889634f); den += go[k]; }
    const float rden = 1.0f / den;
    LDS_WAIT(); asm volatile("" ::: "memory");
    if (hi == 0) { v4u* ep = (v4u*)(EIDX + tok * 128 + h * 16);
#pragma unroll
        for (int q = 0; q < 4; ++q) *(GAS v4u*)(ep + q) = (v4u){eo[4 * q], eo[4 * q + 1], eo[4 * q + 2], eo[4 * q + 3]};
#pragma unroll
        for (int r = 0; r < 8; ++r) *(GAS unsigned*)(EIDXP + tok * 128 + r * 16 + 2 * h) = (eo[r] & 0xffffu) | (eo[8 + r] << 16); }
    else { f32x4* gp = (f32x4*)(GW + tok * 128 + h * 16);
#pragma unroll
        for (int q = 0; q < 4; ++q) *(GAS f32x4*)(gp + q) = (f32x4){go[4 * q] * rden, go[4 * q + 1] * rden, go[4 * q + 2] * rden, go[4 * q + 3] * rden}; }
}
constexpr float PEER_SU = 2048.0f, PEER_SV = 256.0f;
constexpr int PEER_TILES = M / 64;
constexpr int CW_Q6A = 8192, CW_Q6B = 8192 + 8 * 64;
__device__ __forceinline__ float fp8dot16(const v4u& r, const float (&x)[16], float c) {
    const unsigned w[4] = {r.x, r.y, r.z, r.w};
#pragma unroll
    for (int k = 0; k < 4; ++k) { const f32x2v_t lo = __builtin_amdgcn_cvt_pk_f32_fp8((int)w[k], false), hi = __builtin_amdgcn_cvt_pk_f32_fp8((int)w[k], true);
        const float l0 = lo.x, l1 = lo.y, h0 = hi.x, h1 = hi.y;
        c += l0 * x[4 * k]; c += l1 * x[4 * k + 1]; c += h0 * x[4 * k + 2]; c += h1 * x[4 * k + 3]; }
    return c;
}
__device__ __forceinline__ void fp8axpy16(const v4u& r, float wgt, float (&acc)[16]) {
    const unsigned w[4] = {r.x, r.y, r.z, r.w};
#pragma unroll
    for (int k = 0; k < 4; ++k) { const f32x2v_t lo = __builtin_amdgcn_cvt_pk_f32_fp8((int)w[k], false), hi = __builtin_amdgcn_cvt_pk_f32_fp8((int)w[k], true);
        const float l0 = lo.x, l1 = lo.y, h0 = hi.x, h1 = hi.y;
        acc[4 * k] += wgt * l0; acc[4 * k + 1] += wgt * l1; acc[4 * k + 2] += wgt * h0; acc[4 * k + 3] += wgt * h1; }
}
template <class Body>
__device__ __forceinline__ void peer_tasks(Frame& F, gu32* cnt, const Body& body) {
    volatile LAS unsigned* tk = F.MISC + 16;
    const unsigned pref = xb_xcc_id() & 7u;
    for (unsigned k = 0; k < 8; ++k) {
        const unsigned s = (pref + k) & 7u;
        for (;;) {
            if (F.tid == 0) tk[0] = __hip_atomic_fetch_add((unsigned*)(cnt + 64 * s), 1u, __ATOMIC_RELAXED, __HIP_MEMORY_SCOPE_AGENT);
            __syncthreads();
            const unsigned t = tk[0];
            __syncthreads();
            if (t >= (unsigned)PEER_TILES) break;
            body((int)s, (int)t);
        }
    }
}
template <bool IS_U> struct PeerMeta { int id0, id1; float w0, w1; };
struct PeerX { v4u xa, xb; };
template <bool IS_U>
__device__ __forceinline__ void peer_meta_load(PeerMeta<IS_U>& m, int lane, size_t tok, int s, const int* EIDX, const bf16* X1B, const float* W) {
    m.id0 = EIDX[tok * 128 + lane]; m.id1 = EIDX[tok * 128 + 64 + lane];
    if (!IS_U) { m.w0 = W[tok * 128 + lane]; m.w1 = W[tok * 128 + 64 + lane]; }
}
template <bool IS_U>
__device__ __forceinline__ void peer_half_issue(int idh, float wh, int lane, const unsigned char* sbase, v4u (&rows)[8], float (&wj)[8]) {
    const int r = lane >> 3; const unsigned cpo = (unsigned)(lane & 7) * 16u;
#pragma unroll
    for (int j = 0; j < 8; ++j) { const int src = 8 * j + r; const unsigned e = (unsigned)(__shfl(idh, src) & (NEXP - 1)); if (!IS_U) wj[j] = __shfl(wh, src); rows[j] = *(const GAS v4u*)(sbase + (e * 128u + cpo)); }
}
template <bool IS_U, int H>
__device__ __forceinline__ void peer_half_consume(const float (&xq)[16], const v4u (&rows)[8], const float (&wj)[8], float (&v16)[16]) {
    if (IS_U) {
#pragma unroll
        for (int j = 0; j < 8; ++j) v16[8 * H + j] = fp8dot16(rows[j], xq, 0.f);
    } else {
#pragma unroll
        for (int j = 0; j < 8; ++j) fp8axpy16(rows[j], wj[j], v16);
    }
}
template <bool IS_U>
__device__ __forceinline__ void peer_token_finish(int lane, size_t tok, int s, const float (&v16)[16], float* DST) {
    constexpr int B2 = IS_U ? 4 : 32, B1 = IS_U ? 2 : 16, B0 = IS_U ? 1 : 8;
    float r8[8], r4[4], r2[2];
    { const bool up = (lane & B2) != 0;
#pragma unroll
      for (int j = 0; j < 8; ++j) { const float keep = up ? v16[j + 8] : v16[j], send = up ? v16[j] : v16[j + 8]; r8[j] = keep + __shfl_xor(send, B2); } }
    { const bool up = (lane & B1) != 0;
#pragma unroll
      for (int j = 0; j < 4; ++j) { const float keep = up ? r8[j + 4] : r8[j], send = up ? r8[j] : r8[j + 4]; r4[j] = keep + __shfl_xor(send, B1); } }
    { const bool up = (lane & B0) != 0;
#pragma unroll
      for (int j = 0; j < 2; ++j) { const float keep = up ? r4[j + 2] : r4[j], send = up ? r4[j] : r4[j + 2]; r2[j] = keep + __shfl_xor(send, B0); } }
    const int r = lane >> 3, cp = lane & 7;
    if (IS_U) { float* o = DST + ((size_t)s * M + tok) * 128 + 16 * cp + r; o[0] = r2[0]; o[8] = r2[1]; }
    else { *(GAS unsigned*)((bf16*)DST + tok * 1024 + s * 128 + 16 * cp + 2 * r) = cvtpk(r2[0], r2[1]); }
}
template <bool IS_U, int H>
__device__ __forceinline__ void peer_half_consume2(const PeerMeta<IS_U>& m, int lane, const float (&xq)[16], const v4u (&rows)[8], float (&v16)[16]) {
    if (IS_U) {
#pragma unroll
        for (int j = 0; j < 8; ++j) v16[8 * H + j] = fp8dot16(rows[j], xq, 0.f);
    } else {
        const int r = lane >> 3;
#pragma unroll
        for (int j = 0; j < 8; ++j) { const float wj = __shfl(H ? m.w1 : m.w0, 8 * j + r); fp8axpy16(rows[j], wj, v16); }
    }
}
template <bool IS_U>
__device__ __forceinline__ void peer_half_issue2(int idh, int lane, const unsigned char* sbase, v4u (&rows)[8]) {
    const int r = lane >> 3; const unsigned cpo = (unsigned)(lane & 7) * 16u;
#pragma unroll
    for (int j = 0; j < 8; ++j) { const unsigned e = (unsigned)(__shfl(idh, 8 * j + r) & (NEXP - 1)); rows[j] = *(const GAS v4u*)(sbase + (e * 128u + cpo)); }
}
__device__ __forceinline__ void peer_x_load(PeerX& x, int lane, size_t tok, int s, const bf16* X1B) { const bf16* xp = X1B + tok * 1024 + s * 128 + (lane & 7) * 16; x.xa = *(const GAS v4u*)xp; x.xb = *(const GAS v4u*)(xp + 8); }
template <bool IS_U>
__device__ __forceinline__ void peer_xq(const PeerX& c, float (&xq)[16]) {
    if (IS_U) {
        xq[0] = bf_lo(c.xa.x); xq[1] = bf_hi(c.xa.x); xq[2] = bf_lo(c.xa.y); xq[3] = bf_hi(c.xa.y); xq[4] = bf_lo(c.xa.z); xq[5] = bf_hi(c.xa.z); xq[6] = bf_lo(c.xa.w); xq[7] = bf_hi(c.xa.w);
        xq[8] = bf_lo(c.xb.x); xq[9] = bf_hi(c.xb.x); xq[10] = bf_lo(c.xb.y); xq[11] = bf_hi(c.xb.y); xq[12] = bf_lo(c.xb.z); xq[13] = bf_hi(c.xb.z); xq[14] = bf_lo(c.xb.w); xq[15] = bf_hi(c.xb.w); }
}
template <bool IS_U>
__device__ __forceinline__ void peer_slice_task(Frame& F, int s, int t, const unsigned char* TAB, const int* EIDX, const bf16* X1B, const float* W, float* DST) {
    const int lane = F.lane; const size_t tok0 = (size_t)t * 64 + F.wave * 8;
    const unsigned char* sbase = TAB + (size_t)s * NEXP * 128;
    PeerMeta<IS_U> mA, mB, mC, mD; PeerX xA, xB; v4u r0[8], r1[8], r2[8], r3[8];
    if (IS_U) { peer_x_load(xA, lane, tok0, s, X1B); peer_x_load(xB, lane, tok0 + 1, s, X1B); }
    peer_meta_load<IS_U>(mA, lane, tok0, s, EIDX, X1B, W);
    peer_meta_load<IS_U>(mB, lane, tok0 + 1, s, EIDX, X1B, W);
    peer_meta_load<IS_U>(mC, lane, tok0 + 2, s, EIDX, X1B, W);
    peer_half_issue2<IS_U>(mA.id0, lane, sbase, r0);
    peer_half_issue2<IS_U>(mA.id1, lane, sbase, r1);
    peer_half_issue2<IS_U>(mB.id0, lane, sbase, r2);
#pragma unroll 1
    for (int j = 0; j < 4; ++j) {
        const size_t tk = tok0 + 2 * j; float xq[16], v16[16];
        peer_half_issue2<IS_U>(mB.id1, lane, sbase, r3);
        if (j < 3) peer_meta_load<IS_U>(mD, lane, tk + 3, s, EIDX, X1B, W);
        peer_xq<IS_U>(xA, xq);
#pragma unroll
        for (int q = 0; q < 16; ++q) v16[q] = 0.f;
        peer_half_consume2<IS_U, 0>(mA, lane, xq, r0, v16);
        if (j < 3) peer_half_issue2<IS_U>(mC.id0, lane, sbase, r0);
        peer_half_consume2<IS_U, 1>(mA, lane, xq, r1, v16);
        peer_token_finish<IS_U>(lane, tk, s, v16, DST);
        if (j < 3) peer_half_issue2<IS_U>(mC.id1, lane, sbase, r1);
        if (j < 2) peer_meta_load<IS_U>(mA, lane, tk + 4, s, EIDX, X1B, W);
        if (IS_U && j < 3) peer_x_load(xA, lane, tk + 2, s, X1B);
        peer_xq<IS_U>(xB, xq);
#pragma unroll
        for (int q = 0; q < 16; ++q) v16[q] = 0.f;
        peer_half_consume2<IS_U, 0>(mB, lane, xq, r2, v16);
        if (j < 3) peer_half_issue2<IS_U>(mD.id0, lane, sbase, r2);
        if (IS_U && j < 3) peer_x_load(xB, lane, tk + 3, s, X1B);
        peer_half_consume2<IS_U, 1>(mB, lane, xq, r3, v16);
        peer_token_finish<IS_U>(lane, tk + 1, s, v16, DST);
        { const PeerMeta<IS_U> tmp = mA; mA = mC; mB = mD; mC = tmp; }
    }
}
__device__ __forceinline__ void peer_slice_task_v(Frame& F, int s, int t, const unsigned char* TAB, const int* EIDX, const bf16* X1B, const float* W, float* DST) {
    const int lane = F.lane; const size_t tok0 = (size_t)t * 64 + F.wave * 8;
    const unsigned char* sbase = TAB + (size_t)s * NEXP * 128;
    PeerMeta<false> cur, nxt; v4u rowsA[8], rowsB[8]; float wA[8], wB[8];
    peer_meta_load<false>(cur, lane, tok0, s, EIDX, X1B, W);
    peer_meta_load<false>(nxt, lane, tok0 + 1, s, EIDX, X1B, W);
    peer_half_issue<false>(cur.id0, cur.w0, lane, sbase, rowsA, wA);
#pragma unroll 1
    for (int i = 0; i < 8; ++i) {
        float xq[16];
        float v16[16];
#pragma unroll
        for (int k = 0; k < 16; ++k) v16[k] = 0.f;
        peer_half_issue<false>(cur.id1, cur.w1, lane, sbase, rowsB, wB);
        peer_half_consume<false, 0>(xq, rowsA, wA, v16);
        if (i + 1 < 8) peer_half_issue<false>(nxt.id0, nxt.w0, lane, sbase, rowsA, wA);
        peer_half_consume<false, 1>(xq, rowsB, wB, v16);
        peer_token_finish<false>(lane, tok0 + i, s, v16, DST);
        cur = nxt;
        if (i + 2 < 8) peer_meta_load<false>(nxt, lane, tok0 + i + 2, s, EIDX, X1B, W);
    }
}
__device__ __forceinline__ int dot16_i8(const v4u& r, const v4u& x) {
    int c = __builtin_amdgcn_sdot4((int)r.x, (int)x.x, 0, false); c = __builtin_amdgcn_sdot4((int)r.y, (int)x.y, c, false); c = __builtin_amdgcn_sdot4((int)r.z, (int)x.z, c, false); return __builtin_amdgcn_sdot4((int)r.w, (int)x.w, c, false);
}
__device__ __forceinline__ void quad_dot(unsigned r0, unsigned r1, unsigned r2, unsigned r3, int w4, int& a0, int& a1, int& a2, int& a3) {
    const unsigned t0 = __builtin_amdgcn_perm(r1, r0, 0x05010400u), t1 = __builtin_amdgcn_perm(r1, r0, 0x07030602u), t2 = __builtin_amdgcn_perm(r3, r2, 0x05010400u), t3 = __builtin_amdgcn_perm(r3, r2, 0x07030602u);
    const unsigned c0 = __builtin_amdgcn_perm(t2, t0, 0x05040100u), c1 = __builtin_amdgcn_perm(t2, t0, 0x07060302u), c2 = __builtin_amdgcn_perm(t3, t1, 0x05040100u), c3 = __builtin_amdgcn_perm(t3, t1, 0x07060302u);
    a0 = __builtin_amdgcn_sdot4((int)c0, w4, a0, false); a1 = __builtin_amdgcn_sdot4((int)c1, w4, a1, false); a2 = __builtin_amdgcn_sdot4((int)c2, w4, a2, false); a3 = __builtin_amdgcn_sdot4((int)c3, w4, a3, false);
}
__device__ __forceinline__ void half_axpy_i8(const v4u (&rows)[8], int wq0, int wq1, int (&acc)[16]) {
    quad_dot(rows[0].x, rows[1].x, rows[2].x, rows[3].x, wq0, acc[0], acc[1], acc[2], acc[3]);
    quad_dot(rows[0].y, rows[1].y, rows[2].y, rows[3].y, wq0, acc[4], acc[5], acc[6], acc[7]);
    quad_dot(rows[0].z, rows[1].z, rows[2].z, rows[3].z, wq0, acc[8], acc[9], acc[10], acc[11]);
    quad_dot(rows[0].w, rows[1].w, rows[2].w, rows[3].w, wq0, acc[12], acc[13], acc[14], acc[15]);
    quad_dot(rows[4].x, rows[5].x, rows[6].x, rows[7].x, wq1, acc[0], acc[1], acc[2], acc[3]);
    quad_dot(rows[4].y, rows[5].y, rows[6].y, rows[7].y, wq1, acc[4], acc[5], acc[6], acc[7]);
    quad_dot(rows[4].z, rows[5].z, rows[6].z, rows[7].z, wq1, acc[8], acc[9], acc[10], acc[11]);
    quad_dot(rows[4].w, rows[5].w, rows[6].w, rows[7].w, wq1, acc[12], acc[13], acc[14], acc[15]);
}
template <int B2, int B1, int B0>
__device__ __forceinline__ void tr_reduce16(int lane, const int (&v16)[16], int& o0, int& o1) {
    int r8[8], r4[4];
    { const bool up = (lane & B2) != 0;
#pragma unroll
      for (int j = 0; j < 8; ++j) { const int keep = up ? v16[j + 8] : v16[j], send = up ? v16[j] : v16[j + 8]; r8[j] = keep + __shfl_xor(send, B2); } }
    { const bool up = (lane & B1) != 0;
#pragma unroll
      for (int j = 0; j < 4; ++j) { const int keep = up ? r8[j + 4] : r8[j], send = up ? r8[j] : r8[j + 4]; r4[j] = keep + __shfl_xor(send, B1); } }
    { const bool up = (lane & B0) != 0;
      { const int keep = up ? r4[2] : r4[0], send = up ? r4[0] : r4[2]; o0 = keep + __shfl_xor(send, B0); }
      { const int keep = up ? r4[3] : r4[1], send = up ? r4[1] : r4[3]; o1 = keep + __shfl_xor(send, B0); } }
}
struct PeerIdsH { v4u a; };
__device__ __forceinline__ void peer_ids_half(PeerIdsH& m, int lane, size_t tok, int h, const unsigned short* EIDXP) { m.a = *(const GAS v4u*)(EIDXP + tok * 128 + (lane >> 3) * 16 + 8 * h); }
__device__ __forceinline__ void peer_half_issue3(const PeerIdsH& m, int lane, const unsigned char* sbase, v4u (&rows)[8]) {
    const unsigned cpo = (unsigned)(lane & 7) * 16u;
    const unsigned e[8] = {m.a.x & 0xffffu, m.a.x >> 16, m.a.y & 0xffffu, m.a.y >> 16, m.a.z & 0xffffu, m.a.z >> 16, m.a.w & 0xffffu, m.a.w >> 16};
#pragma unroll
    for (int j = 0; j < 8; ++j) rows[j] = *(const GAS v4u*)(sbase + ((e[j] & (unsigned)(NEXP - 1)) * 128u + cpo));
}
template <bool IS_U>
__device__ __forceinline__ void peer_slice_task(Frame& F, int s, int t, const unsigned char* TAB, const unsigned short* EIDXP, const unsigned char* XW, const float* SW, void* DST) {
    const int lane = F.lane, r = lane >> 3, cp = lane & 7; const size_t tok0 = (size_t)t * 64 + F.wave * 8;
    const unsigned char* sbase = TAB + (size_t)s * NEXP * 128;
    const unsigned char* xb = IS_U ? (XW + s * 128 + cp * 16) : (XW + r * 16);
    constexpr size_t XS = IS_U ? 1024 : 128;
    PeerIdsH iA, iB; v4u xA, xB; v4u r0[8], r1[8], r2[8], r3[8];
    peer_ids_half(iA, lane, tok0, 0, EIDXP); peer_ids_half(iB, lane, tok0, 1, EIDXP);
    xA = *(const GAS v4u*)(xb + tok0 * XS); xB = *(const GAS v4u*)(xb + (tok0 + 1) * XS);
    peer_half_issue3(iA, lane, sbase, r0); peer_ids_half(iA, lane, tok0 + 1, 0, EIDXP);
    peer_half_issue3(iB, lane, sbase, r1); peer_ids_half(iB, lane, tok0 + 1, 1, EIDXP);
    peer_half_issue3(iA, lane, sbase, r2); peer_ids_half(iA, lane, tok0 + 2, 0, EIDXP);
#define PEER_FINISH(tk_, v16_) do { int o0_, o1_; \
        if (IS_U) { tr_reduce16<4, 2, 1>(lane, v16_, o0_, o1_); int* a_ = (int*)DST + (size_t)(tk_) * 128 + cp * 8 + r; __hip_atomic_fetch_add(a_, o0_, __ATOMIC_RELAXED, __HIP_MEMORY_SCOPE_AGENT); __hip_atomic_fetch_add(a_ + 64, o1_, __ATOMIC_RELAXED, __HIP_MEMORY_SCOPE_AGENT); }       \
        else { tr_reduce16<32, 16, 8>(lane, v16_, o0_, o1_); const float sw_ = SW[(tk_)]; *(GAS unsigned*)((bf16*)DST + (tk_) * 1024 + s * 128 + 16 * cp + 2 * r) = cvtpk((float)o0_ * sw_, (float)o1_ * sw_); } } while (0)
#pragma unroll 1
    for (int j = 0; j < 4; ++j) {
        const size_t tk = tok0 + 2 * j; int v16[16];
        peer_half_issue3(iB, lane, sbase, r3);
        if (j < 3) peer_ids_half(iB, lane, tk + 2, 1, EIDXP);
        if (IS_U) {
#pragma unroll
            for (int q = 0; q < 8; ++q) v16[q] = dot16_i8(r0[q], xA);
        } else {
#pragma unroll
            for (int q = 0; q < 16; ++q) v16[q] = 0;
            half_axpy_i8(r0, (int)xA.x, (int)xA.y, v16);
        }
        if (j < 3) { peer_half_issue3(iA, lane, sbase, r0); peer_ids_half(iA, lane, tk + 3, 0, EIDXP); }
        if (IS_U) {
#pragma unroll
            for (int q = 0; q < 8; ++q) v16[8 + q] = dot16_i8(r1[q], xA);
        } else half_axpy_i8(r1, (int)xA.z, (int)xA.w, v16);
        PEER_FINISH(tk, v16);
        if (j < 3) { peer_half_issue3(iB, lane, sbase, r1); peer_ids_half(iB, lane, tk + 3, 1, EIDXP); xA = *(const GAS v4u*)(xb + (tk + 2) * XS); }
        if (IS_U) {
#pragma unroll
            for (int q = 0; q < 8; ++q) v16[q] = dot16_i8(r2[q], xB);
        } else {
#pragma unroll
            for (int q = 0; q < 16; ++q) v16[q] = 0;
            half_axpy_i8(r2, (int)xB.x, (int)xB.y, v16);
        }
        if (j < 3) { peer_half_issue3(iA, lane, sbase, r2); if (j < 2) peer_ids_half(iA, lane, tk + 4, 0, EIDXP); }
        if (IS_U) {
#pragma unroll
            for (int q = 0; q < 8; ++q) v16[8 + q] = dot16_i8(r3[q], xB);
        } else half_axpy_i8(r3, (int)xB.z, (int)xB.w, v16);
        PEER_FINISH(tk + 1, v16);
        if (j < 3) xB = *(const GAS v4u*)(xb + (tk + 3) * XS);
    }
#undef PEER_FINISH
}
template <bool IS_U>
__device__ __forceinline__ void peer_slice_stream(Frame& F, int s, int tokB, int tokE, const unsigned char* TAB, const unsigned short* EIDXP, const unsigned char* XW, const float* SW, void* DST) {
    const int lane = F.lane, r = lane >> 3, cp = lane & 7; const size_t tok0 = (size_t)tokB; const size_t tokL = (size_t)tokE - 1; const int np = (tokE - tokB + 1) >> 1;
#define CL(t_) ((t_) < tokL ? (t_) : tokL)
    const unsigned char* sbase = TAB + (size_t)s * NEXP * 128;
    const unsigned char* xb = IS_U ? (XW + s * 128 + cp * 16) : (XW + r * 16);
    constexpr size_t XS = IS_U ? 1024 : 128;
    PeerIdsH iA, iB; v4u xA, xB; v4u r0[8], r1[8], r2[8], r3[8];
    peer_ids_half(iA, lane, tok0, 0, EIDXP); peer_ids_half(iB, lane, tok0, 1, EIDXP);
    xA = *(const GAS v4u*)(xb + tok0 * XS); xB = *(const GAS v4u*)(xb + CL(tok0 + 1) * XS);
    peer_half_issue3(iA, lane, sbase, r0); peer_ids_half(iA, lane, CL(tok0 + 1), 0, EIDXP);
    peer_half_issue3(iB, lane, sbase, r1); peer_ids_half(iB, lane, CL(tok0 + 1), 1, EIDXP);
    peer_half_issue3(iA, lane, sbase, r2); peer_ids_half(iA, lane, CL(tok0 + 2), 0, EIDXP);
#define PEER_FINISH(tk_, v16_) do { int o0_, o1_; \
        if (IS_U) { tr_reduce16<4, 2, 1>(lane, v16_, o0_, o1_); int* a_ = (int*)DST + (size_t)(tk_) * 128 + cp * 8 + r; __hip_atomic_fetch_add(a_, o0_, __ATOMIC_RELAXED, __HIP_MEMORY_SCOPE_AGENT); __hip_atomic_fetch_add(a_ + 64, o1_, __ATOMIC_RELAXED, __HIP_MEMORY_SCOPE_AGENT); }       \
        else { tr_reduce16<32, 16, 8>(lane, v16_, o0_, o1_); const float sw_ = SW[(tk_)]; *(GAS unsigned*)((bf16*)DST + (tk_) * 1024 + s * 128 + 16 * cp + 2 * r) = cvtpk((float)o0_ * sw_, (float)o1_ * sw_); } } while (0)
#pragma unroll 1
    for (int j = 0; j < np; ++j) { const bool more = j < np - 1;
        const size_t tk = tok0 + 2 * j; int v16[16];
        peer_half_issue3(iB, lane, sbase, r3);
        if (more) peer_ids_half(iB, lane, CL(tk + 2), 1, EIDXP);
        if (IS_U) {
#pragma unroll
            for (int q = 0; q < 8; ++q) v16[q] = dot16_i8(r0[q], xA);
        } else {
#pragma unroll
            for (int q = 0; q < 16; ++q) v16[q] = 0;
            half_axpy_i8(r0, (int)xA.x, (int)xA.y, v16);
        }
        if (more) { peer_half_issue3(iA, lane, sbase, r0); peer_ids_half(iA, lane, CL(tk + 3), 0, EIDXP); }
        if (IS_U) {
#pragma unroll
            for (int q = 0; q < 8; ++q) v16[8 + q] = dot16_i8(r1[q], xA);
        } else half_axpy_i8(r1, (int)xA.z, (int)xA.w, v16);
        PEER_FINISH(tk, v16);
        if (more) { peer_half_issue3(iB, lane, sbase, r1); peer_ids_half(iB, lane, CL(tk + 3), 1, EIDXP); xA = *(const GAS v4u*)(xb + CL(tk + 2) * XS); }
        if (IS_U) {
#pragma unroll
            for (int q = 0; q < 8; ++q) v16[q] = dot16_i8(r2[q], xB);
        } else {
#pragma unroll
            for (int q = 0; q < 16; ++q) v16[q] = 0;
            half_axpy_i8(r2, (int)xB.x, (int)xB.y, v16);
        }
        if (more) { peer_half_issue3(iA, lane, sbase, r2); if (j < np - 2) peer_ids_half(iA, lane, CL(tk + 4), 0, EIDXP); }
        if (IS_U) {
#pragma unroll
            for (int q = 0; q < 8; ++q) v16[8 + q] = dot16_i8(r3[q], xB);
        } else half_axpy_i8(r3, (int)xB.z, (int)xB.w, v16);
        if (tk + 1 <= tokL) PEER_FINISH(tk + 1, v16);
        if (more) xB = *(const GAS v4u*)(xb + CL(tk + 3) * XS);
    }
#undef PEER_FINISH
#undef CL
}
template <int NR>
__device__ __forceinline__ void peer_reduce_tokens(int lane, const size_t (&toks)[NR], const int* PART, const int* EIDX, const float* USC, const float* VSC, const float* SX, const float* GW, unsigned char* WQ, float* SW) {
    const int pi0 = ((lane >> 3) & 1) * 64 + (lane >> 4) * 8 + (lane & 7);
    int p0[NR][1], p1[NR][1], e0[NR], e1[NR]; float g0[NR], g1[NR], sx[NR], u0[NR], u1[NR], c0[NR], c1[NR];
#pragma unroll
    for (int r = 0; r < NR; ++r) { const size_t tok = toks[r];
        p0[r][0] = PART[tok * 128 + pi0]; p1[r][0] = PART[tok * 128 + pi0 + 32];
        e0[r] = EIDX[tok * 128 + lane] & (NEXP - 1); e1[r] = EIDX[tok * 128 + 64 + lane] & (NEXP - 1); g0[r] = GW[tok * 128 + lane]; g1[r] = GW[tok * 128 + 64 + lane]; sx[r] = SX[tok]; }
#pragma unroll
    for (int r = 0; r < NR; ++r) { u0[r] = USC[e0[r]]; u1[r] = USC[e1[r]]; c0[r] = VSC[e0[r]]; c1[r] = VSC[e1[r]]; }
    float w0[NR], w1[NR], m[NR];
#pragma unroll
    for (int r = 0; r < NR; ++r) { const int a0 = p0[r][0], a1 = p1[r][0];
        w0[r] = g0[r] * gelu_tanh((float)a0 * u0[r] * sx[r]) * c0[r]; w1[r] = g1[r] * gelu_tanh((float)a1 * u1[r] * sx[r]) * c1[r];
        m[r] = fmaxf(fabsf(w0[r]), fabsf(w1[r])); }
    wave_max_n<NR>(m);
#pragma unroll
    for (int r = 0; r < NR; ++r) { const size_t tok = toks[r]; const float inv = m[r] > 0.f ? 127.0f / m[r] : 0.f;
        const int q0 = (int)rintf(w0[r] * inv), q1 = (int)rintf(w1[r] * inv);
        WQ[tok * 128 + (lane & 7) * 16 + (lane >> 3)] = (unsigned char)(q0 & 0xff);
        WQ[tok * 128 + (lane & 7) * 16 + 8 + (lane >> 3)] = (unsigned char)(q1 & 0xff);
        if (lane == 0) SW[tok] = m[r] * (1.0f / 127.0f); }
}
template <int NR> struct Ln2Raw { u32x2v_t x[NR][4], f[NR][4]; };
template <int NR>
__device__ __forceinline__ void ln2_load(Ln2Raw<NR>& raw, int lane, const bf16* X1B, const bf16* FFN, const size_t (&rows)[NR]) {
#pragma unroll
    for (int r = 0; r < NR; ++r)
#pragma unroll
        for (int j = 0; j < 4; ++j) { raw.x[r][j] = ((const GAS u32x2v_t*)(X1B + rows[r] * D))[lane + 64 * j]; raw.f[r][j] = ((const GAS u32x2v_t*)(FFN + rows[r] * D))[lane + 64 * j]; }
}
template <int NR>
__device__ __forceinline__ void ln2_rows(const Ln2Raw<NR>& raw, int lane, const size_t (&rows)[NR], const float* g, const float* bt, float* X2, bf16* X2B) {
    f32x4 gg[4], bb[4];
#pragma unroll
    for (int j = 0; j < 4; ++j) { gg[j] = ((const GAS f32x4*)g)[lane + 64 * j]; bb[j] = ((const GAS f32x4*)bt)[lane + 64 * j]; }
    f32x4 v[NR][4]; float s[NR], s2[NR];
#pragma unroll
    for (int r = 0; r < NR; ++r) { s[r] = 0.f;
#pragma unroll
        for (int j = 0; j < 4; ++j) { const u32x2v_t xb = raw.x[r][j], fb = raw.f[r][j]; const unsigned x0 = xb[0], x1_ = xb[1], f0 = fb[0], f1 = fb[1];
            const f32x4 a = (f32x4){bf_lo(x0), bf_hi(x0), bf_lo(x1_), bf_hi(x1_)}, f = (f32x4){bf_lo(f0), bf_hi(f0), bf_lo(f1), bf_hi(f1)};
            v[r][j] = a * ALPHA + f; s[r] += (v[r][j].x + v[r][j].y) + (v[r][j].z + v[r][j].w); } }
    wave_sum_n<NR>(s);
#pragma unroll
    for (int r = 0; r < NR; ++r) { const float mean = s[r] * (1.f / D); s2[r] = 0.f;
#pragma unroll
        for (int j = 0; j < 4; ++j) { v[r][j] = v[r][j] - mean; s2[r] += (v[r][j].x * v[r][j].x + v[r][j].y * v[r][j].y) + (v[r][j].z * v[r][j].z + v[r][j].w * v[r][j].w); } }
    wave_sum_n<NR>(s2);
#pragma unroll
    for (int r = 0; r < NR; ++r) { const float rstd = 1.f / sqrtf(s2[r] * (1.f / D) + LN_EPS); const size_t m = rows[r];
#pragma unroll
        for (int j = 0; j < 4; ++j) { const f32x4 o = v[r][j] * rstd * gg[j] + bb[j];
            u32x2v_t w; w.x = cvtpk(o.x, o.y); w.y = cvtpk(o.z, o.w);
            ((GAS u32x2v_t*)(X2B + m * D))[lane + 64 * j] = w; } }
}
template <class Epi>
__device__ __forceinline__ void sample_gemm(Frame& F, const bf16* A, const bf16* Bt, int N, int K, const Epi& epi, int cu_lo = 0, int cu = -1) {
    const int lane = F.lane, r32 = lane & 31, hi = lane >> 5;
    const int ntile = 8 * (N / 32);
    const int Gs = F.G - cu_lo; const int me = cu < 0 ? F.vcu : cu;
    if (me < cu_lo) return;
    for (int wt = (me - cu_lo) + F.wave * Gs; wt < ntile; wt += Gs * NWAVES) {
        const int rt = wt & 7, ct = wt >> 3;
        const bf16* ap = A + (size_t)(32 * rt + r32) * K + 64 * hi;
        const bf16* bp = Bt + (size_t)(32 * ct + r32) * K + 64 * hi;
        f32x16 acc = f32x16{};
        bf16x8 a0[8], b0[8], a1[8], b1[8];
#pragma unroll
        for (int j = 0; j < 8; ++j) { a0[j] = *(const GAS bf16x8*)(ap + 8 * j); b0[j] = *(const GAS bf16x8*)(bp + 8 * j); }
#pragma unroll 1
        for (int k0 = 0; k0 < K; k0 += 256) {
#pragma unroll
            for (int j = 0; j < 8; ++j) { a1[j] = *(const GAS bf16x8*)(ap + k0 + 128 + 8 * j); b1[j] = *(const GAS bf16x8*)(bp + k0 + 128 + 8 * j); }
#pragma unroll
            for (int j = 0; j < 8; ++j) acc = __builtin_amdgcn_mfma_f32_32x32x16_bf16(a0[j], b0[j], acc, 0, 0, 0);
            if (k0 + 256 < K) {
#pragma unroll
                for (int j = 0; j < 8; ++j) { a0[j] = *(const GAS bf16x8*)(ap + k0 + 256 + 8 * j); b0[j] = *(const GAS bf16x8*)(bp + k0 + 256 + 8 * j); }
            }
#pragma unroll
            for (int j = 0; j < 8; ++j) acc = __builtin_amdgcn_mfma_f32_32x32x16_bf16(a1[j], b1[j], acc, 0, 0, 0);
        }
#pragma unroll
        for (int r = 0; r < 16; ++r) epi(32 * rt + crow(r, hi), 32 * ct + r32, acc[r], 32 * ct);
    }
}
template <class Pre, class Fin>
__device__ __forceinline__ void sample_gemm_ks(Frame& F, const bf16* A, const bf16* Bt, int N, const Pre& pre, const Fin& fin) {
    constexpr int K = 1024;
    const int lane = F.lane, r32 = lane & 31, hi = lane >> 5;
    const int ntile = 8 * (N / 32);
    LAS float* red = (LAS float*)(F.lds + RING_OFF);
    const int orr = 2 * F.wave + (lane >> 5), opp = lane & 31, ohi = opp >> 4, oc = (2 * opp) & 31;
    for (int wt = F.vcu; wt < ntile; wt += F.G) {
        const int rt = wt & 7, ct = wt >> 3;
        const int row = 32 * rt + crow(orr, ohi), col = 32 * ct + oc;
        const auto pv = pre(row, col);
        const bf16* ap = A + (size_t)(32 * rt + r32) * K + 128 * F.wave + 64 * hi;
        const bf16* bp = Bt + (size_t)(32 * ct + r32) * K + 128 * F.wave + 64 * hi;
        bf16x8 a[8], b[8];
#pragma unroll
        for (int j = 0; j < 8; ++j) { a[j] = *(const GAS bf16x8*)(ap + 8 * j); b[j] = *(const GAS bf16x8*)(bp + 8 * j); }
        f32x16 acc = f32x16{};
#pragma unroll
        for (int j = 0; j < 8; ++j) acc = __builtin_amdgcn_mfma_f32_32x32x16_bf16(a[j], b[j], acc, 0, 0, 0);
#pragma unroll
        for (int r = 0; r < 16; ++r) red[(F.wave * 16 + r) * 64 + lane] = acc[r];
        __syncthreads();
        float v0 = 0.f, v1 = 0.f;
#pragma unroll
        for (int w = 0; w < NWAVES; ++w) { const f32x2v_t t = *(const LAS f32x2v_t*)(red + (w * 16 + orr) * 64 + 2 * opp); v0 += t.x; v1 += t.y; }
        fin(row, col, v0, v1, pv);
        __syncthreads();
    }
}
__global__ void __launch_bounds__(NWAVES * 64, 2) mega_fwd(Args args) {
    extern __shared__ __attribute__((aligned(16))) unsigned char lds[];
    Frame F;
    F.lds = (LAS unsigned char*)lds;
    F.MISC = (volatile LAS unsigned*)(F.lds + MISC_OFF);
    F.tid = threadIdx.x; F.lane = F.tid & 63; F.wave = __builtin_amdgcn_readfirstlane(F.tid >> 6);
    F.G = gridDim.x; { const int bx = blockIdx.x; F.vcu = (F.G % 8 == 0) ? (bx % 8) * (F.G / 8) + bx / 8 : bx; }
    unsigned char* ws = args.ws;
    F.ctl = (gu32*)(ws + WS_CTL);
    for (int u = F.tid; u < (LDS_BYTES - LDSCTL_OFF) / 4; u += NWAVES * 64) ((LAS unsigned*)(F.lds + LDSCTL_OFF))[u] = 0u;
    __syncthreads();
    XcdBarrier bar = xcd_barrier_post((unsigned*)(F.ctl + CW_BAR), F.MISC + 8);
    float* out = args.out;
#define LAUNDER() do { asm volatile("" : "+v"(F.tid)); F.lane = F.tid & 63; } while (0)

    LAUNDER();
    p0_prologue(F, args, ws);
    xcd_barrier(bar);

    LAUNDER();
    {
        pg8::Gemm g{(const pg8::bf16_t*)(ws + WS_XB), (const pg8::bf16_t*)(ws + WS_WIN_T), MP, INW, D}; pg8::StaticOrder S; S.init(MP, INW, F.G, (int)blockIdx.x);
        pg8::EpiIn E{(pg8::bf16_t*)(ws + WS_Q), (pg8::bf16_t*)(ws + WS_KB), (pg8::bf16_t*)(ws + WS_VB), (pg8::bf16_t*)(ws + WS_XR), (pg8::bf16_t*)(ws + WS_GT),
                     out + O_KP, out + O_VP, out + O_CP, out + O_KS, out + O_VS, out + O_CS};
        pg8::gemm_phase<pg8::EpiIn, pg8::StaticOrder, true, true>(F.lds + RING_OFF, g, S, E);
    }
    {
        LAUNDER();
        pg8::Gemm g{(const pg8::bf16_t*)(ws + WS_PE), (const pg8::bf16_t*)(ws + WS_WPLE_T), MP, D, 256};
        pg8::EpiBf16 E{(pg8::bf16_t*)(ws + WS_PLE), D};
        const int hg = F.G / 2;
        if ((int)blockIdx.x >= hg) { pg8::StaticOrder S; S.init(MP, D, F.G - hg, (int)blockIdx.x - hg); pg8::gemm_phase<pg8::EpiBf16, pg8::StaticOrder, true, true>(F.lds + RING_OFF, g, S, E); }
    }
    LAUNDER();
    {
        bf16 *Qs = (bf16*)(ws + WS_Q) + (size_t)MP * 512, *KBs = (bf16*)(ws + WS_KB) + (size_t)MP * 512, *VBs = (bf16*)(ws + WS_VB) + (size_t)MP * 512, *XRs = (bf16*)(ws + WS_XR) + (size_t)MP * 512, *GTs = (bf16*)(ws + WS_GT) + (size_t)MP * 512;
        float *ks = out + O_KS, *vs = out + O_VS, *cs = out + O_CS;
        sample_gemm(F, (const bf16*)(ws + WS_XB) + (size_t)MP * D, (const bf16*)(ws + WS_WIN_T), INW, D, [&](int row, int col, float v, int c0) {
            const int kind = col >> 9, cc = col & 511, t = row & 7;
            if (kind <= 1 && (c0 & 63) == 0) {
                const float oth = __shfl_xor(v, 8); const int d = cc & 15, i = d & 7;
                const float RC[8] = {0.15915494309189535f, 0.03086376340470123f, 0.005985185712713705f, 0.001160663641240061f, 0.00022507907903927653f, 4.364795279280289e-05f, 8.464330808241401e-06f, 1.6414262627950345e-06f};
                float rc = RC[0];
#pragma unroll
                for (int q = 1; q < 8; ++q) rc = (i == q) ? RC[q] : rc;
                float rv = (float)(PAST + t) * rc; rv = rv - floorf(rv);
                const float c = __builtin_amdgcn_cosf(rv), sn = __builtin_amdgcn_sinf(rv);
                if ((cc & 63) < 16) v = d < 8 ? v * c - oth * sn : v * c + oth * sn;
            }
            if (kind == 0) Qs[(size_t)row * 512 + cc] = (bf16)f2bf(v * 0.18033688011112042f);
            else if (kind == 1) { KBs[(size_t)row * 512 + cc] = (bf16)f2bf(v); ks[(size_t)row * 512 + cc] = v; }
            else if (kind == 2) { VBs[(size_t)row * 512 + cc] = (bf16)f2bf(v); vs[(size_t)row * 512 + cc] = v; }
            else if (kind == 3) { XRs[(size_t)row * 512 + cc] = (bf16)f2bf(v); if (t >= 5) cs[(size_t)((row >> 3) * 3 + (t - 5)) * 512 + cc] = v; }
            else GTs[(size_t)row * 512 + cc] = (bf16)f2bf(v);
        }, F.G / 2, (int)blockIdx.x);
        bf16* PLEs = (bf16*)(ws + WS_PLE) + (size_t)MP * D;
        sample_gemm(F, (const bf16*)(ws + WS_PE) + (size_t)MP * 256, (const bf16*)(ws + WS_WPLE_T), D, 256, [&](int row, int col, float v, int) { PLEs[(size_t)row * D + col] = (bf16)f2bf(v); }, F.G / 2, (int)blockIdx.x);
    }
    xcd_barrier(bar);

    float lam;
    { const float a = wave_sum(((const float*)args.in[10])[F.lane] * ((const float*)args.in[11])[F.lane]);
      const float b = wave_sum(((const float*)args.in[12])[F.lane] * ((const float*)args.in[13])[F.lane]);
      lam = expf(a) - expf(b) + LAM_INIT; }
    const float* subln = (const float*)args.in[14];
    bf16* MIX = (bf16*)(ws + WS_MIX);

    LAUNDER();
    {
        const bf16 *XR = (const bf16*)(ws + WS_XR), *GT = (const bf16*)(ws + WS_GT), *WAT = (const bf16*)(ws + WS_WAT), *WXT = (const bf16*)(ws + WS_WXT);
        const bf16 *Qb = (const bf16*)(ws + WS_Q), *KBb = (const bf16*)(ws + WS_KB), *VBb = (const bf16*)(ws + WS_VB);
        const bool samp_first = (F.vcu & 1) == 0;
        if (samp_first) for (int it = F.vcu; it < NBS * 8; it += F.G) sattn_item(F, it >> 3, it & 7, it, (const float*)args.in[4], (const float*)args.in[5], (const int*)args.in[8], Qb, (float*)(ws + WS_SPART), (float*)(ws + WS_SSTAT));
        for (int pu = F.vcu; pu < 256; pu += F.G) {
            const int bh = pu >> 3, s = pu & 7;
            pattn_unit(F, bh >> 2, bh & 3, s, Qb, KBb, VBb, MIX, lam, subln);
            pattn_unit(F, bh >> 2, bh & 3, 15 - s, Qb, KBb, VBb, MIX, lam, subln);
        }
        for (int u = F.vcu; u < 256; u += F.G) rg_prompt_unit<true>(F, args, u >> 5, (u >> 2) & 7, u & 3, XR, GT, WAT, WXT, MIX, out + O_HP, (float*)(ws + WS_RGC));
        if (!samp_first) for (int it = F.vcu; it < NBS * 8; it += F.G) sattn_item(F, it >> 3, it & 7, it, (const float*)args.in[4], (const float*)args.in[5], (const int*)args.in[8], Qb, (float*)(ws + WS_SPART), (float*)(ws + WS_SSTAT));
    }
    xcd_barrier(bar);

    LAUNDER();
    {
        const int gw = F.vcu * NWAVES + F.wave, NGW = F.G * NWAVES;
        for (int u = F.vcu; u < 256; u += F.G) rg_prompt_unit<false>(F, args, u >> 5, (u >> 2) & 7, u & 3, (const bf16*)(ws + WS_XR), (const bf16*)(ws + WS_GT), (const bf16*)(ws + WS_WAT), (const bf16*)(ws + WS_WXT), MIX, out + O_HP, (float*)(ws + WS_RGC));
        for (int u = NGW - 1 - gw; u < NBS * 8; u += NGW) rg_sample_unit(F, args, u >> 3, u & 7, (const bf16*)(ws + WS_XR), (const bf16*)(ws + WS_GT), (const bf16*)(ws + WS_WAT), (const bf16*)(ws + WS_WXT), MIX, out + O_HS);
        for (int u = gw; u < NBS * 4 * 8; u += NGW) scomb_unit(F, u >> 5, (u >> 3) & 3, u & 7, (const bf16*)(ws + WS_Q), (const bf16*)(ws + WS_KB), (const bf16*)(ws + WS_VB), (const float*)(ws + WS_SPART), (const float*)(ws + WS_SSTAT), MIX, lam, subln);
    }
    xcd_barrier(bar);

    LAUNDER();
    {
        pg8::Gemm g{(const pg8::bf16_t*)(ws + WS_MIX), (const pg8::bf16_t*)(ws + WS_WOUT_T), MP, D, D}; pg8::StaticOrder S; S.init(MP, D, F.G, (int)blockIdx.x);
        pg8::EpiPre1 E{(const pg8::bf16_t*)(ws + WS_XB), (pg8::bf16_t*)(ws + WS_PRE1), ALPHA};
        pg8::gemm_phase<pg8::EpiPre1, pg8::StaticOrder, true, true>(F.lds + RING_OFF, g, S, E);
        { const float* xs = (const float*)args.in[1]; bf16* PRE1s = (bf16*)(ws + WS_PRE1) + (size_t)MP * D;
          sample_gemm_ks(F, (const bf16*)(ws + WS_MIX) + (size_t)MP * D, (const bf16*)(ws + WS_WOUT_T), D,
              [&](int row, int col) { return *(const GAS f32x2v_t*)(xs + (size_t)row * D + col); },
              [&](int row, int col, float v0, float v1, const f32x2v_t& x) { *(GAS unsigned*)(PRE1s + (size_t)row * D + col) = pk2(ALPHA * x.x + v0, ALPHA * x.y + v1); }); }
    }
    xcd_barrier(bar);

    LAUNDER();
    {
        const int gw = F.vcu * NWAVES + F.wave, NGW = F.G * NWAVES;
        {
            const bf16* PRE = (const bf16*)(ws + WS_PRE1);
            size_t rc[3], rn[3]; LnRaw<3> cur, nxt;
#pragma unroll
            for (int r = 0; r < 3; ++r) rc[r] = (size_t)(gw + r * NGW < M ? gw + r * NGW : M - 1);
            ln1_load<3>(cur, F.lane, PRE, rc);
            for (int m0 = gw; m0 < M; m0 += 3 * NGW) {
#pragma unroll
                for (int r = 0; r < 3; ++r) { const int m = m0 + (3 + r) * NGW; rn[r] = (size_t)(m < M ? m : M - 1); }
                ln1_load<3>(nxt, F.lane, PRE, rn);
                ln1_rows<3>(cur, F.lane, rc, (const float*)args.in[23], (const float*)args.in[24], (float*)(ws + WS_X1), (bf16*)(ws + WS_X1B), ws + WS_X1Q, (float*)(ws + WS_SX));
#pragma unroll
                for (int r = 0; r < 3; ++r) ((GAS u32x2v_t*)((int*)(ws + WS_PART) + rc[r] * 128))[F.lane] = (u32x2v_t){0u, 0u};
                cur = nxt;
#pragma unroll
                for (int r = 0; r < 3; ++r) rc[r] = rn[r];
            }
        }
    }
    xcd_barrier(bar);

    LAUNDER();
    {
        pg8::Gemm g{(const pg8::bf16_t*)(ws + WS_X1B), (const pg8::bf16_t*)(ws + WS_WQ_T), MP, 2048, D}; pg8::StaticOrder S; S.init(MP, 2048, F.G, (int)blockIdx.x);
        pg8::EpiBf16 E{(pg8::bf16_t*)(ws + WS_PQ), 2048};
        pg8::gemm_phase<pg8::EpiBf16, pg8::StaticOrder, true, true>(F.lds + RING_OFF, g, S, E);
        { bf16* PQs = (bf16*)(ws + WS_PQ) + (size_t)MP * 2048;
          sample_gemm_ks(F, (const bf16*)(ws + WS_X1B) + (size_t)MP * D, (const bf16*)(ws + WS_WQ_T), 2048,
              [&](int, int) { return 0; },
              [&](int row, int col, float v0, float v1, int) { *(GAS unsigned*)(PQs + (size_t)row * 2048 + col) = pk2(v0, v1); }); }
    }
    xcd_barrier(bar);

    LAUNDER();
    {
        const int h5 = F.vcu & 7, cg = F.vcu >> 3, ngr = F.G >> 3, NTG = M / 32;
        { const GAS v4u* ksrc = (const GAS v4u*)((const bf16*)(ws + WS_KEYS) + (size_t)h5 * 2 * 16384);
#pragma unroll
          for (int i = 0; i < 8; ++i) { const int gch = F.tid + 512 * i, row = gch >> 4, c = gch & 15;
              *(LAS v4u*)(F.lds + RING_OFF + TK_KEYS_OFF + row * 256 + ((c ^ (row & 15)) * 16)) = ksrc[gch]; }
          __syncthreads(); }
        const int ntg = cg < NTG ? (NTG - cg + ngr - 1) / ngr : 0;
        { bf16x8 qn[8], kn[8];
          if (F.wave < ntg) peer_topk_prefetch(F.lane, __builtin_amdgcn_readfirstlane(cg + ngr * F.wave), h5, 0, (const bf16*)(ws + WS_PQ), (const bf16*)(ws + WS_KEYS), qn, kn);
          for (int j = F.wave; j < ntg; j += NWAVES) { const int jn = j + NWAVES;
              peer_topk_unit(F, __builtin_amdgcn_readfirstlane(cg + ngr * j), h5, __builtin_amdgcn_readfirstlane(cg + ngr * jn), h5, jn < ntg, qn, kn,
                             (const bf16*)(ws + WS_PQ), (const bf16*)(ws + WS_KEYS), (int*)(ws + WS_EIDX), (unsigned short*)(ws + WS_EIDXP), (float*)(ws + WS_GW)); } }
        { const bool std = (F.G == 256);
          const bool extra = std && F.vcu < 64 && F.wave == 0;
          const int lin = F.vcu * NWAVES + F.wave;
          const int before = std ? (F.vcu < 64 ? F.vcu + (F.wave > 0 ? 1 : 0) : 64) : 0;
          const int ncv = F.G * NWAVES - (std ? 64 : 0);
          if (!extra) for (int c = lin - before; c < 4096; c += ncv) {
              if (c < 2048) convert_i8_rows8((const float*)args.in[27], ws + WS_U, (float*)(ws + WS_USC), c * 8, F.lane);
              else convert_i8_rows8((const float*)args.in[28], ws + WS_V, (float*)(ws + WS_VSC), (c - 2048) * 8, F.lane);
          } }
    }
    xcd_barrier(bar);

    LAUNDER();
    {
        const unsigned char* X1Q = ws + WS_X1Q; const unsigned char* U8S = ws + WS_U; const unsigned short* EIDXP = (const unsigned short*)(ws + WS_EIDXP); int* PART = (int*)(ws + WS_PART);
        { const int cps = F.G >> 3, sl = F.vcu / cps, nws = cps * NWAVES, tpw = (M + nws - 1) / nws, tb = ((F.vcu % cps) * NWAVES + F.wave) * tpw, te = tb + tpw < M ? tb + tpw : M;
          if (sl < 8 && tb < te) peer_slice_stream<true>(F, sl, tb, te, U8S, EIDXP, X1Q, nullptr, PART); }
    }
    xcd_barrier(bar);

    LAUNDER();
    {
        const int gw = F.vcu * NWAVES + F.wave, NGW = F.G * NWAVES;
        for (int m0 = gw; m0 < M; m0 += 9 * NGW) {
            size_t toks[9];
#pragma unroll
            for (int r = 0; r < 9; ++r) toks[r] = (size_t)(m0 + r * NGW < M ? m0 + r * NGW : M - 1);
            peer_reduce_tokens<9>(F.lane, toks, (const int*)(ws + WS_PART), (const int*)(ws + WS_EIDX), (const float*)(ws + WS_USC), (const float*)(ws + WS_VSC), (const float*)(ws + WS_SX), (const float*)(ws + WS_GW), ws + WS_WQ, (float*)(ws + WS_SW));
        }
    }
    xcd_barrier(bar);

    LAUNDER();
    {
        const unsigned char* V8S = ws + WS_V; const unsigned short* EIDXP = (const unsigned short*)(ws + WS_EIDXP); float* FFN = (float*)(ws + WS_FFN);
        { const int cps = F.G >> 3, sl = F.vcu / cps, nws = cps * NWAVES, tpw = (M + nws - 1) / nws, tb = ((F.vcu % cps) * NWAVES + F.wave) * tpw, te = tb + tpw < M ? tb + tpw : M;
          if (sl < 8 && tb < te) peer_slice_stream<false>(F, sl, tb, te, V8S, EIDXP, ws + WS_WQ, (const float*)(ws + WS_SW), FFN); }
    }
    xcd_barrier(bar);

    LAUNDER();
    {
        const int gw = F.vcu * NWAVES + F.wave, NGW = F.G * NWAVES;
        {
            const bf16* X1Bp = (const bf16*)(ws + WS_X1B); const bf16* FFNp = (const bf16*)(ws + WS_FFN);
            size_t rc[3], rn[3]; Ln2Raw<3> cur, nxt;
#pragma unroll
            for (int r = 0; r < 3; ++r) rc[r] = (size_t)(gw + r * NGW < M ? gw + r * NGW : M - 1);
            ln2_load<3>(cur, F.lane, X1Bp, FFNp, rc);
            for (int m0 = gw; m0 < M; m0 += 3 * NGW) {
#pragma unroll
                for (int r = 0; r < 3; ++r) { const int m = m0 + (3 + r) * NGW; rn[r] = (size_t)(m < M ? m : M - 1); }
                ln2_load<3>(nxt, F.lane, X1Bp, FFNp, rn);
                ln2_rows<3>(cur, F.lane, rc, (const float*)args.in[29], (const float*)args.in[30], (float*)(ws + WS_X2), (bf16*)(ws + WS_X2B));
                cur = nxt;
#pragma unroll
                for (int r = 0; r < 3; ++r) rc[r] = rn[r];
            }
        }
    }
    xcd_barrier(bar);

    LAUNDER();
    {
        pg8::Gemm g{(const pg8::bf16_t*)(ws + WS_X2B), (const pg8::bf16_t*)(ws + WS_WG_T), MP, D, D}; pg8::StaticOrder S; S.init(MP, D, F.G, (int)blockIdx.x);
        pg8::EpiFinal E{(const pg8::bf16_t*)(ws + WS_X2B), (const pg8::bf16_t*)(ws + WS_PLE), (const float*)args.in[33], out + O_YP, out + O_YS, (float*)(ws + WS_PRE1)};
        pg8::gemm_phase<pg8::EpiFinal, pg8::StaticOrder, true, true>(F.lds + RING_OFF, g, S, E);
        { const bf16* X2Bs = (const bf16*)(ws + WS_X2B) + (size_t)MP * D; const bf16* PLEs = (const bf16*)(ws + WS_PLE) + (size_t)MP * D; const float* gb = (const float*)args.in[33]; float* ys = out + O_YS;
          struct P7Pre { unsigned x2, pl; f32x2v_t g; };
          sample_gemm_ks(F, X2Bs, (const bf16*)(ws + WS_WG_T), D,
              [&](int row, int col) { P7Pre q; q.x2 = *(const GAS unsigned*)(X2Bs + (size_t)row * D + col); q.pl = *(const GAS unsigned*)(PLEs + (size_t)row * D + col); q.g = *(const GAS f32x2v_t*)(gb + col); return q; },
              [&](int row, int col, float v0, float v1, const P7Pre& q) {
                  const float s0 = __builtin_amdgcn_rcpf(1.0f + __builtin_amdgcn_exp2f(-1.4426950408889634f * (v0 + q.g.x))), s1 = __builtin_amdgcn_rcpf(1.0f + __builtin_amdgcn_exp2f(-1.4426950408889634f * (v1 + q.g.y)));
                  f32x2v_t o; o.x = bf_lo(q.x2) + s0 * bf_lo(q.pl); o.y = bf_hi(q.x2) + s1 * bf_hi(q.pl);
                  *(GAS f32x2v_t*)(ys + (size_t)row * D + col) = o; }); }
    }
}

extern "C" void kernel_launch(void* const* d_in, const int* in_sizes, int n_in, void* d_out, int out_size, void* d_ws, size_t ws_size, hipStream_t stream) {
    static int grid = 0;
    if (grid == 0) {
        if (n_in != 34 || (size_t)out_size != O_END || ws_size < WS_END) { fprintf(stderr, "kernel_launch: unexpected shapes (n_in %d out %d ws %zu)\n", n_in, out_size, ws_size); grid = -1; return; }
        int dev = 0, cus = 0, per_cu = 0;
        if (hipGetDevice(&dev) != hipSuccess || hipDeviceGetAttribute(&cus, hipDeviceAttributeMultiprocessorCount, dev) != hipSuccess) { grid = -1; return; }
        if (hipFuncSetAttribute((const void*)mega_fwd, hipFuncAttributeMaxDynamicSharedMemorySize, LDS_BYTES) != hipSuccess) { fprintf(stderr, "kernel_launch: hipFuncSetAttribute failed\n"); grid = -1; return; }
        if (hipOccupancyMaxActiveBlocksPerMultiprocessor(&per_cu, (const void*)mega_fwd, NWAVES * 64, LDS_BYTES) != hipSuccess || per_cu < 1) { fprintf(stderr, "kernel_launch: occupancy query says %d\n", per_cu); }
        (void)hipGetLastError();
        grid = cus;
    }
    if (grid < 0) return;
    if (hipMemsetAsync((char*)d_ws + WS_CTL, 0, CTL_ZERO_BYTES, stream) != hipSuccess) return;
    Args a{};
    for (int i = 0; i < 34; ++i) a.in[i] = d_in[i];
    a.out = (float*)d_out; a.ws = (unsigned char*)d_ws;
    hipLaunchKernelGGL(mega_fwd, dim3(grid), dim3(NWAVES * 64), LDS_BYTES, stream, a);
}
```

```cpp
#include <hip/hip_runtime.h>
#include <cstdio>
#include <cstdint>
namespace pg8 {
#define PG8_LAS __attribute__((address_space(3)))
typedef unsigned short bf16_t;
typedef short bf16x8 __attribute__((ext_vector_type(8)));
typedef float f32x4 __attribute__((ext_vector_type(4)));
typedef unsigned u32x4 __attribute__((ext_vector_type(4)));
constexpr int BM = 256, BK = 64, HALF = 128, HTB = HALF * BK * 2  , STAGE_BYTES = 8 * HTB, NXCD = 8, WGM = 8;

__host__ __device__ __forceinline__ int lds_byte(int r, int c) { const int st = (r >> 4) * 2 + (c >> 5), rr = r & 15, cc = c & 31, ob = rr * 64 + cc * 2; return st * 1024 + (ob ^ (((ob >> 9) & 1) << 5)); }
__host__ __device__ __forceinline__ void stage_rc(int b, int& R, int& C) { const int st = b / 1024, sb = b % 1024, swz = sb ^ (((sb >> 9) & 1) << 5); R = (st >> 1) * 16 + swz / 64; C = (st & 1) * 32 + (swz % 64) / 2; }
__host__ __device__ __forceinline__ int perm32(int rho) { const int n = rho >> 4, i = rho & 15; return 8 * (i >> 2) + 4 * n + (i & 3); }

struct Unit { int pm, pn; };
struct Gemm { const bf16_t* A; const bf16_t* Bt; int M, N, K; };

struct StaticOrder {
    int nM, nN, nwg, G, c;
    __host__ __device__ void init(int M, int N, int G_, int c_) { nM = M / BM; nN = N / BM; nwg = nM * nN; G = G_; c = c_; }
    __host__ __device__ bool next(int i, Unit& u) const {
        const long L = (long)i * G + c; if (L >= nwg) return false;
        int wgid = (int)L; { const int q = nwg / NXCD, r = nwg % NXCD, xcd = wgid % NXCD, off = wgid / NXCD; wgid = (xcd < r ? xcd * (q + 1) : r * (q + 1) + (xcd - r) * q) + off; }
        const int nig = WGM * nN, gid = wgid / nig, fm = gid * WGM, gsz = (nM - fm) < WGM ? (nM - fm) : WGM;
        u.pm = fm + ((wgid % nig) % gsz); u.pn = (wgid % nig) / gsz; return true;
    }
    __device__ __forceinline__ void a_ready(const Unit&) const {}
    __device__ __forceinline__ void done(const Unit&) const {}
};

__device__ __forceinline__ unsigned cvt_pk_bf16(float lo, float hi) { unsigned r; asm volatile("v_cvt_pk_bf16_f32 %0, %1, %2" : "=v"(r) : "v"(lo), "v"(hi)); return r; }
typedef float f32x2 __attribute__((ext_vector_type(2)));
typedef unsigned u32x2 __attribute__((ext_vector_type(2)));

struct EpiBf16 {
    static constexpr bool PERM = true, AFTER_DRAIN = false;
    bf16_t* O; int ldc;
    __device__ __forceinline__ void operator()(const f32x4 (&acc)[2][2][4][2], const Unit& u, int wr, int wc, int fr, int fq) const {
        const int row0 = u.pm * BM + wr * 64 + fr; const int col0 = u.pn * BM + wc * 32 + 8 * fq;
#pragma unroll
        for (int ai = 0; ai < 2; ++ai)
#pragma unroll
            for (int m = 0; m < 4; ++m) { bf16_t* rowp = O + (size_t)(row0 + ai * HALF + m * 16) * ldc + col0;
#pragma unroll
                for (int bj = 0; bj < 2; ++bj) { const f32x4 v0 = acc[ai][bj][m][0], v1 = acc[ai][bj][m][1];
                    u32x4 w; w.x = cvt_pk_bf16(v0[0], v0[1]); w.y = cvt_pk_bf16(v0[2], v0[3]); w.z = cvt_pk_bf16(v1[0], v1[1]); w.w = cvt_pk_bf16(v1[2], v1[3]);
                    *(u32x4*)(rowp + bj * HALF) = w; } }
    }
};

struct PleOrder {
    int c, G;
    __device__ __forceinline__ bool next(int i, Unit& u) const { const int h = G / 2; if (c < h) return false; const int L = (c - h) + (G - h) * i; if (L >= 256) return false; u.pm = L >> 2; u.pn = L & 3; return true; }
    __device__ __forceinline__ void a_ready(const Unit&) const {}
    __device__ __forceinline__ void done(const Unit&) const {}
};
struct EpiIn {
    static constexpr bool PERM = true, AFTER_DRAIN = false;
    bf16_t *Q, *KB, *VB, *XR, *GT; float *kp, *vp, *cp, *ks, *vs, *cs;
    __device__ __forceinline__ void operator()(const f32x4 (&acc)[2][2][4][2], const Unit& u, int wr, int wc, int fr, int fq) const {
        const int kind = u.pn >> 1; const bool samp = (u.pm == 64);
        const int colt = (u.pn & 1) * 256 + wc * 32 + 8 * fq;
        const int row0 = u.pm * BM + wr * 64 + fr;
        const bool rot = (kind <= 1) && ((wc & 1) == 0);
        const float RC[8] = {0.15915494309189535f, 0.03086376340470123f, 0.005985185712713705f, 0.001160663641240061f, 0.00022507907903927653f, 4.364795279280289e-05f, 8.464330808241401e-06f, 1.6414262627950345e-06f};
        const float C2 = 0.18033688011112042f;
#pragma unroll
        for (int ai = 0; ai < 2; ++ai)
#pragma unroll
            for (int m = 0; m < 4; ++m) {
                const int row = row0 + ai * HALF + m * 16;
                const int sp = samp ? ((row - 16384) & 7) : (row & 2047);
                const float pos = (float)(samp ? 8192 + sp : sp);
                float cs_[8], sn_[8];
                if (rot) {
#pragma unroll
                    for (int j = 0; j < 8; ++j) { float rv = pos * RC[j]; rv = rv - floorf(rv); cs_[j] = __builtin_amdgcn_cosf(rv); sn_[j] = __builtin_amdgcn_sinf(rv); }
                }
#pragma unroll
                for (int bj = 0; bj < 2; ++bj) {
                    f32x4 v0 = acc[ai][bj][m][0], v1 = acc[ai][bj][m][1];
                    const int col = colt + bj * HALF;
                    if (rot) {
                        float mine[8] = {v0[0], v0[1], v0[2], v0[3], v1[0], v1[1], v1[2], v1[3]};
                        float res[8];
#pragma unroll
                        for (int j = 0; j < 8; ++j) { const float oth = __shfl_xor(mine[j], 16); const float t = (fq == 0) ? -oth : oth; res[j] = mine[j] * cs_[j] + t * sn_[j]; }
                        if (fq < 2) { v0 = (f32x4){res[0], res[1], res[2], res[3]}; v1 = (f32x4){res[4], res[5], res[6], res[7]}; }
                    }
                    if (kind == 0) { v0 = v0 * C2; v1 = v1 * C2; }
                    u32x4 w; w.x = cvt_pk_bf16(v0[0], v0[1]); w.y = cvt_pk_bf16(v0[2], v0[3]); w.z = cvt_pk_bf16(v1[0], v1[1]); w.w = cvt_pk_bf16(v1[2], v1[3]);
                    bf16_t* dst = kind == 0 ? Q : kind == 1 ? KB : kind == 2 ? VB : kind == 3 ? XR : GT;
                    *(u32x4*)(dst + (size_t)row * 512 + col) = w;
                    if (kind == 1 || kind == 2) {
                        float* o = samp ? ((kind == 1 ? ks : vs) + (size_t)(row - 16384) * 512 + col) : ((kind == 1 ? kp : vp) + (size_t)row * 512 + col);
                        *(f32x4*)o = v0; *(f32x4*)(o + 4) = v1;
                    } else if (kind == 3) {
                        if (samp) { if (sp >= 5) { float* o = cs + (size_t)(((row - 16384) >> 3) * 3 + (sp - 5)) * 512 + col; *(f32x4*)o = v0; *(f32x4*)(o + 4) = v1; } }
                        else { if (sp >= 2045) { float* o = cp + (size_t)((row >> 11) * 3 + (sp - 2045)) * 512 + col; *(f32x4*)o = v0; *(f32x4*)(o + 4) = v1; } }
                    }
                }
            }
    }
};

struct EpiPre1 {
    static constexpr bool PERM = true, AFTER_DRAIN = false;
    const bf16_t* xb; bf16_t* C; float alpha;
    __device__ __forceinline__ void operator()(const f32x4 (&acc)[2][2][4][2], const Unit& u, int wr, int wc, int fr, int fq) const {
        const int row0 = u.pm * BM + wr * 64 + fr, col0 = u.pn * BM + wc * 32 + 8 * fq;
#pragma unroll
        for (int ai = 0; ai < 2; ++ai)
#pragma unroll
            for (int m = 0; m < 4; ++m) { const size_t off = (size_t)(row0 + ai * HALF + m * 16) * 1024 + col0;
#pragma unroll
                for (int bj = 0; bj < 2; ++bj) { const u32x4 xr = *(const u32x4*)(xb + off + bj * HALF); const unsigned x0 = xr[0], x1 = xr[1], x2 = xr[2], x3 = xr[3];
                    const f32x4 xa = (f32x4){__builtin_bit_cast(float, x0 << 16), __builtin_bit_cast(float, x0 & 0xffff0000u), __builtin_bit_cast(float, x1 << 16), __builtin_bit_cast(float, x1 & 0xffff0000u)};
                    const f32x4 xc = (f32x4){__builtin_bit_cast(float, x2 << 16), __builtin_bit_cast(float, x2 & 0xffff0000u), __builtin_bit_cast(float, x3 << 16), __builtin_bit_cast(float, x3 & 0xffff0000u)};
                    const f32x4 v0 = acc[ai][bj][m][0] + xa * alpha, v1 = acc[ai][bj][m][1] + xc * alpha;
                    u32x4 w; w.x = cvt_pk_bf16(v0[0], v0[1]); w.y = cvt_pk_bf16(v0[2], v0[3]); w.z = cvt_pk_bf16(v1[0], v1[1]); w.w = cvt_pk_bf16(v1[2], v1[3]);
                    *(u32x4*)(C + off + bj * HALF) = w; } }
    }
};

struct EpiFinal {
    static constexpr bool PERM = false, AFTER_DRAIN = false;
    const bf16_t* X2B; const bf16_t* PLE; const float* gb; float *yp, *ys; float* ZD;
    __device__ __forceinline__ void operator()(const f32x4 (&acc)[2][2][4][2], const Unit& u, int wr, int wc, int fr, int fq) const {
        const int row0 = u.pm * BM + wr * 64 + fr, col0 = u.pn * BM + wc * 32 + 4 * fq;
        float* yb = (u.pm == 64) ? (ys - (size_t)16384 * 1024) : yp;
        f32x4 bv[2][2];
#pragma unroll
        for (int bj = 0; bj < 2; ++bj)
#pragma unroll
            for (int n = 0; n < 2; ++n) bv[bj][n] = *(const f32x4*)(gb + col0 + bj * HALF + n * 16);
#pragma unroll
        for (int ai = 0; ai < 2; ++ai)
#pragma unroll
            for (int m = 0; m < 4; ++m) { const size_t off = (size_t)(row0 + ai * HALF + m * 16) * 1024 + col0;
#pragma unroll
                for (int bj = 0; bj < 2; ++bj)
#pragma unroll
                    for (int n = 0; n < 2; ++n) {
                        const u32x2 xr = *(const u32x2*)(X2B + off + bj * HALF + n * 16); const unsigned xr0 = xr[0], xr1 = xr[1];
                        const f32x4 x2 = (f32x4){__builtin_bit_cast(float, xr0 << 16), __builtin_bit_cast(float, xr0 & 0xffff0000u), __builtin_bit_cast(float, xr1 << 16), __builtin_bit_cast(float, xr1 & 0xffff0000u)};
                        const u32x2 pr = *(const u32x2*)(PLE + off + bj * HALF + n * 16);
                        const unsigned p0 = pr[0], p1 = pr[1];
                        const f32x4 pl = (f32x4){__builtin_bit_cast(float, p0 << 16), __builtin_bit_cast(float, p0 & 0xffff0000u), __builtin_bit_cast(float, p1 << 16), __builtin_bit_cast(float, p1 & 0xffff0000u)};
                        const f32x4 z = acc[ai][bj][m][n] + bv[bj][n]; f32x4 o;
#pragma unroll
                        for (int e = 0; e < 4; ++e) { const float s = __builtin_amdgcn_rcpf(1.0f + __builtin_amdgcn_exp2f(-1.4426950408889634f * z[e])); o[e] = x2[e] + s * pl[e]; }
                        *(f32x4*)(yb + off + bj * HALF + n * 16) = o;
                    } }
    }
};

template <class Epi, class Sched, bool ALIGN_EPI = false, bool SP2 = false>
__device__ __forceinline__ void gemm_phase(PG8_LAS unsigned char* lds, const Gemm g, const Sched& S, const Epi& E) {
    int tid_ = threadIdx.x; asm volatile("" : "+v"(tid_)); const int tid = tid_, wid = __builtin_amdgcn_readfirstlane(tid >> 6), lane = tid & 63, wr = wid >> 2, wc = wid & 3, fr = lane & 15, fq = lane >> 4;
    const int K = g.K, nt = K / BK;
    unsigned voffA[2], voffB[2];
#pragma unroll
    for (int i = 0; i < 2; ++i) { int R, C; stage_rc(tid * 16 + i * 8192, R, C); const int Rb = Epi::PERM ? ((R & ~31) + perm32(R & 31)) : R;
        voffA[i] = (unsigned)(R * K + C) * 2u; voffB[i] = (unsigned)(Rb * K + C) * 2u; }
    const size_t kstep = (size_t)(BK * 2);
    const size_t hstep = (size_t)HALF * K * 2;
    const size_t tstep = 2 * hstep;
    const unsigned ldsw = (unsigned)wid * 1024u;
    const int aoff = lds_byte(wr * 64 + fr, fq * 8), boff = lds_byte(wc * 32 + fr, fq * 8);
#define PG8_SA(b, h) (((b) * 2 + (h)) * HTB)
#define PG8_SB(b, h) ((4 + (b) * 2 + (h)) * HTB)
#define PG8_STAGE(bufoff, gbase, voff) do { _Pragma("unroll") for (int _i = 0; _i < 2; ++_i) \
        __builtin_amdgcn_global_load_lds((const unsigned*)((const char*)(gbase) + (voff)[_i]), (PG8_LAS unsigned*)(lds + (bufoff) + ldsw + _i * 8192), 16, 0, 0); } while (0)
#define PG8_LDA(dst, b, h) do { _Pragma("unroll") for (int m = 0; m < 4; ++m) _Pragma("unroll") for (int k = 0; k < 2; ++k) dst[m][k] = *(const PG8_LAS bf16x8*)(lds + PG8_SA(b, h) + aoff + m * 2048 + k * 1024); } while (0)
#define PG8_LDB(dst, b, h) do { _Pragma("unroll") for (int n = 0; n < 2; ++n) _Pragma("unroll") for (int k = 0; k < 2; ++k) dst[n][k] = *(const PG8_LAS bf16x8*)(lds + PG8_SB(b, h) + boff + n * 2048 + k * 1024); } while (0)
#define PG8_MMA(ai, bj, At, Bt) do { __builtin_amdgcn_s_setprio(1); _Pragma("unroll") for (int m = 0; m < 4; ++m) _Pragma("unroll") for (int n = 0; n < 2; ++n) _Pragma("unroll") for (int k = 0; k < 2; ++k) \
        acc[ai][bj][m][n] = __builtin_amdgcn_mfma_f32_16x16x32_bf16(Bt[n][k], At[m][k], acc[ai][bj][m][n], 0, 0, 0); __builtin_amdgcn_s_setprio(0); } while (0)
#define PG8_WAIT_V(n) asm volatile("s_waitcnt vmcnt(" #n ")" ::: "memory")
#define PG8_WAIT_L(n) asm volatile("s_waitcnt lgkmcnt(" #n ")" ::: "memory")
#define PG8_BAR __builtin_amdgcn_s_barrier()
#define PG8_SCHED __builtin_amdgcn_sched_barrier(0)
    Unit cur, nxt; int ui = 0;
    if (!S.next(0, cur)) return;
    f32x4 acc[2][2][4][2];
#pragma unroll
    for (int a = 0; a < 2; ++a)
#pragma unroll
        for (int b = 0; b < 2; ++b)
#pragma unroll
            for (int m = 0; m < 4; ++m)
#pragma unroll
                for (int n = 0; n < 2; ++n) acc[a][b][m][n] = (f32x4){0.f, 0.f, 0.f, 0.f};
    bf16x8 At[4][2], B0[2][2], B1[2][2];
    const char* cA = (const char*)g.A + (size_t)cur.pm * tstep; const char* cB = (const char*)g.Bt + (size_t)cur.pn * tstep;
    S.a_ready(cur);
    if constexpr (SP2) {
        PG8_STAGE(PG8_SB(0, 0), cB, voffB); PG8_STAGE(PG8_SB(0, 1), cB + hstep, voffB); PG8_STAGE(PG8_SA(0, 0), cA, voffA); PG8_STAGE(PG8_SA(0, 1), cA + hstep, voffA);
        if (wr == 1) PG8_BAR;
        PG8_WAIT_V(2); PG8_BAR;
        PG8_STAGE(PG8_SB(1, 0), cB + kstep, voffB); PG8_STAGE(PG8_SA(1, 0), cA + kstep, voffA); PG8_STAGE(PG8_SB(1, 1), cB + hstep + kstep, voffB);
        PG8_WAIT_V(6); PG8_BAR;
    } else {
        PG8_STAGE(PG8_SB(0, 0), cB, voffB); PG8_STAGE(PG8_SA(0, 0), cA, voffA); PG8_STAGE(PG8_SB(0, 1), cB + hstep, voffB); PG8_STAGE(PG8_SA(0, 1), cA + hstep, voffA);
        if (wr == 1) PG8_BAR;
        PG8_WAIT_V(4); PG8_BAR;
        PG8_STAGE(PG8_SB(1, 0), cB + kstep, voffB); PG8_STAGE(PG8_SA(1, 0), cA + kstep, voffA); PG8_STAGE(PG8_SB(1, 1), cB + hstep + kstep, voffB);
        PG8_WAIT_V(6); PG8_BAR;
    }
    for (;;) {
        const bool has_next = S.next(ui + 1, nxt);
        const char* nA = has_next ? (const char*)g.A + (size_t)nxt.pm * tstep : cA; const char* nB = has_next ? (const char*)g.Bt + (size_t)nxt.pn * tstep : cB;
        for (int t = 0; t < nt; t += 2) {
            const bool last = (t == nt - 2);
            const char* a1 = cA + (size_t)(t + 1) * kstep;
            const char* a2 = last ? nA : cA + (size_t)(t + 2) * kstep; const char* b2 = last ? nB : cB + (size_t)(t + 2) * kstep;
            const char* a3 = a2 + kstep; const char* b3 = b2 + kstep;
            if (last && has_next) S.a_ready(nxt);
            if constexpr (SP2) {
            PG8_LDB(B0, 0, 0); PG8_LDB(B1, 0, 1); PG8_SCHED; PG8_LDA(At, 0, 0); PG8_STAGE(PG8_SA(1, 1), a1 + hstep, voffA);
            PG8_WAIT_V(8); PG8_WAIT_L(0); PG8_BAR; PG8_MMA(0, 0, At, B0); PG8_MMA(0, 1, At, B1); PG8_BAR; PG8_SCHED;
            PG8_LDA(At, 0, 1); PG8_STAGE(PG8_SB(0, 0), b2, voffB); PG8_STAGE(PG8_SB(0, 1), b2 + hstep, voffB); PG8_STAGE(PG8_SA(0, 0), a2, voffA);
            PG8_WAIT_V(8); PG8_WAIT_L(0); PG8_BAR; PG8_MMA(1, 0, At, B0); PG8_MMA(1, 1, At, B1); PG8_BAR; PG8_SCHED;
            PG8_LDB(B0, 1, 0); PG8_LDB(B1, 1, 1); PG8_SCHED; PG8_LDA(At, 1, 0); PG8_STAGE(PG8_SA(0, 1), a2 + hstep, voffA);
            PG8_WAIT_V(8); PG8_WAIT_L(0); PG8_BAR; PG8_MMA(0, 0, At, B0); PG8_MMA(0, 1, At, B1); PG8_BAR; PG8_SCHED;
            PG8_LDA(At, 1, 1); PG8_STAGE(PG8_SB(1, 0), b3, voffB); PG8_STAGE(PG8_SB(1, 1), b3 + hstep, voffB); PG8_STAGE(PG8_SA(1, 0), a3, voffA);
            PG8_WAIT_V(8); PG8_WAIT_L(0); PG8_BAR; PG8_MMA(1, 0, At, B0); PG8_MMA(1, 1, At, B1); PG8_BAR; PG8_SCHED;
            } else {
            PG8_LDB(B0, 0, 0); PG8_SCHED; PG8_LDA(At, 0, 0); PG8_STAGE(PG8_SA(1, 1), a1 + hstep, voffA);
            PG8_WAIT_L(8); PG8_BAR; PG8_WAIT_L(0); PG8_MMA(0, 0, At, B0); PG8_BAR; PG8_SCHED;
            PG8_LDB(B1, 0, 1); PG8_STAGE(PG8_SB(0, 0), b2, voffB);
            PG8_BAR; PG8_WAIT_L(0); PG8_MMA(0, 1, At, B1); PG8_BAR;
            PG8_LDA(At, 0, 1); PG8_STAGE(PG8_SA(0, 0), a2, voffA);
            PG8_BAR; PG8_WAIT_L(0); PG8_MMA(1, 0, At, B0); PG8_BAR; PG8_SCHED;
            PG8_STAGE(PG8_SB(0, 1), b2 + hstep, voffB);
            PG8_WAIT_V(6); PG8_BAR; PG8_MMA(1, 1, At, B1); PG8_BAR;
            PG8_LDB(B0, 1, 0); PG8_SCHED; PG8_LDA(At, 1, 0); PG8_STAGE(PG8_SA(0, 1), a2 + hstep, voffA);
            PG8_WAIT_L(8); PG8_BAR; PG8_WAIT_L(0); PG8_MMA(0, 0, At, B0); PG8_BAR; PG8_SCHED;
            PG8_LDB(B1, 1, 1); PG8_STAGE(PG8_SB(1, 0), b3, voffB);
            PG8_BAR; PG8_WAIT_L(0); PG8_MMA(0, 1, At, B1); PG8_BAR;
            PG8_LDA(At, 1, 1); PG8_STAGE(PG8_SA(1, 0), a3, voffA);
            PG8_BAR; PG8_WAIT_L(0); PG8_MMA(1, 0, At, B0); PG8_BAR; PG8_SCHED;
            PG8_STAGE(PG8_SB(1, 1), b3 + hstep, voffB);
            PG8_WAIT_V(6); PG8_BAR; PG8_MMA(1, 1, At, B1); PG8_BAR;
            }
        }
        if constexpr (ALIGN_EPI) { if (wr == 0) PG8_BAR; }
        if constexpr (!Epi::AFTER_DRAIN) { E(acc, cur, wr, wc, fr, fq); S.done(cur); }
        if (!has_next) break;
#pragma unroll
        for (int a = 0; a < 2; ++a)
#pragma unroll
            for (int b = 0; b < 2; ++b)
#pragma unroll
                for (int m = 0; m < 4; ++m)
#pragma unroll
                    for (int n = 0; n < 2; ++n) acc[a][b][m][n] = (f32x4){0.f, 0.f, 0.f, 0.f};
        cur = nxt; cA = nA; cB = nB; ++ui;
        if constexpr (ALIGN_EPI) { if (wr == 1) PG8_BAR; }
    }
    PG8_WAIT_V(0);
    if constexpr (!ALIGN_EPI) { if (wr == 0) PG8_BAR; }
    PG8_BAR;
    if constexpr (Epi::AFTER_DRAIN) { E.fused(acc, cur, wr, wc, fr, fq, lds, wid, lane); S.done(cur); }
#undef PG8_SA
#undef PG8_SB
#undef PG8_STAGE
#undef PG8_LDA
#undef PG8_LDB
#undef PG8_MMA
#undef PG8_WAIT_V
#undef PG8_WAIT_L
#undef PG8_BAR
#undef PG8_SCHED
}
}
constexpr int NWAVES = 8;
constexpr int D = 1024, NBP = 8, SEQ = 2048, MP = NBP * SEQ, NBS = 32, TS = 8, MS = NBS * TS, M = MP + MS;
constexpr int PAST = 8192, PAGE = 128, NPAGES = PAST / PAGE, NPOOL = 2560;
constexpr int INW = 2560, NEXP = 16384;
constexpr float LN_EPS = 1e-5f;
constexpr float ALPHA = 1.189207115002721f;
constexpr float LAM_INIT = 0.2f;
constexpr size_t O_YP = 0, O_YS = O_YP + (size_t)MP * D, O_KP = O_YS + (size_t)MS * D, O_VP = O_KP + (size_t)MP * 512, O_HP = O_VP + (size_t)MP * 512,
                 O_CP = O_HP + (size_t)NBP * 512, O_KS = O_CP + (size_t)NBP * 3 * 512, O_VS = O_KS + (size_t)MS * 512, O_HS = O_VS + (size_t)MS * 512, O_CS = O_HS + (size_t)NBS * 512,
                 O_END = O_CS + (size_t)NBS * 3 * 512;
constexpr size_t MiB = 1u << 20;
constexpr size_t WS_CTL = 0, CTL_ZERO_BYTES = 1 * MiB;
constexpr size_t WS_WIN_T = 2 * MiB, WS_WOUT_T = 8 * MiB, WS_WQ_T = 10 * MiB, WS_WG_T = 14 * MiB, WS_WPLE_T = 16 * MiB, WS_KEYS = 17 * MiB, WS_WAT = 18 * MiB, WS_WXT = 18 * MiB + 65536;
constexpr size_t WS_U = 32 * MiB, WS_V = 64 * MiB, WS_XB = 96 * MiB, WS_PE = 130 * MiB, WS_Q = 140 * MiB, WS_KB = 158 * MiB, WS_VB = 176 * MiB, WS_XR = 194 * MiB, WS_GT = 212 * MiB;
constexpr size_t WS_MIX = 230 * MiB, WS_PLE = 264 * MiB, WS_PRE1 = 298 * MiB, WS_X1 = 364 * MiB, WS_X1B = 430 * MiB, WS_PQ = 464 * MiB, WS_EIDX = 530 * MiB, WS_GW = 540 * MiB;
constexpr size_t WS_X2 = 550 * MiB, WS_X2B = 616 * MiB, WS_SPART = 650 * MiB, WS_SSTAT = 659 * MiB, WS_RGC = 660 * MiB, WS_W = 662 * MiB, WS_FFN = 672 * MiB, WS_PART = 740 * MiB, WS_X1Q = 810 * MiB, WS_SX = 828 * MiB, WS_USC = 829 * MiB, WS_VSC = 830 * MiB, WS_SW = 831 * MiB, WS_EIDXP = 832 * MiB, WS_WQ = 842 * MiB, WS_END = 846 * MiB;
constexpr int CW_TMO = 0, CW_CODE = 1, CW_CONV = 64, CW_BAR = 4096;
constexpr int RING_OFF = 0, RING_BYTES = 131072;
constexpr int LDSCTL_OFF = RING_BYTES, MISC_OFF = LDSCTL_OFF + 320;
constexpr int LDS_BYTES = 147456;
#define GAS __attribute__((address_space(1)))
#define LAS __attribute__((address_space(3)))
typedef unsigned short bf16;
typedef unsigned v4u __attribute__((ext_vector_type(4)));
typedef float f32x4 __attribute__((ext_vector_type(4)));
typedef short bf16x8 __attribute__((ext_vector_type(8)));
typedef GAS unsigned gu32;
typedef GAS unsigned long long gu64;
#define RLX_AGENT __ATOMIC_RELAXED, __HIP_MEMORY_SCOPE_AGENT
#define LDS_WAIT() asm volatile("s_waitcnt lgkmcnt(0)" ::: "memory")
#define VM_WAIT() asm volatile("s_waitcnt vmcnt(0)" ::: "memory")
__device__ __forceinline__ unsigned f2bf(float f) { unsigned u = __builtin_bit_cast(unsigned, f); return (u + 0x7fffu + ((u >> 16) & 1u)) >> 16; }
__device__ __forceinline__ unsigned pk2(float lo, float hi) { return f2bf(lo) | (f2bf(hi) << 16); }

#define XB_TMO      128
#define XB_XCNT(j)  (256  + 64 * (j))
#define XB_XSUB(j)  (1280 + 64 * (j))
#define XB_XGEN(j)  (2304 + 64 * (j))
#define XB_TOP      3328
#define XB_TOPGEN   3392
#define XCD_BAR_WORDS 3456
#define XB_SPIN_CAP (1u << 18)

__device__ __forceinline__ unsigned xb_ld(unsigned* p)              { return __hip_atomic_load(p, __ATOMIC_RELAXED, __HIP_MEMORY_SCOPE_AGENT); }
__device__ __forceinline__ unsigned xb_add(unsigned* p, unsigned v) { return __hip_atomic_fetch_add(p, v, __ATOMIC_RELAXED, __HIP_MEMORY_SCOPE_AGENT); }
__device__ __forceinline__ unsigned xb_xcc_id() { return (unsigned)__builtin_amdgcn_s_getreg((3 << 11) | 20) & 0xFu; }
#define XB_SPIN(cond, bar) do { unsigned _sp = 0; while (cond) { __builtin_amdgcn_s_sleep(1); \
    if ((++_sp & 255u) == 0u) { if (xb_ld(&(bar)[XB_TMO])) break; if (_sp > XB_SPIN_CAP) { atomicAdd(&(bar)[XB_TMO], 1u); break; } } } } while (0)

struct XcdBarrier {
    unsigned* bar; unsigned x;
    volatile LAS unsigned* st;
};

__device__ __forceinline__ XcdBarrier xcd_barrier_post(unsigned* bar, volatile LAS unsigned* st) {
    XcdBarrier b; b.bar = bar; b.x = xb_xcc_id(); b.st = st;
    if (threadIdx.x == 0) (void)xb_add(&bar[XB_XCNT(b.x)], 1u);
    return b;
}
__device__ __forceinline__ void xcd_barrier_complete(unsigned* bar, unsigned x, unsigned& nloc, unsigned& nx) {
    const unsigned G = gridDim.x * gridDim.y * gridDim.z;
    unsigned sum, cnt, mine, sp = 0u;
    for (;;) {
        sum = 0u; cnt = 0u; mine = 0u;
#pragma unroll
        for (unsigned j = 0; j < 16; ++j) { const unsigned c = xb_ld(&bar[XB_XCNT(j)]); sum += c; cnt += (c > 0u) ? 1u : 0u; mine = (j == x) ? c : mine; }
        if (sum == G) break;
        __builtin_amdgcn_s_sleep(1);
        if ((++sp & 255u) == 0u) { if (xb_ld(&bar[XB_TMO])) break; if (sp > XB_SPIN_CAP) { atomicAdd(&bar[XB_TMO], 1u); break; } }
    }
    nloc = mine > 0u ? mine : 1u; nx = cnt > 0u ? cnt : 1u;
}

__device__ __forceinline__ void xcd_barrier(const XcdBarrier& b) {
    asm volatile("s_waitcnt vmcnt(0)" ::: "memory");
    __syncthreads();
    if (threadIdx.x == 0) {
        unsigned* bar = b.bar;
        __builtin_amdgcn_s_waitcnt(0);
        unsigned nloc = b.st[0], nx = b.st[1];
        if (nloc == 0u) { xcd_barrier_complete(bar, b.x, nloc, nx); b.st[0] = nloc; b.st[1] = nx; }
        const unsigned old = xb_add(&bar[XB_XSUB(b.x)], 1u);
        const unsigned gen = old / nloc;
        if (old + 1u == (gen + 1u) * nloc) {
            __builtin_amdgcn_fence(__ATOMIC_RELEASE, "agent");
            asm volatile("s_waitcnt vmcnt(0)" ::: "memory");
            const unsigned og = xb_add(&bar[XB_TOP], 1u);
            const unsigned tg = og / nx;
            if (og + 1u == (tg + 1u) * nx) xb_add(&bar[XB_TOPGEN], 1u);
            else XB_SPIN(xb_ld(&bar[XB_TOPGEN]) == tg, bar);
            __builtin_amdgcn_fence(__ATOMIC_ACQUIRE, "agent");
            xb_add(&bar[XB_XGEN(b.x)], 1u);
            asm volatile("s_waitcnt vmcnt(0)" ::: "memory");
        } else {
            XB_SPIN(xb_ld(&bar[XB_XGEN(b.x)]) == gen, bar);
            __builtin_amdgcn_fence(__ATOMIC_ACQUIRE, "agent");
            asm volatile("s_waitcnt vmcnt(0)" ::: "memory");
        }
    }
    __syncthreads();
}
struct Frame {
    LAS unsigned char* lds;
    volatile LAS unsigned* MISC;
    gu32* ctl;
    int tid, lane, wave;
    int vcu, G;
};
__device__ __forceinline__ float wave_sum(float v) {
#pragma unroll
    for (int o = 1; o < 64; o <<= 1) v += __shfl_xor(v, o);
    return v;
}
__device__ __forceinline__ float bf_lo(unsigned u) { return __builtin_bit_cast(float, u << 16); }
__device__ __forceinline__ float bf_hi(unsigned u) { return __builtin_bit_cast(float, u & 0xffff0000u); }
__device__ __forceinline__ void p0_transpose_item(const float* W, int K, int N, bf16* WT, LAS float* scr, int item, int lane, float sc = 1.0f) {
    const int nblk = N / 32, kb = item / nblk, nb = item % nblk, k0 = 64 * kb, n0 = 32 * nb;
#pragma unroll 8
    for (int i = 0; i < 32; ++i) { const int kk = 2 * i + (lane >> 5); scr[kk * 33 + (lane & 31)] = W[(size_t)(k0 + kk) * N + n0 + (lane & 31)] * sc; }
    LDS_WAIT(); asm volatile("" ::: "memory");
    const int c = lane & 7;
#pragma unroll
    for (int j = 0; j < 4; ++j) { const int n = (lane >> 3) + 8 * j; const LAS float* s = scr + (8 * c) * 33 + n;
        v4u o; o.x = pk2(s[0 * 33], s[1 * 33]); o.y = pk2(s[2 * 33], s[3 * 33]); o.z = pk2(s[4 * 33], s[5 * 33]); o.w = pk2(s[6 * 33], s[7 * 33]);
        *(GAS v4u*)(WT + (size_t)(n0 + n) * K + k0 + 8 * c) = o; }
    LDS_WAIT(); asm volatile("" ::: "memory");
}
__device__ __forceinline__ void p0_convert(const float* src, bf16* dst, size_t n, int gw, int NGW, int lane) {
    typedef unsigned u32x2c __attribute__((ext_vector_type(2)));
    const size_t np = n / 512;
    for (size_t p0 = gw; p0 < np; p0 += (size_t)4 * NGW) {
        f32x4 a[4], b[4];
#pragma unroll
        for (int q = 0; q < 4; ++q) { const size_t p = p0 + (size_t)q * NGW; const size_t pc = p < np ? p : p0; const GAS f32x4* s = (const GAS f32x4*)(src + pc * 512); a[q] = s[lane]; b[q] = s[64 + lane]; }
#pragma unroll
        for (int q = 0; q < 4; ++q) { const size_t p = p0 + (size_t)q * NGW; if (p < np) {
            u32x2c oa, ob; oa.x = pk2(a[q].x, a[q].y); oa.y = pk2(a[q].z, a[q].w); ob.x = pk2(b[q].x, b[q].y); ob.y = pk2(b[q].z, b[q].w);
            ((GAS u32x2c*)(dst + p * 512))[lane] = oa; ((GAS u32x2c*)(dst + p * 512))[64 + lane] = ob; } }
    }
}
template <bool SLICED>
__device__ __forceinline__ void p0_convert_fp8(const float* src, unsigned char* dst, size_t n, float scale, int gw, int NGW, int lane) {
    const size_t np = n / 1024;
    for (size_t p = gw; p < np; p += NGW) {
        const GAS f32x4* s = (const GAS f32x4*)(src + p * 1024) + lane * 4;
        unsigned w[4];
#pragma unroll
        for (int k = 0; k < 4; ++k) { const f32x4 a = s[k];
            const float c0 = fminf(fmaxf(a.x * scale, -448.f), 448.f), c1 = fminf(fmaxf(a.y * scale, -448.f), 448.f), c2 = fminf(fmaxf(a.z * scale, -448.f), 448.f), c3 = fminf(fmaxf(a.w * scale, -448.f), 448.f);
            int t = 0; t = __builtin_amdgcn_cvt_pk_fp8_f32(c0, c1, t, false); t = __builtin_amdgcn_cvt_pk_fp8_f32(c2, c3, t, true); w[k] = (unsigned)t; }
        if (SLICED) *(GAS v4u*)(dst + ((size_t)(lane >> 3) * NEXP + p) * 128 + (lane & 7) * 16) = (v4u){w[0], w[1], w[2], w[3]};
        else *((GAS v4u*)(dst + p * 1024) + lane) = (v4u){w[0], w[1], w[2], w[3]};
    }
}
__device__ __forceinline__ void convert_fp8_rows(const float* src, unsigned char* dst, int r0, int nr, float scale, int lane) {
    for (int p = r0; p < r0 + nr; ++p) {
        const GAS f32x4* s = (const GAS f32x4*)(src + (size_t)p * 1024) + lane * 4;
        unsigned w[4];
#pragma unroll
        for (int k = 0; k < 4; ++k) { const f32x4 a = __builtin_nontemporal_load(s + k);
            const float c0 = fminf(fmaxf(a.x * scale, -448.f), 448.f), c1 = fminf(fmaxf(a.y * scale, -448.f), 448.f), c2 = fminf(fmaxf(a.z * scale, -448.f), 448.f), c3 = fminf(fmaxf(a.w * scale, -448.f), 448.f);
            int t = 0; t = __builtin_amdgcn_cvt_pk_fp8_f32(c0, c1, t, false); t = __builtin_amdgcn_cvt_pk_fp8_f32(c2, c3, t, true); w[k] = (unsigned)t; }
        *(GAS v4u*)(dst + ((size_t)(lane >> 3) * NEXP + p) * 128 + (lane & 7) * 16) = (v4u){w[0], w[1], w[2], w[3]};
    }
}
struct CvRows { f32x4 a[4][4]; };
__device__ __forceinline__ void cv_load(CvRows& r, const float* src, int p0, int lane) {
#pragma unroll
    for (int q = 0; q < 4; ++q) { const GAS f32x4* s = (const GAS f32x4*)(src + (size_t)(p0 + q) * 1024) + lane;
#pragma unroll
        for (int k = 0; k < 4; ++k) r.a[q][k] = __builtin_nontemporal_load(s + 64 * k); }
}
__device__ __forceinline__ void cv_store(const CvRows& r, unsigned char* dst, float* scale, int p0, int lane) {
    float m[4];
#pragma unroll
    for (int q = 0; q < 4; ++q) { m[q] = 0.f;
#pragma unroll
        for (int k = 0; k < 4; ++k) m[q] = fmaxf(m[q], fmaxf(fmaxf(fabsf(r.a[q][k].x), fabsf(r.a[q][k].y)), fmaxf(fabsf(r.a[q][k].z), fabsf(r.a[q][k].w)))); }
#pragma unroll
    for (int o = 1; o < 64; o <<= 1) {
#pragma unroll
        for (int q = 0; q < 4; ++q) m[q] = fmaxf(m[q], __shfl_xor(m[q], o)); }
#pragma unroll
    for (int q = 0; q < 4; ++q) { const float inv = m[q] > 0.f ? 127.0f / m[q] : 0.f;
#pragma unroll
        for (int k = 0; k < 4; ++k) { const int q0 = (int)rintf(r.a[q][k].x * inv), q1 = (int)rintf(r.a[q][k].y * inv), q2 = (int)rintf(r.a[q][k].z * inv), q3 = (int)rintf(r.a[q][k].w * inv);
            const unsigned w = ((unsigned)q0 & 0xffu) | (((unsigned)q1 & 0xffu) << 8) | (((unsigned)q2 & 0xffu) << 16) | (((unsigned)q3 & 0xffu) << 24);
            *(GAS unsigned*)(dst + ((size_t)(2 * k + (lane >> 5)) * NEXP + (p0 + q)) * 128 + 4 * (lane & 31)) = w; }
        scale[p0 + q] = m[q] * (1.0f / 127.0f); }
}
__device__ __forceinline__ void convert_i8_rows8(const float* src, unsigned char* dst, float* scale, int r0, int lane) {
    CvRows A, B;
    cv_load(A, src, r0, lane);
    cv_load(B, src, r0 + 4, lane);
    cv_store(A, dst, scale, r0, lane);
    cv_store(B, dst, scale, r0 + 4, lane);
}
constexpr float RG_NLOG2E = -1.4426950408889634f;
struct Args { const void* in[34]; float* out; unsigned char* ws; };

__device__ __forceinline__ void p0_prologue(Frame& F, const Args& A, unsigned char* ws) {
    LAS float* scr = (LAS float*)(F.lds + RING_OFF + F.wave * 16384);
    const int gw = F.vcu * NWAVES + F.wave, NGW = F.G * NWAVES;
    constexpr int I_IN = (D / 64) * (INW / 32), I_OUT = (D / 64) * (D / 32), I_WQ = (D / 64) * (2048 / 32), I_G = I_OUT, I_PLE = (256 / 64) * (D / 32), I_RG = 16 * 2;
    constexpr int NITEMS = I_IN + I_OUT + I_WQ + I_G + I_PLE + I_RG;
    for (int it = gw; it < NITEMS; it += NGW) {
        int r = it;
        if (r < I_IN) { p0_transpose_item((const float*)A.in[9], D, INW, (bf16*)(ws + WS_WIN_T), scr, r, F.lane); continue; } r -= I_IN;
        if (r < I_OUT) { p0_transpose_item((const float*)A.in[22], D, D, (bf16*)(ws + WS_WOUT_T), scr, r, F.lane); continue; } r -= I_OUT;
        if (r < I_WQ) { p0_transpose_item((const float*)A.in[25], D, 2048, (bf16*)(ws + WS_WQ_T), scr, r, F.lane); continue; } r -= I_WQ;
        if (r < I_G) { p0_transpose_item((const float*)A.in[32], D, D, (bf16*)(ws + WS_WG_T), scr, r, F.lane); continue; } r -= I_G;
        if (r < I_PLE) { p0_transpose_item((const float*)A.in[31], 256, D, (bf16*)(ws + WS_WPLE_T), scr, r, F.lane); continue; } r -= I_PLE;
        { const int mat = r >> 4, blk = (r >> 1) & 7, sub = r & 1;
          p0_transpose_item((const float*)A.in[mat ? 19 : 17] + blk * 4096, 64, 64, (bf16*)(ws + (mat ? WS_WXT : WS_WAT)) + blk * 4096, scr, sub, F.lane, RG_NLOG2E); }
    }
    p0_convert((const float*)A.in[0], (bf16*)(ws + WS_XB), (size_t)MP * D, gw, NGW, F.lane);
    p0_convert((const float*)A.in[1], (bf16*)(ws + WS_XB) + (size_t)MP * D, (size_t)MS * D, gw, NGW, F.lane);
    p0_convert((const float*)A.in[2], (bf16*)(ws + WS_PE), (size_t)MP * 256, gw, NGW, F.lane);
    p0_convert((const float*)A.in[3], (bf16*)(ws + WS_PE) + (size_t)MP * 256, (size_t)MS * 256, gw, NGW, F.lane);
    p0_convert((const float*)A.in[26], (bf16*)(ws + WS_KEYS), (size_t)8 * 2 * 128 * 128, gw, NGW, F.lane);
}
typedef float f32x16 __attribute__((ext_vector_type(16)));
typedef float f32x2v_t __attribute__((ext_vector_type(2)));
typedef unsigned u32x4 __attribute__((ext_vector_type(4)));
typedef unsigned u32x2v_t __attribute__((ext_vector_type(2)));
typedef short s16x4 __attribute__((ext_vector_type(4)));
typedef short v4i16_t __attribute__((ext_vector_type(4)));
typedef __bf16 bf16x2_t __attribute__((ext_vector_type(2)));
__device__ __forceinline__ int crow(int r, int hi) { return (r & 3) + 8 * (r >> 2) + 4 * hi; }
__device__ __forceinline__ unsigned cvtpk(float lo, float hi) { f32x2v_t v = {lo, hi}; bf16x2_t b = __builtin_convertvector(v, bf16x2_t); return __builtin_bit_cast(unsigned, b); }
__device__ __forceinline__ s16x4 vtr(LAS const unsigned char* p) { return __builtin_bit_cast(s16x4, __builtin_amdgcn_ds_read_tr16_b64_v4i16((LAS v4i16_t*)p)); }
__device__ __forceinline__ float swap32_max(float v) { auto rr = __builtin_amdgcn_permlane32_swap(__float_as_uint(v), __float_as_uint(v), false, false); return fmaxf(__uint_as_float(rr[0]), __uint_as_float(rr[1])); }
__device__ __forceinline__ float swap32_sum(float v) { auto rr = __builtin_amdgcn_permlane32_swap(__float_as_uint(v), __float_as_uint(v), false, false); return __uint_as_float(rr[0]) + __uint_as_float(rr[1]); }

constexpr int PA_RSK = 272, PA_RSV = 320, PA_KB = 64 * PA_RSK, PA_VB = 64 * PA_RSV, PA_BUF = PA_KB + PA_VB;
constexpr int PA_RSC = 528;

__device__ __forceinline__ void pattn_unit(Frame& F, int b, int h, int qb, const bf16* Q, const bf16* KB, const bf16* VB, bf16* MIX, float lam, const float* subln) {
    const int tid = F.tid, lane = F.lane, r32 = lane & 31, hi = lane >> 5, wid = F.wave, mp = wid >> 2, w4 = wid & 3;
    LAS unsigned char* L = F.lds + RING_OFF;
    const size_t rowbase = (size_t)b * SEQ;
    const int q0 = qb * 128 + w4 * 32;
    bf16x8 qf[4];
    { const bf16* qp = Q + (rowbase + q0 + r32) * 512 + h * 128 + mp * 64 + hi * 8;
#pragma unroll
      for (int ks = 0; ks < 4; ++ks) qf[ks] = *(const GAS bf16x8*)(qp + ks * 16); }
    const int sk0 = tid >> 4, sc = tid & 15;
    const bf16* kg = KB + (rowbase + sk0) * 512 + h * 128 + sc * 8;
    const bf16* vg = VB + (rowbase + sk0) * 512 + h * 128 + sc * 8;
    const int kl0 = sk0 * PA_RSK + sc * 16, vl0 = PA_KB + sk0 * PA_RSV + sc * 16;
    const int NT = 2 * qb + 2;
    v4u sK0, sK1, sV0, sV1;
#define PA_LOAD(t) do { const size_t o_ = (size_t)(t) * 64 * 512; sK0 = *(const GAS v4u*)(kg + o_); sK1 = *(const GAS v4u*)(kg + o_ + 32 * 512); sV0 = *(const GAS v4u*)(vg + o_); sV1 = *(const GAS v4u*)(vg + o_ + 32 * 512); } while (0)
#define PA_STORE(buf) do { LAS unsigned char* B_ = L + (buf) * PA_BUF; *(LAS v4u*)(B_ + kl0) = sK0; *(LAS v4u*)(B_ + kl0 + 32 * PA_RSK) = sK1; *(LAS v4u*)(B_ + vl0) = sV0; *(LAS v4u*)(B_ + vl0 + 32 * PA_RSV) = sV1; } while (0)
    PA_LOAD(0); PA_STORE(0);
    __syncthreads();
    f32x16 o[4];
#pragma unroll
    for (int i = 0; i < 4; ++i) o[i] = f32x16{};
    float mrun = -INFINITY, lrun = 0.f;
    const int vtr0 = PA_KB + (4 * hi + ((lane & 15) >> 2)) * PA_RSV + (16 * ((lane >> 4) & 1) + 4 * (lane & 3)) * 2;
    const int kfr0 = r32 * PA_RSK + (mp * 64 + hi * 8) * 2;
    for (int t = 0; t < NT; ++t) {
        if (t + 1 < NT) PA_LOAD(t + 1);
        LAS unsigned char* Bc = L + (t & 1) * PA_BUF;
        f32x16 s0 = f32x16{}, s1 = f32x16{};
#pragma unroll
        for (int ks = 0; ks < 4; ++ks) {
            const bf16x8 k0 = *(const LAS bf16x8*)(Bc + kfr0 + ks * 32);
            const bf16x8 k1 = *(const LAS bf16x8*)(Bc + kfr0 + 32 * PA_RSK + ks * 32);
            s0 = __builtin_amdgcn_mfma_f32_32x32x16_bf16(k0, qf[ks], s0, 0, 0, 0);
            s1 = __builtin_amdgcn_mfma_f32_32x32x16_bf16(k1, qf[ks], s1, 0, 0, 0);
        }
        if (t >= NT - 2) {
            const int qrel = q0 + r32 - t * 64;
#pragma unroll
            for (int r = 0; r < 16; ++r) { const int kv = crow(r, hi); if (kv > qrel) s0[r] = -INFINITY; if (kv + 32 > qrel) s1[r] = -INFINITY; }
        }
        s16x4 vA[4][2];
#pragma unroll
        for (int rb_ = 0; rb_ < 4; ++rb_) { vA[rb_][0] = vtr(Bc + vtr0 + rb_ * 64); vA[rb_][1] = vtr(Bc + vtr0 + 8 * PA_RSV + rb_ * 64); }
        float rm;
        asm("v_max3_f32 %0, %1, %2, %3" : "=v"(rm) : "v"(s0[0]), "v"(s1[0]), "v"(s0[1]));
#pragma unroll
        for (int r = 1; r < 16; ++r) { if (r < 15) asm("v_max3_f32 %0, %1, %2, %3" : "=v"(rm) : "v"(rm), "v"(s1[r]), "v"(s0[r + 1])); else asm("v_max_f32 %0, %1, %2" : "=v"(rm) : "v"(rm), "v"(s1[15])); }
        rm = swap32_max(rm);
        const float mnew = (rm > mrun + 8.0f) ? rm : mrun;
        const bool resc = __any(mnew != mrun);
        const float alpha = __builtin_amdgcn_exp2f(mrun - mnew);
        mrun = mnew;
#pragma unroll
        for (int r = 0; r < 16; ++r) s0[r] = __builtin_amdgcn_exp2f(s0[r] - mnew);
#pragma unroll
        for (int r = 8; r < 16; ++r) s1[r] = __builtin_amdgcn_exp2f(s1[r] - mnew);
        f32x2v_t ps2 = (f32x2v_t){0.f, 0.f};
#pragma unroll
        for (int r = 0; r < 16; r += 2) ps2 += (f32x2v_t){s0[r], s0[r + 1]};
#pragma unroll
        for (int r = 8; r < 16; r += 2) ps2 += (f32x2v_t){s1[r], s1[r + 1]};
        if (resc) {
            lrun *= alpha;
#pragma unroll
            for (int i = 0; i < 4; ++i)
#pragma unroll
                for (int r = 0; r < 16; ++r) o[i][r] *= alpha;
        }
        u32x4 pf[4];
        pf[0] = (u32x4){cvtpk(s0[0], s0[1]), cvtpk(s0[2], s0[3]), cvtpk(s0[4], s0[5]), cvtpk(s0[6], s0[7])};
        pf[1] = (u32x4){cvtpk(s0[8], s0[9]), cvtpk(s0[10], s0[11]), cvtpk(s0[12], s0[13]), cvtpk(s0[14], s0[15])};
        pf[3] = (u32x4){cvtpk(s1[8], s1[9]), cvtpk(s1[10], s1[11]), cvtpk(s1[12], s1[13]), cvtpk(s1[14], s1[15])};
#define PA_VLD(dst, kk_) do { _Pragma("unroll") for (int rb_ = 0; rb_ < 4; ++rb_) { dst[rb_][0] = vtr(Bc + vtr0 + (16 * (kk_)) * PA_RSV + rb_ * 64); dst[rb_][1] = vtr(Bc + vtr0 + (16 * (kk_) + 8) * PA_RSV + rb_ * 64); } } while (0)
#define PA_VMM(src, kk_) do { _Pragma("unroll") for (int rb_ = 0; rb_ < 4; ++rb_) { const bf16x8 vf_ = (bf16x8){src[rb_][0][0], src[rb_][0][1], src[rb_][0][2], src[rb_][0][3], src[rb_][1][0], src[rb_][1][1], src[rb_][1][2], src[rb_][1][3]}; \
            o[rb_] = __builtin_amdgcn_mfma_f32_32x32x16_bf16(vf_, __builtin_bit_cast(bf16x8, pf[kk_]), o[rb_], 0, 0, 0); } } while (0)
        s16x4 vB[4][2];
        PA_VLD(vB, 1); __builtin_amdgcn_sched_barrier(0);
        PA_VMM(vA, 0);
#pragma unroll
        for (int r = 0; r < 8; ++r) s1[r] = __builtin_amdgcn_exp2f(s1[r] - mnew);
#pragma unroll
        for (int r = 0; r < 8; r += 2) ps2 += (f32x2v_t){s1[r], s1[r + 1]};
        pf[2] = (u32x4){cvtpk(s1[0], s1[1]), cvtpk(s1[2], s1[3]), cvtpk(s1[4], s1[5]), cvtpk(s1[6], s1[7])};
        __builtin_amdgcn_sched_barrier(0);
        PA_VLD(vA, 2); __builtin_amdgcn_sched_barrier(0);
        PA_VMM(vB, 1); __builtin_amdgcn_sched_barrier(0);
        PA_VLD(vB, 3); __builtin_amdgcn_sched_barrier(0);
        PA_VMM(vA, 2); __builtin_amdgcn_sched_barrier(0);
        PA_VMM(vB, 3);
        lrun += ps2.x + ps2.y;
#undef PA_VLD
#undef PA_VMM
        if (t + 1 < NT) PA_STORE((t + 1) & 1);
        __syncthreads();
    }
#undef PA_LOAD
#undef PA_STORE
    const float ltot = swap32_sum(lrun);
    const float nsc = (mp == 1 ? lam : 1.0f) / ltot;
    LAS unsigned char* cb = L + (w4 * 32 + r32) * PA_RSC + hi * 16;
    if (mp == 1) {
#pragma unroll
        for (int rb = 0; rb < 4; ++rb)
#pragma unroll
            for (int g = 0; g < 4; ++g) *(LAS f32x4*)(cb + (32 * rb + 8 * g) * 4) = (f32x4){o[rb][4 * g] * nsc, o[rb][4 * g + 1] * nsc, o[rb][4 * g + 2] * nsc, o[rb][4 * g + 3] * nsc};
    }
    __syncthreads();
    if (mp == 0) {
        float ss = 0.f;
#pragma unroll
        for (int rb = 0; rb < 4; ++rb)
#pragma unroll
            for (int g = 0; g < 4; ++g) { const f32x4 o2 = *(const LAS f32x4*)(cb + (32 * rb + 8 * g) * 4);
#pragma unroll
                for (int e = 0; e < 4; ++e) { const float v = o[rb][4 * g + e] * nsc - o2[e]; o[rb][4 * g + e] = v; ss += v * v; } }
        ss = swap32_sum(ss);
        const float rs = (1.0f - LAM_INIT) / sqrtf(ss * (1.0f / 128.0f) + LN_EPS);
        bf16* orow = MIX + (rowbase + q0 + r32) * 1024 + h * 128 + 4 * hi;
#pragma unroll
        for (int rb = 0; rb < 4; ++rb)
#pragma unroll
            for (int g = 0; g < 4; ++g) { const f32x4 gg = *(const GAS f32x4*)(subln + 32 * rb + 8 * g + 4 * hi);
                f32x2v_t w; w.x = __builtin_bit_cast(float, cvtpk(o[rb][4 * g] * rs * gg[0], o[rb][4 * g + 1] * rs * gg[1])); w.y = __builtin_bit_cast(float, cvtpk(o[rb][4 * g + 2] * rs * gg[2], o[rb][4 * g + 3] * rs * gg[3]));
                *(GAS f32x2v_t*)(orow + 32 * rb + 8 * g) = w; }
    }
    __syncthreads();
}
typedef float f32x4v_t __attribute__((ext_vector_type(4)));
constexpr int SA_RS = 288, SA_IMG = 128 * SA_RS, SA_VOFF = SA_IMG;
__device__ __forceinline__ f32x4 ntload4(const float* p) { return __builtin_nontemporal_load((const f32x4*)p); }
__device__ __forceinline__ void sattn_item(Frame& F, int b, int sp, int slot, const float* CK, const float* CV, const int* PT, const bf16* Q, float* SPART, float* SSTAT) {
    const int tid = F.tid, lane = F.lane, wid = F.wave, head = wid & 3, z = wid >> 2, c16 = lane & 15, fq = lane >> 4;
    LAS unsigned char* L = F.lds + RING_OFF;
    bf16x8 qz[4];
    { const int map = c16 >> 3, t = c16 & 7; const bf16* qp = Q + (size_t)(MP + b * 8 + t) * 512 + head * 128 + fq * 8;
#pragma unroll
      for (int ks = 0; ks < 4; ++ks) qz[ks] = ((ks >> 1) == map) ? *(const GAS bf16x8*)(qp + ks * 32) : (bf16x8){0, 0, 0, 0, 0, 0, 0, 0}; }
    f32x4 o[4];
#pragma unroll
    for (int i = 0; i < 4; ++i) o[i] = (f32x4){0.f, 0.f, 0.f, 0.f};
    float mrun = -INFINITY, lrun = 0.f;
    f32x4 rkA[8], rvA[8], rkB[8], rvB[8];
    const int pgv = PT[b * NPAGES + sp * 8 + (lane & 7)];
    const int NCH = 32;
#define SA_LOAD(rk, rv, ci) do { const int pg_ = __builtin_amdgcn_readlane(pgv, (ci) >> 2); const size_t base_ = ((size_t)pg_ * PAGE + ((ci) & 3) * 32) * 512 + (size_t)tid * 4; \
        _Pragma("unroll") for (int i_ = 0; i_ < 8; ++i_) { rk[i_] = ntload4(CK + base_ + i_ * 2048); rv[i_] = ntload4(CV + base_ + i_ * 2048); } } while (0)
    const int st0 = (((tid >> 5) & 3) * 32 + (tid >> 7)) * SA_RS + (tid & 31) * 8;
    const int kfr = (head * 32 + c16) * SA_RS + fq * 16;
    const int vfr = SA_VOFF + (head * 32 + 4 * fq + (c16 >> 2)) * SA_RS + (64 * z + 4 * (c16 & 3)) * 2;
#define SA_STEP(rk, rv, ci) do { \
        _Pragma("unroll") for (int i = 0; i < 8; ++i) { \
            f32x2v_t wk, wv; wk.x = __builtin_bit_cast(float, cvtpk(rk[i][0], rk[i][1])); wk.y = __builtin_bit_cast(float, cvtpk(rk[i][2], rk[i][3])); \
            wv.x = __builtin_bit_cast(float, cvtpk(rv[i][0], rv[i][1])); wv.y = __builtin_bit_cast(float, cvtpk(rv[i][2], rv[i][3])); \
            *(LAS f32x2v_t*)(L + st0 + i * 4 * SA_RS) = wk; *(LAS f32x2v_t*)(L + SA_VOFF + st0 + i * 4 * SA_RS) = wv; } \
        __syncthreads(); \
        if ((ci) + 2 < NCH) SA_LOAD(rk, rv, (ci) + 2); \
        f32x4 s0 = (f32x4){0.f, 0.f, 0.f, 0.f}, s1 = s0; \
        _Pragma("unroll") for (int ks = 0; ks < 4; ++ks) { \
            const bf16x8 k0 = *(const LAS bf16x8*)(L + kfr + ks * 64); \
            const bf16x8 k1 = *(const LAS bf16x8*)(L + kfr + 16 * SA_RS + ks * 64); \
            s0 = __builtin_amdgcn_mfma_f32_16x16x32_bf16(k0, qz[ks], s0, 0, 0, 0); \
            s1 = __builtin_amdgcn_mfma_f32_16x16x32_bf16(k1, qz[ks], s1, 0, 0, 0); } \
        float rm = fmaxf(fmaxf(fmaxf(s0[0], s0[1]), fmaxf(s0[2], s0[3])), fmaxf(fmaxf(s1[0], s1[1]), fmaxf(s1[2], s1[3]))); \
        rm = fmaxf(rm, __shfl_xor(rm, 16)); rm = fmaxf(rm, __shfl_xor(rm, 32)); \
        const float mnew = fmaxf(mrun, rm); \
        const float alpha = __builtin_amdgcn_exp2f(mrun - mnew); \
        mrun = mnew; \
        float ps = 0.f; \
        _Pragma("unroll") for (int r = 0; r < 4; ++r) { s0[r] = __builtin_amdgcn_exp2f(s0[r] - mnew); s1[r] = __builtin_amdgcn_exp2f(s1[r] - mnew); ps += s0[r] + s1[r]; } \
        lrun = lrun * alpha + ps; \
        const u32x4 pf = (u32x4){cvtpk(s0[0], s0[1]), cvtpk(s0[2], s0[3]), cvtpk(s1[0], s1[1]), cvtpk(s1[2], s1[3])}; \
        _Pragma("unroll") for (int db = 0; db < 4; ++db) { \
            const s16x4 lo = vtr(L + vfr + db * 32); \
            const s16x4 hi4 = vtr(L + vfr + 16 * SA_RS + db * 32); \
            const bf16x8 vf = (bf16x8){lo[0], lo[1], lo[2], lo[3], hi4[0], hi4[1], hi4[2], hi4[3]}; \
            o[db] = o[db] * alpha; \
            o[db] = __builtin_amdgcn_mfma_f32_16x16x32_bf16(vf, __builtin_bit_cast(bf16x8, pf), o[db], 0, 0, 0); } \
        __syncthreads(); } while (0)
    SA_LOAD(rkA, rvA, 0); SA_LOAD(rkB, rvB, 1);
#pragma unroll 1
    for (int ci = 0; ci < NCH; ci += 2) { SA_STEP(rkA, rvA, ci); SA_STEP(rkB, rvB, ci + 1); }
#undef SA_LOAD
#undef SA_STEP
    float lt = lrun; lt += __shfl_xor(lt, 16); lt += __shfl_xor(lt, 32);
    float* po = SPART + (((size_t)slot * 4 + head) * 16 + c16) * 128 + 64 * z + 4 * fq;
#pragma unroll
    for (int db = 0; db < 4; ++db) *(GAS f32x4*)(po + 16 * db) = o[db];
    if (z == 0 && fq == 0) { float* st = SSTAT + (((size_t)slot * 4 + head) * 16 + c16) * 2; st[0] = mrun; st[1] = lt; }
}
constexpr int RG_XCS = 144, RG_RIS = 272, RG_XC = 0, RG_R = 16 * RG_XCS, RG_I = RG_R + 16 * RG_RIS, RG_WS = RG_I + 16 * RG_RIS;
constexpr int RG_SEG_OFF = 8 * RG_WS;
struct RgConst { float cw0, cw1, cw2, cw3, cb, kexp; };
struct RgW { bf16x8 wa[4][2], wx[4][2]; float ba[4], bx[4]; };

__device__ __forceinline__ float gelu_tanh(float x) { const float z = 0.7978845608028654f * (x + 0.044715f * x * x * x); return x * __builtin_amdgcn_rcpf(1.0f + __builtin_amdgcn_exp2f(-2.0f * 1.4426950408889634f * z)); }
__device__ __forceinline__ float sigmoidf_(float x) { return __builtin_amdgcn_rcpf(1.0f + __builtin_amdgcn_exp2f(-1.4426950408889634f * x)); }

__device__ __forceinline__ void rg_gates(LAS unsigned char* wl, int lane, const RgConst& C, const RgW& W, const float (&xh)[3], const float (&xs)[16], float (&a)[16], float (&u)[16]) {
    float xc[16];
#pragma unroll
    for (int t = 0; t < 16; ++t) {
        const float x3 = t >= 3 ? xs[t - 3] : xh[t], x2 = t >= 2 ? xs[t - 2] : xh[t + 1], x1 = t >= 1 ? xs[t - 1] : xh[t + 2];
        xc[t] = C.cb + C.cw0 * x3 + C.cw1 * x2 + C.cw2 * x1 + C.cw3 * xs[t];
        *(LAS unsigned short*)(wl + RG_XC + t * RG_XCS + lane * 2) = (unsigned short)f2bf(xc[t]);
    }
    LDS_WAIT(); asm volatile("" ::: "memory");
    const int c16 = lane & 15, fq = lane >> 4;
    bf16x8 af[2];
#pragma unroll
    for (int ks = 0; ks < 2; ++ks) af[ks] = *(const LAS bf16x8*)(wl + RG_XC + c16 * RG_XCS + (32 * ks + 8 * fq) * 2);
#pragma unroll
    for (int cb = 0; cb < 4; ++cb) {
        f32x4 ar = (f32x4){0.f, 0.f, 0.f, 0.f}, ai = ar;
#pragma unroll
        for (int ks = 0; ks < 2; ++ks) { ar = __builtin_amdgcn_mfma_f32_16x16x32_bf16(af[ks], W.wa[cb][ks], ar, 0, 0, 0); ai = __builtin_amdgcn_mfma_f32_16x16x32_bf16(af[ks], W.wx[cb][ks], ai, 0, 0, 0); }
#pragma unroll
        for (int r = 0; r < 4; ++r) {
            *(LAS float*)(wl + RG_R + (4 * fq + r) * RG_RIS + (16 * cb + c16) * 4) = __builtin_amdgcn_rcpf(1.0f + __builtin_amdgcn_exp2f(ar[r] + W.ba[cb]));
            *(LAS float*)(wl + RG_I + (4 * fq + r) * RG_RIS + (16 * cb + c16) * 4) = __builtin_amdgcn_rcpf(1.0f + __builtin_amdgcn_exp2f(ai[r] + W.bx[cb]));
        }
    }
    LDS_WAIT(); asm volatile("" ::: "memory");
#pragma unroll
    for (int t = 0; t < 16; ++t) {
        const float r = *(const LAS float*)(wl + RG_R + t * RG_RIS + lane * 4), i = *(const LAS float*)(wl + RG_I + t * RG_RIS + lane * 4);
        const float av = __builtin_amdgcn_exp2f(C.kexp * r);
        a[t] = av; u[t] = __builtin_amdgcn_sqrtf(1.0f - av * av) * (i * xc[t]);
    }
    LDS_WAIT(); asm volatile("" ::: "memory");
}
__device__ __forceinline__ void rg_load_consts(int n, int lane, const Args& A, const bf16* WAT, const bf16* WXT, RgConst& C, RgW& W) {
    const int ch = n * 64 + lane;
    const float* cw = (const float*)A.in[15];
    C.cw0 = cw[ch]; C.cw1 = cw[512 + ch]; C.cw2 = cw[1024 + ch]; C.cw3 = cw[1536 + ch]; C.cb = ((const float*)A.in[16])[ch];
    const float lam = ((const float*)A.in[21])[ch];
    C.kexp = -8.0f * log1pf(expf(-lam)) * 1.4426950408889634f;
    const int c16 = lane & 15, fq = lane >> 4;
#pragma unroll
    for (int cb = 0; cb < 4; ++cb) {
        const int d = 16 * cb + c16;
#pragma unroll
        for (int ks = 0; ks < 2; ++ks) { W.wa[cb][ks] = *(const GAS bf16x8*)(WAT + (size_t)n * 4096 + d * 64 + 32 * ks + 8 * fq); W.wx[cb][ks] = *(const GAS bf16x8*)(WXT + (size_t)n * 4096 + d * 64 + 32 * ks + 8 * fq); }
        W.ba[cb] = RG_NLOG2E * ((const float*)A.in[18])[n * 64 + d]; W.bx[cb] = RG_NLOG2E * ((const float*)A.in[20])[n * 64 + d];
    }
}
template <bool PASS1>
__device__ __forceinline__ void rg_prompt_unit(Frame& F, const Args& A, int b, int n, int q, const bf16* XR, const bf16* GT, const bf16* WAT, const bf16* WXT, bf16* MIX, float* hout, float* RGC) {
    const int lane = F.lane, seg = F.wave;
    LAS unsigned char* wl = F.lds + RING_OFF + seg * RG_WS;
    LAS float* SEG = (LAS float*)(F.lds + RING_OFF + RG_SEG_OFF);
    RgConst C; RgW W; rg_load_consts(n, lane, A, WAT, WXT, C, W);
    const int ch = n * 64 + lane;
    float carry = 0.f, Pu = 1.f;
    if (!PASS1) {
#pragma unroll
        for (int qq = 0; qq < 3; ++qq) if (qq < q) { const f32x2v_t ph = *(const GAS f32x2v_t*)(RGC + ((size_t)((b * 8 + n) * 4 + qq) * 64 + lane) * 2); carry = ph.x * carry + ph.y; }
    }
    float xh[3], xs[16], gt[16];
    v4u sx0, sx1, sh, sg0, sg1;
    const int prow = lane >> 3, pch = (lane & 7) * 8;
#define RG_LOADTILE(tile_) do { const int t0_ = q * 512 + (tile_) * 128 + seg * 16; const size_t r0_ = (size_t)b * SEQ + t0_; \
        sx0 = *(const GAS v4u*)(XR + (r0_ + prow) * 512 + n * 64 + pch); sx1 = *(const GAS v4u*)(XR + (r0_ + 8 + prow) * 512 + n * 64 + pch); \
        sh = (v4u){0u, 0u, 0u, 0u}; if (lane < 24 && t0_ - 3 + prow >= 0) sh = *(const GAS v4u*)(XR + (r0_ - 3 + prow) * 512 + n * 64 + pch); \
        if (!PASS1) { sg0 = *(const GAS v4u*)(GT + (r0_ + prow) * 512 + n * 64 + pch); sg1 = *(const GAS v4u*)(GT + (r0_ + 8 + prow) * 512 + n * 64 + pch); } } while (0)
#define RG_UNSTAGE() do { \
        *(LAS v4u*)(wl + RG_R + (3 + prow) * 128 + pch * 2) = sx0; *(LAS v4u*)(wl + RG_R + (11 + prow) * 128 + pch * 2) = sx1; if (lane < 24) *(LAS v4u*)(wl + RG_R + prow * 128 + pch * 2) = sh; \
        if (!PASS1) { *(LAS v4u*)(wl + RG_I + prow * 128 + pch * 2) = sg0; *(LAS v4u*)(wl + RG_I + (8 + prow) * 128 + pch * 2) = sg1; } \
        LDS_WAIT(); asm volatile("" ::: "memory"); \
        _Pragma("unroll") for (int j = 0; j < 3; ++j) xh[j] = bf_lo((unsigned)*(const LAS unsigned short*)(wl + RG_R + j * 128 + lane * 2)); \
        _Pragma("unroll") for (int t = 0; t < 16; ++t) { xs[t] = bf_lo((unsigned)*(const LAS unsigned short*)(wl + RG_R + (3 + t) * 128 + lane * 2)); \
            if (!PASS1) gt[t] = bf_lo((unsigned)*(const LAS unsigned short*)(wl + RG_I + t * 128 + lane * 2)); } \
        LDS_WAIT(); asm volatile("" ::: "memory"); } while (0)
    RG_LOADTILE(0);
#pragma unroll 1
    for (int tile = 0; tile < 4; ++tile) {
        const size_t r0 = (size_t)b * SEQ + q * 512 + tile * 128 + seg * 16;
        RG_UNSTAGE();
        if (tile < 3) RG_LOADTILE(tile + 1);
        float a[16], u[16];
        rg_gates(wl, lane, C, W, xh, xs, a, u);
        float P = 1.f, H = 0.f;
#pragma unroll
        for (int t = 0; t < 16; ++t) { H = a[t] * H + u[t]; P *= a[t]; }
        LAS float* sg = SEG + ((tile & 1) * 8) * 128;
        sg[seg * 128 + lane * 2] = P; sg[seg * 128 + lane * 2 + 1] = H;
        __syncthreads();
        float hin = carry;
#pragma unroll
        for (int s = 0; s < 8; ++s) { const float Ps = sg[s * 128 + lane * 2], Hs = sg[s * 128 + lane * 2 + 1]; if (s < seg) hin = Ps * hin + Hs; carry = Ps * carry + Hs; Pu *= Ps; }
        if (!PASS1) {
            float h = hin;
#pragma unroll
            for (int t = 0; t < 16; ++t) { h = a[t] * h + u[t]; *(LAS unsigned short*)(wl + RG_R + t * 128 + lane * 2) = (unsigned short)f2bf(h * gelu_tanh(gt[t])); }
            if (q == 3 && tile == 3 && seg == 7) hout[b * 512 + ch] = h;
            LDS_WAIT(); asm volatile("" ::: "memory");
            const v4u y0 = *(const LAS v4u*)(wl + RG_R + prow * 128 + pch * 2), y1 = *(const LAS v4u*)(wl + RG_R + (8 + prow) * 128 + pch * 2);
            *(GAS v4u*)(MIX + (r0 + prow) * 1024 + 512 + n * 64 + pch) = y0; *(GAS v4u*)(MIX + (r0 + 8 + prow) * 1024 + 512 + n * 64 + pch) = y1;
            LDS_WAIT(); asm volatile("" ::: "memory");
        }
    }
#undef RG_LOADTILE
#undef RG_UNSTAGE
    if (PASS1 && seg == 0) { f32x2v_t ph; ph.x = Pu; ph.y = carry; *(GAS f32x2v_t*)(RGC + ((size_t)((b * 8 + n) * 4 + q) * 64 + lane) * 2) = ph; }
    __syncthreads();
}
__device__ __forceinline__ void rg_sample_unit(Frame& F, const Args& A, int b, int n, const bf16* XR, const bf16* GT, const bf16* WAT, const bf16* WXT, bf16* MIX, float* hout) {
    const int lane = F.lane;
    LAS unsigned char* wl = F.lds + RING_OFF + F.wave * RG_WS;
    RgConst C; RgW W; rg_load_consts(n, lane, A, WAT, WXT, C, W);
    const int ch = n * 64 + lane;
    const size_t r0 = (size_t)MP + b * 8;
    float xh[3], xs[16], gt[8];
    const float* sc = (const float*)A.in[7];
#pragma unroll
    for (int j = 0; j < 3; ++j) xh[j] = sc[(size_t)(b * 3 + j) * 512 + ch];
#pragma unroll
    for (int t = 0; t < 8; ++t) { xs[t] = bf_lo((unsigned)XR[(r0 + t) * 512 + ch]); gt[t] = bf_lo((unsigned)GT[(r0 + t) * 512 + ch]); }
#pragma unroll
    for (int t = 8; t < 16; ++t) xs[t] = 0.f;
    float a[16], u[16];
    rg_gates(wl, lane, C, W, xh, xs, a, u);
    float h = ((const float*)A.in[6])[b * 512 + ch];
#pragma unroll
    for (int t = 0; t < 8; ++t) { h = a[t] * h + u[t]; MIX[(r0 + t) * 1024 + 512 + ch] = (bf16)f2bf(h * gelu_tanh(gt[t])); }
    hout[b * 512 + ch] = h;
}
__device__ __forceinline__ void scomb_unit(Frame& F, int b, int head, int t, const bf16* Q, const bf16* KB, const bf16* VB, const float* SPART, const float* SSTAT, bf16* MIX, float lam, const float* subln) {
    const int lane = F.lane;
    const size_t r0 = (size_t)MP + b * 8;
    float vn[8][2];
#pragma unroll
    for (int j = 0; j < 8; ++j) { const unsigned w = *(const GAS unsigned*)(VB + (r0 + j) * 512 + head * 128 + 2 * lane); vn[j][0] = bf_lo(w); vn[j][1] = bf_hi(w); }
    const f32x2v_t gg = *(const GAS f32x2v_t*)(subln + 2 * lane);
    float om[2][2];
#pragma unroll
    for (int map = 0; map < 2; ++map) {
        const int col = map * 8 + t;
        const float kq = bf_lo((unsigned)Q[(r0 + t) * 512 + head * 128 + map * 64 + lane]);
        float sn[8];
#pragma unroll
        for (int j = 0; j < 8; ++j) { const float kk = bf_lo((unsigned)KB[(r0 + j) * 512 + head * 128 + map * 64 + lane]); const float d = wave_sum(kq * kk); sn[j] = (j <= t) ? d : -INFINITY; }
        float ms[8], ls[8], mt = -INFINITY;
#pragma unroll
        for (int s = 0; s < 8; ++s) { const float* st = SSTAT + (((size_t)(b * 8 + s) * 4 + head) * 16 + col) * 2; ms[s] = st[0]; ls[s] = st[1]; mt = fmaxf(mt, ms[s]); }
#pragma unroll
        for (int j = 0; j < 8; ++j) mt = fmaxf(mt, sn[j]);
        float l = 0.f, o0 = 0.f, o1 = 0.f;
#pragma unroll
        for (int s = 0; s < 8; ++s) { const float w = __builtin_amdgcn_exp2f(ms[s] - mt); l += w * ls[s];
            const f32x2v_t pv = *(const GAS f32x2v_t*)(SPART + (((size_t)(b * 8 + s) * 4 + head) * 16 + col) * 128 + 2 * lane); o0 += w * pv.x; o1 += w * pv.y; }
#pragma unroll
        for (int j = 0; j < 8; ++j) { const float p = __builtin_amdgcn_exp2f(sn[j] - mt); l += p; o0 += p * vn[j][0]; o1 += p * vn[j][1]; }
        const float inv = 1.0f / l; om[map][0] = o0 * inv; om[map][1] = o1 * inv;
        asm volatile("" ::: "memory");
    }
    const float a0 = om[0][0] - lam * om[1][0], a1 = om[0][1] - lam * om[1][1];
    const float ss = wave_sum(a0 * a0 + a1 * a1);
    const float rs = (1.0f - LAM_INIT) / sqrtf(ss * (1.0f / 128.0f) + LN_EPS);
    *(GAS unsigned*)(MIX + (r0 + t) * 1024 + head * 128 + 2 * lane) = cvtpk(a0 * rs * gg.x, a1 * rs * gg.y);
}
template <int NR> struct LnRaw { u32x2v_t w[NR][4]; };
template <int NR>
__device__ __forceinline__ void wave_sum_n(float (&v)[NR]) {
#pragma unroll
    for (int o = 1; o < 64; o <<= 1) {
#pragma unroll
        for (int r = 0; r < NR; ++r) v[r] += __shfl_xor(v[r], o); }
}
template <int NR>
__device__ __forceinline__ void wave_max_n(float (&v)[NR]) {
#pragma unroll
    for (int o = 1; o < 64; o <<= 1) {
#pragma unroll
        for (int r = 0; r < NR; ++r) v[r] = fmaxf(v[r], __shfl_xor(v[r], o)); }
}
template <int NR>
__device__ __forceinline__ void ln1_load(LnRaw<NR>& raw, int lane, const bf16* PRE, const size_t (&rows)[NR]) {
#pragma unroll
    for (int r = 0; r < NR; ++r) { const GAS u32x2v_t* xr = (const GAS u32x2v_t*)(PRE + rows[r] * D) + lane;
#pragma unroll
        for (int j = 0; j < 4; ++j) raw.w[r][j] = xr[64 * j]; }
}
template <int NR>
__device__ __forceinline__ void ln1_rows(const LnRaw<NR>& raw, int lane, const size_t (&rows)[NR], const float* g, const float* bt, float* X1, bf16* X1B, unsigned char* X1Q, float* SX) {
    f32x4 gg[4], bb[4];
#pragma unroll
    for (int j = 0; j < 4; ++j) { gg[j] = ((const GAS f32x4*)g)[lane + 64 * j]; bb[j] = ((const GAS f32x4*)bt)[lane + 64 * j]; }
    f32x4 v[NR][4]; float s[NR], s2[NR], am[NR];
#pragma unroll
    for (int r = 0; r < NR; ++r) { s[r] = 0.f;
#pragma unroll
        for (int j = 0; j < 4; ++j) { const u32x2v_t w = raw.w[r][j]; const unsigned w0 = w[0], w1 = w[1]; v[r][j] = (f32x4){bf_lo(w0), bf_hi(w0), bf_lo(w1), bf_hi(w1)}; s[r] += (v[r][j].x + v[r][j].y) + (v[r][j].z + v[r][j].w); } }
    wave_sum_n<NR>(s);
#pragma unroll
    for (int r = 0; r < NR; ++r) { const float mean = s[r] * (1.f / D); s2[r] = 0.f;
#pragma unroll
        for (int j = 0; j < 4; ++j) { v[r][j] = v[r][j] - mean; s2[r] += (v[r][j].x * v[r][j].x + v[r][j].y * v[r][j].y) + (v[r][j].z * v[r][j].z + v[r][j].w * v[r][j].w); } }
    wave_sum_n<NR>(s2);
#pragma unroll
    for (int r = 0; r < NR; ++r) { const float rstd = 1.f / sqrtf(s2[r] * (1.f / D) + LN_EPS); am[r] = 0.f;
#pragma unroll
        for (int j = 0; j < 4; ++j) { const f32x4 o = v[r][j] * rstd * gg[j] + bb[j]; v[r][j] = o; am[r] = fmaxf(am[r], fmaxf(fmaxf(fabsf(o.x), fabsf(o.y)), fmaxf(fabsf(o.z), fabsf(o.w)))); } }
    wave_max_n<NR>(am);
#pragma unroll
    for (int r = 0; r < NR; ++r) { const float inv = am[r] > 0.f ? 127.0f / am[r] : 0.f; const size_t m = rows[r];
#pragma unroll
        for (int j = 0; j < 4; ++j) { const f32x4 o = v[r][j];
            u32x2v_t w; w.x = cvtpk(o.x, o.y); w.y = cvtpk(o.z, o.w);
            ((GAS u32x2v_t*)(X1B + m * D))[lane + 64 * j] = w;
            const int q0 = (int)rintf(o.x * inv), q1 = (int)rintf(o.y * inv), q2 = (int)rintf(o.z * inv), q3 = (int)rintf(o.w * inv);
            ((GAS unsigned*)(X1Q + m * D))[lane + 64 * j] = ((unsigned)q0 & 0xffu) | (((unsigned)q1 & 0xffu) << 8) | (((unsigned)q2 & 0xffu) << 16) | (((unsigned)q3 & 0xffu) << 24); }
        if (lane == 0) SX[m] = am[r] * (1.0f / 127.0f); }
}
constexpr int TK_KEYS_OFF = 65536;
#define TK_INS(L, x_) do { float x__ = (x_); _Pragma("unroll") for (int k_ = 0; k_ < 16; ++k_) { const float hi__ = fmaxf(L[k_], x__); x__ = fminf(L[k_], x__); L[k_] = hi__; } } while (0)
#define TK_CE(a, b) do { const float hi__ = fmaxf(a, b), lo__ = fminf(a, b); a = hi__; b = lo__; } while (0)
__device__ __forceinline__ void tk_sort16_desc(float (&v)[16]) {
#pragma unroll
    for (int k = 2; k <= 16; k <<= 1)
#pragma unroll
        for (int j = k >> 1; j > 0; j >>= 1)
#pragma unroll
            for (int i = 0; i < 16; ++i) { const int l = i ^ j; if (l > i) { if ((i & k) == 0) TK_CE(v[i], v[l]); else TK_CE(v[l], v[i]); } }
}
__device__ __forceinline__ void tk_bitonic_merge16_desc(float (&v)[16]) {
#pragma unroll
    for (int j = 8; j > 0; j >>= 1)
#pragma unroll
        for (int i = 0; i < 16; ++i) { const int l = i ^ j; if (l > i) TK_CE(v[i], v[l]); }
}
__device__ __forceinline__ void tk_merge_top16(float (&a)[16], const float (&b)[16]) {
#pragma unroll
    for (int i = 0; i < 16; ++i) a[i] = fmaxf(a[i], b[15 - i]);
    tk_bitonic_merge16_desc(a);
}
__device__ __forceinline__ void tk_merge_sorted(float (&L)[16]) {
    float Cb[16];
#pragma unroll
    for (int i = 0; i < 16; ++i) Cb[i] = __shfl_xor(L[i], 32);
    float Cm[16];
#pragma unroll
    for (int i = 0; i < 16; ++i) Cm[i] = fmaxf(L[i], Cb[15 - i]);
#pragma unroll
    for (int d = 8; d >= 1; d >>= 1)
#pragma unroll
        for (int i = 0; i < 16; ++i) if ((i & d) == 0) { const float a = fmaxf(Cm[i], Cm[i + d]), b = fminf(Cm[i], Cm[i + d]); Cm[i] = a; Cm[i + d] = b; }
#pragma unroll
    for (int i = 0; i < 16; ++i) L[i] = Cm[i];
}
__device__ __forceinline__ void peer_topk_prefetch(int lane, int tg, int h, int p, const bf16* PQ, const bf16* KEYS, bf16x8 (&qn)[8], bf16x8 (&kn)[8]) {
    const int r32 = lane & 31, hi = lane >> 5;
    const bf16* qp = PQ + ((size_t)tg * 32 + r32) * 2048 + (h * 2 + p) * 128 + hi * 64;
#pragma unroll
    for (int ks = 0; ks < 8; ++ks) qn[ks] = *(const GAS bf16x8*)(qp + ks * 8);
}
__device__ __forceinline__ void peer_topk_unit(Frame& F, int tg, int h, int tgn, int hn, bool has_next, bf16x8 (&qn)[8], bf16x8 (&kn)[8], const bf16* PQ, const bf16* KEYS, int* EIDX, unsigned short* EIDXP, float* GW) {
    const int lane = F.lane, r32 = lane & 31, hi = lane >> 5;
    const size_t tok = (size_t)tg * 32 + r32;
    float sl0[16], sl1[16];
#pragma unroll
    for (int k = 0; k < 16; ++k) { sl0[k] = 0.f; sl1[k] = 0.f; }
#pragma unroll 1
    for (int p = 0; p < 2; ++p) {
        bf16x8 qf[8];
        const LAS unsigned char* kbase = F.lds + RING_OFF + TK_KEYS_OFF + p * 32768 + r32 * 256;
        const int ksw = r32 & 15;
        f32x16 acc[4];
#pragma unroll
        for (int ks = 0; ks < 8; ++ks) qf[ks] = qn[ks];
#pragma unroll
        for (int rb = 0; rb < 4; ++rb) { acc[rb] = f32x16{};
            bf16x8 kf[8];
#pragma unroll
            for (int ks = 0; ks < 8; ++ks) kf[ks] = *(const LAS bf16x8*)(kbase + rb * 8192 + (((8 * hi + ks) ^ ksw) * 16));
#pragma unroll
            for (int ks = 0; ks < 8; ++ks) acc[rb] = __builtin_amdgcn_mfma_f32_32x32x16_bf16(kf[ks], qf[ks], acc[rb], 0, 0, 0); }
        if (p == 0) peer_topk_prefetch(lane, tg, h, 1, PQ, KEYS, qn, kn);
        else if (has_next) peer_topk_prefetch(lane, tgn, hn, 0, PQ, KEYS, qn, kn);
        float L[16], g1[16], g2[16], g3[16];
#pragma unroll
        for (int r = 0; r < 16; ++r) {
            L[r]  = __uint_as_float((__float_as_uint(acc[0][r]) & 0xffffff80u) | (unsigned)(crow(r, hi)));
            g1[r] = __uint_as_float((__float_as_uint(acc[1][r]) & 0xffffff80u) | (unsigned)(32 + crow(r, hi)));
            g2[r] = __uint_as_float((__float_as_uint(acc[2][r]) & 0xffffff80u) | (unsigned)(64 + crow(r, hi)));
            g3[r] = __uint_as_float((__float_as_uint(acc[3][r]) & 0xffffff80u) | (unsigned)(96 + crow(r, hi))); }
        tk_sort16_desc(L); tk_sort16_desc(g1); tk_sort16_desc(g2); tk_sort16_desc(g3);
        tk_merge_top16(L, g1); tk_merge_top16(g2, g3); tk_merge_top16(L, g2);
        tk_merge_sorted(L);
#pragma unroll
        for (int k = 0; k < 16; ++k) { if (p == 0) sl0[k] = L[k]; else sl1[k] = L[k]; }
    }
    float v1[16], v2[16];
#pragma unroll
    for (int k = 0; k < 16; ++k) { v1[k] = __uint_as_float(__float_as_uint(sl0[k]) & 0xffffff80u); v2[k] = __uint_as_float(__float_as_uint(sl1[k]) & 0xffffff80u); }
#define TK_C(a, b) __uint_as_float((__float_as_uint(v1[a] + v2[b]) & 0xffffff00u) | (unsigned)((a) * 16 + (b)))
    float T[16], S1[16], S2[16];
#pragma unroll
    for (int b = 0; b < 16; ++b) T[b] = TK_C(0, b);
#pragma unroll
    for (int b = 0; b < 8; ++b) { S1[b] = TK_C(1, b); S1[8 + b] = TK_C(8 + b, 0); }
    S2[0] = TK_C(2, 0); S2[1] = TK_C(2, 1); S2[2] = TK_C(2, 2); S2[3] = TK_C(2, 3); S2[4] = TK_C(2, 4);
    S2[5] = TK_C(3, 0); S2[6] = TK_C(3, 1); S2[7] = TK_C(3, 2); S2[8] = TK_C(3, 3);
    S2[9] = TK_C(4, 0); S2[10] = TK_C(4, 1); S2[11] = TK_C(4, 2);
    S2[12] = TK_C(5, 0); S2[13] = TK_C(5, 1); S2[14] = TK_C(6, 0); S2[15] = TK_C(6, 1);
    tk_sort16_desc(S1); tk_sort16_desc(S2);
    tk_merge_top16(T, S1); tk_merge_top16(T, S2);
    TK_INS(T, TK_C(7, 0)); TK_INS(T, TK_C(7, 1));
#undef TK_C
    LAS unsigned* lt = (LAS unsigned*)(F.lds + RING_OFF + F.wave * 8192) + lane;
#pragma unroll
    for (int k = 0; k < 16; ++k) { lt[k * 64] = __float_as_uint(sl0[k]) & 127u; lt[(16 + k) * 64] = __float_as_uint(sl1[k]) & 127u; }
    LDS_WAIT(); asm volatile("" ::: "memory");
    unsigned eo[16]; float go[16]; float den = 0.f;
    const float vmax = __uint_as_float(__float_as_uint(T[0]) & 0xffffff00u);
#pragma unroll
    for (int k = 0; k < 16; ++k) { const unsigned bits = __float_as_uint(T[k]); const unsigned a = (bits >> 4) & 15u, b = bits & 15u;
        eo[k] = lt[a * 64] * 128u + lt[(16 + b) * 64];
        go[k] = __builtin_amdgcn_exp2f((__uint_as_float(bits & 0xffffff00u) - vmax) * 1.4426950408889634f); den += go[k]; }
    const float rden = 1.0f / den;
    LDS_WAIT(); asm volatile("" ::: "memory");
    if (hi == 0) { v4u* ep = (v4u*)(EIDX + tok * 128 + h * 16);
#pragma unroll
        for (int q = 0; q < 4; ++q) *(GAS v4u*)(ep + q) = (v4u){eo[4 * q], eo[4 * q + 1], eo[4 * q + 2], eo[4 * q + 3]};
#pragma unroll
        for (int r = 0; r < 8; ++r) *(GAS unsigned*)(EIDXP + tok * 128 + r * 16 + 2 * h) = (eo[r] & 0xffffu) | (eo[8 + r] << 16); }
    else { f32x4* gp = (f32x4*)(GW + tok * 128 + h * 16);
#pragma unroll
        for (int q = 0; q < 4; ++q) *(GAS f32x4*)(gp + q) = (f32x4){go[4 * q] * rden, go[4 * q + 1] * rden, go[4 * q + 2] * rden, go[4 * q + 3] * rden}; }
}
constexpr float PEER_SU = 2048.0f, PEER_SV = 256.0f;
constexpr int PEER_TILES = M / 64;
constexpr int CW_Q6A = 8192, CW_Q6B = 8192 + 8 * 64;
__device__ __forceinline__ float fp8dot16(const v4u& r, const float (&x)[16], float c) {
    const unsigned w[4] = {r.x, r.y, r.z, r.w};
#pragma unroll
    for (int k = 0; k < 4; ++k) { const f32x2v_t lo = __builtin_amdgcn_cvt_pk_f32_fp8((int)w[k], false), hi = __builtin_amdgcn_cvt_pk_f32_fp8((int)w[k], true);
        const float l0 = lo.x, l1 = lo.y, h0 = hi.x, h1 = hi.y;
        c += l0 * x[4 * k]; c += l1 * x[4 * k + 1]; c += h0 * x[4 * k + 2]; c += h1 * x[4 * k + 3]; }
    return c;
}
__device__ __forceinline__ void fp8axpy16(const v4u& r, float wgt, float (&acc)[16]) {
    const unsigned w[4] = {r.x, r.y, r.z, r.w};
#pragma unroll
    for (int k = 0; k < 4; ++k) { const f32x2v_t lo = __builtin_amdgcn_cvt_pk_f32_fp8((int)w[k], false), hi = __builtin_amdgcn_cvt_pk_f32_fp8((int)w[k], true);
        const float l0 = lo.x, l1 = lo.y, h0 = hi.x, h1 = hi.y;
        acc[4 * k] += wgt * l0; acc[4 * k + 1] += wgt * l1; acc[4 * k + 2] += wgt * h0; acc[4 * k + 3] += wgt * h1; }
}
template <class Body>
__device__ __forceinline__ void peer_tasks(Frame& F, gu32* cnt, const Body& body) {
    volatile LAS unsigned* tk = F.MISC + 16;
    const unsigned pref = xb_xcc_id() & 7u;
    for (unsigned k = 0; k < 8; ++k) {
        const unsigned s = (pref + k) & 7u;
        for (;;) {
            if (F.tid == 0) tk[0] = __hip_atomic_fetch_add((unsigned*)(cnt + 64 * s), 1u, __ATOMIC_RELAXED, __HIP_MEMORY_SCOPE_AGENT);
            __syncthreads();
            const unsigned t = tk[0];
            __syncthreads();
            if (t >= (unsigned)PEER_TILES) break;
            body((int)s, (int)t);
        }
    }
}
template <bool IS_U> struct PeerMeta { int id0, id1; float w0, w1; };
struct PeerX { v4u xa, xb; };
template <bool IS_U>
__device__ __forceinline__ void peer_meta_load(PeerMeta<IS_U>& m, int lane, size_t tok, int s, const int* EIDX, const bf16* X1B, const float* W) {
    m.id0 = EIDX[tok * 128 + lane]; m.id1 = EIDX[tok * 128 + 64 + lane];
    if (!IS_U) { m.w0 = W[tok * 128 + lane]; m.w1 = W[tok * 128 + 64 + lane]; }
}
template <bool IS_U>
__device__ __forceinline__ void peer_half_issue(int idh, float wh, int lane, const unsigned char* sbase, v4u (&rows)[8], float (&wj)[8]) {
    const int r = lane >> 3; const unsigned cpo = (unsigned)(lane & 7) * 16u;
#pragma unroll
    for (int j = 0; j < 8; ++j) { const int src = 8 * j + r; const unsigned e = (unsigned)(__shfl(idh, src) & (NEXP - 1)); if (!IS_U) wj[j] = __shfl(wh, src); rows[j] = *(const GAS v4u*)(sbase + (e * 128u + cpo)); }
}
template <bool IS_U, int H>
__device__ __forceinline__ void peer_half_consume(const float (&xq)[16], const v4u (&rows)[8], const float (&wj)[8], float (&v16)[16]) {
    if (IS_U) {
#pragma unroll
        for (int j = 0; j < 8; ++j) v16[8 * H + j] = fp8dot16(rows[j], xq, 0.f);
    } else {
#pragma unroll
        for (int j = 0; j < 8; ++j) fp8axpy16(rows[j], wj[j], v16);
    }
}
template <bool IS_U>
__device__ __forceinline__ void peer_token_finish(int lane, size_t tok, int s, const float (&v16)[16], float* DST) {
    constexpr int B2 = IS_U ? 4 : 32, B1 = IS_U ? 2 : 16, B0 = IS_U ? 1 : 8;
    float r8[8], r4[4], r2[2];
    { const bool up = (lane & B2) != 0;
#pragma unroll
      for (int j = 0; j < 8; ++j) { const float keep = up ? v16[j + 8] : v16[j], send = up ? v16[j] : v16[j + 8]; r8[j] = keep + __shfl_xor(send, B2); } }
    { const bool up = (lane & B1) != 0;
#pragma unroll
      for (int j = 0; j < 4; ++j) { const float keep = up ? r8[j + 4] : r8[j], send = up ? r8[j] : r8[j + 4]; r4[j] = keep + __shfl_xor(send, B1); } }
    { const bool up = (lane & B0) != 0;
#pragma unroll
      for (int j = 0; j < 2; ++j) { const float keep = up ? r4[j + 2] : r4[j], send = up ? r4[j] : r4[j + 2]; r2[j] = keep + __shfl_xor(send, B0); } }
    const int r = lane >> 3, cp = lane & 7;
    if (IS_U) { float* o = DST + ((size_t)s * M + tok) * 128 + 16 * cp + r; o[0] = r2[0]; o[8] = r2[1]; }
    else { *(GAS unsigned*)((bf16*)DST + tok * 1024 + s * 128 + 16 * cp + 2 * r) = cvtpk(r2[0], r2[1]); }
}
template <bool IS_U, int H>
__device__ __forceinline__ void peer_half_consume2(const PeerMeta<IS_U>& m, int lane, const float (&xq)[16], const v4u (&rows)[8], float (&v16)[16]) {
    if (IS_U) {
#pragma unroll
        for (int j = 0; j < 8; ++j) v16[8 * H + j] = fp8dot16(rows[j], xq, 0.f);
    } else {
        const int r = lane >> 3;
#pragma unroll
        for (int j = 0; j < 8; ++j) { const float wj = __shfl(H ? m.w1 : m.w0, 8 * j + r); fp8axpy16(rows[j], wj, v16); }
    }
}
template <bool IS_U>
__device__ __forceinline__ void peer_half_issue2(int idh, int lane, const unsigned char* sbase, v4u (&rows)[8]) {
    const int r = lane >> 3; const unsigned cpo = (unsigned)(lane & 7) * 16u;
#pragma unroll
    for (int j = 0; j < 8; ++j) { const unsigned e = (unsigned)(__shfl(idh, 8 * j + r) & (NEXP - 1)); rows[j] = *(const GAS v4u*)(sbase + (e * 128u + cpo)); }
}
__device__ __forceinline__ void peer_x_load(PeerX& x, int lane, size_t tok, int s, const bf16* X1B) { const bf16* xp = X1B + tok * 1024 + s * 128 + (lane & 7) * 16; x.xa = *(const GAS v4u*)xp; x.xb = *(const GAS v4u*)(xp + 8); }
template <bool IS_U>
__device__ __forceinline__ void peer_xq(const PeerX& c, float (&xq)[16]) {
    if (IS_U) {
        xq[0] = bf_lo(c.xa.x); xq[1] = bf_hi(c.xa.x); xq[2] = bf_lo(c.xa.y); xq[3] = bf_hi(c.xa.y); xq[4] = bf_lo(c.xa.z); xq[5] = bf_hi(c.xa.z); xq[6] = bf_lo(c.xa.w); xq[7] = bf_hi(c.xa.w);
        xq[8] = bf_lo(c.xb.x); xq[9] = bf_hi(c.xb.x); xq[10] = bf_lo(c.xb.y); xq[11] = bf_hi(c.xb.y); xq[12] = bf_lo(c.xb.z); xq[13] = bf_hi(c.xb.z); xq[14] = bf_lo(c.xb.w); xq[15] = bf_hi(c.xb.w); }
}
template <bool IS_U>
__device__ __forceinline__ void peer_slice_task(Frame& F, int s, int t, const unsigned char* TAB, const int* EIDX, const bf16* X1B, const float* W, float* DST) {
    const int lane = F.lane; const size_t tok0 = (size_t)t * 64 + F.wave * 8;
    const unsigned char* sbase = TAB + (size_t)s * NEXP * 128;
    PeerMeta<IS_U> mA, mB, mC, mD; PeerX xA, xB; v4u r0[8], r1[8], r2[8], r3[8];
    if (IS_U) { peer_x_load(xA, lane, tok0, s, X1B); peer_x_load(xB, lane, tok0 + 1, s, X1B); }
    peer_meta_load<IS_U>(mA, lane, tok0, s, EIDX, X1B, W);
    peer_meta_load<IS_U>(mB, lane, tok0 + 1, s, EIDX, X1B, W);
    peer_meta_load<IS_U>(mC, lane, tok0 + 2, s, EIDX, X1B, W);
    peer_half_issue2<IS_U>(mA.id0, lane, sbase, r0);
    peer_half_issue2<IS_U>(mA.id1, lane, sbase, r1);
    peer_half_issue2<IS_U>(mB.id0, lane, sbase, r2);
#pragma unroll 1
    for (int j = 0; j < 4; ++j) {
        const size_t tk = tok0 + 2 * j; float xq[16], v16[16];
        peer_half_issue2<IS_U>(mB.id1, lane, sbase, r3);
        if (j < 3) peer_meta_load<IS_U>(mD, lane, tk + 3, s, EIDX, X1B, W);
        peer_xq<IS_U>(xA, xq);
#pragma unroll
        for (int q = 0; q < 16; ++q) v16[q] = 0.f;
        peer_half_consume2<IS_U, 0>(mA, lane, xq, r0, v16);
        if (j < 3) peer_half_issue2<IS_U>(mC.id0, lane, sbase, r0);
        peer_half_consume2<IS_U, 1>(mA, lane, xq, r1, v16);
        peer_token_finish<IS_U>(lane, tk, s, v16, DST);
        if (j < 3) peer_half_issue2<IS_U>(mC.id1, lane, sbase, r1);
        if (j < 2) peer_meta_load<IS_U>(mA, lane, tk + 4, s, EIDX, X1B, W);
        if (IS_U && j < 3) peer_x_load(xA, lane, tk + 2, s, X1B);
        peer_xq<IS_U>(xB, xq);
#pragma unroll
        for (int q = 0; q < 16; ++q) v16[q] = 0.f;
        peer_half_consume2<IS_U, 0>(mB, lane, xq, r2, v16);
        if (j < 3) peer_half_issue2<IS_U>(mD.id0, lane, sbase, r2);
        if (IS_U && j < 3) peer_x_load(xB, lane, tk + 3, s, X1B);
        peer_half_consume2<IS_U, 1>(mB, lane, xq, r3, v16);
        peer_token_finish<IS_U>(lane, tk + 1, s, v16, DST);
        { const PeerMeta<IS_U> tmp = mA; mA = mC; mB = mD; mC = tmp; }
    }
}
__device__ __forceinline__ void peer_slice_task_v(Frame& F, int s, int t, const unsigned char* TAB, const int* EIDX, const bf16* X1B, const float* W, float* DST) {
    const int lane = F.lane; const size_t tok0 = (size_t)t * 64 + F.wave * 8;
    const unsigned char* sbase = TAB + (size_t)s * NEXP * 128;
    PeerMeta<false> cur, nxt; v4u rowsA[8], rowsB[8]; float wA[8], wB[8];
    peer_meta_load<false>(cur, lane, tok0, s, EIDX, X1B, W);
    peer_meta_load<false>(nxt, lane, tok0 + 1, s, EIDX, X1B, W);
    peer_half_issue<false>(cur.id0, cur.w0, lane, sbase, rowsA, wA);
#pragma unroll 1
    for (int i = 0; i < 8; ++i) {
        float xq[16];
        float v16[16];
#pragma unroll
        for (int k = 0; k < 16; ++k) v16[k] = 0.f;
        peer_half_issue<false>(cur.id1, cur.w1, lane, sbase, rowsB, wB);
        peer_half_consume<false, 0>(xq, rowsA, wA, v16);
        if (i + 1 < 8) peer_half_issue<false>(nxt.id0, nxt.w0, lane, sbase, rowsA, wA);
        peer_half_consume<false, 1>(xq, rowsB, wB, v16);
        peer_token_finish<false>(lane, tok0 + i, s, v16, DST);
        cur = nxt;
        if (i + 2 < 8) peer_meta_load<false>(nxt, lane, tok0 + i + 2, s, EIDX, X1B, W);
    }
}
__device__ __forceinline__ int dot16_i8(const v4u& r, const v4u& x) {
    int c = __builtin_amdgcn_sdot4((int)r.x, (int)x.x, 0, false); c = __builtin_amdgcn_sdot4((int)r.y, (int)x.y, c, false); c = __builtin_amdgcn_sdot4((int)r.z, (int)x.z, c, false); return __builtin_amdgcn_sdot4((int)r.w, (int)x.w, c, false);
}
__device__ __forceinline__ void quad_dot(unsigned r0, unsigned r1, unsigned r2, unsigned r3, int w4, int& a0, int& a1, int& a2, int& a3) {
    const unsigned t0 = __builtin_amdgcn_perm(r1, r0, 0x05010400u), t1 = __builtin_amdgcn_perm(r1, r0, 0x07030602u), t2 = __builtin_amdgcn_perm(r3, r2, 0x05010400u), t3 = __builtin_amdgcn_perm(r3, r2, 0x07030602u);
    const unsigned c0 = __builtin_amdgcn_perm(t2, t0, 0x05040100u), c1 = __builtin_amdgcn_perm(t2, t0, 0x07060302u), c2 = __builtin_amdgcn_perm(t3, t1, 0x05040100u), c3 = __builtin_amdgcn_perm(t3, t1, 0x07060302u);
    a0 = __builtin_amdgcn_sdot4((int)c0, w4, a0, false); a1 = __builtin_amdgcn_sdot4((int)c1, w4, a1, false); a2 = __builtin_amdgcn_sdot4((int)c2, w4, a2, false); a3 = __builtin_amdgcn_sdot4((int)c3, w4, a3, false);
}
__device__ __forceinline__ void half_axpy_i8(const v4u (&rows)[8], int wq0, int wq1, int (&acc)[16]) {
    quad_dot(rows[0].x, rows[1].x, rows[2].x, rows[3].x, wq0, acc[0], acc[1], acc[2], acc[3]);
    quad_dot(rows[0].y, rows[1].y, rows[2].y, rows[3].y, wq0, acc[4], acc[5], acc[6], acc[7]);
    quad_dot(rows[0].z, rows[1].z, rows[2].z, rows[3].z, wq0, acc[8], acc[9], acc[10], acc[11]);
    quad_dot(rows[0].w, rows[1].w, rows[2].w, rows[3].w, wq0, acc[12], acc[13], acc[14], acc[15]);
    quad_dot(rows[4].x, rows[5].x, rows[6].x, rows[7].x, wq1, acc[0], acc[1], acc[2], acc[3]);
    quad_dot(rows[4].y, rows[5].y, rows[6].y, rows[7].y, wq1, acc[4], acc[5], acc[6], acc[7]);
    quad_dot(rows[4].z, rows[5].z, rows[6].z, rows[7].z, wq1, acc[8], acc[9], acc[10], acc[11]);
    quad_dot(rows[4].w, rows[5].w, rows[6].w, rows[7].w, wq1, acc[12], acc[13], acc[14], acc[15]);
}
template <int B2, int B1, int B0>
__device__ __forceinline__ void tr_reduce16(int lane, const int (&v16)[16], int& o0, int& o1) {
    int r8[8], r4[4];
    { const bool up = (lane & B2) != 0;
#pragma unroll
      for (int j = 0; j < 8; ++j) { const int keep = up ? v16[j + 8] : v16[j], send = up ? v16[j] : v16[j + 8]; r8[j] = keep + __shfl_xor(send, B2); } }
    { const bool up = (lane & B1) != 0;
#pragma unroll
      for (int j = 0; j < 4; ++j) { const int keep = up ? r8[j + 4] : r8[j], send = up ? r8[j] : r8[j + 4]; r4[j] = keep + __shfl_xor(send, B1); } }
    { const bool up = (lane & B0) != 0;
      { const int keep = up ? r4[2] : r4[0], send = up ? r4[0] : r4[2]; o0 = keep + __shfl_xor(send, B0); }
      { const int keep = up ? r4[3] : r4[1], send = up ? r4[1] : r4[3]; o1 = keep + __shfl_xor(send, B0); } }
}
struct PeerIdsH { v4u a; };
__device__ __forceinline__ void peer_ids_half(PeerIdsH& m, int lane, size_t tok, int h, const unsigned short* EIDXP) { m.a = *(const GAS v4u*)(EIDXP + tok * 128 + (lane >> 3) * 16 + 8 * h); }
__device__ __forceinline__ void peer_half_issue3(const PeerIdsH& m, int lane, const unsigned char* sbase, v4u (&rows)[8]) {
    const unsigned cpo = (unsigned)(lane & 7) * 16u;
    const unsigned e[8] = {m.a.x & 0xffffu, m.a.x >> 16, m.a.y & 0xffffu, m.a.y >> 16, m.a.z & 0xffffu, m.a.z >> 16, m.a.w & 0xffffu, m.a.w >> 16};
#pragma unroll
    for (int j = 0; j < 8; ++j) rows[j] = *(const GAS v4u*)(sbase + ((e[j] & (unsigned)(NEXP - 1)) * 128u + cpo));
}
template <bool IS_U>
__device__ __forceinline__ void peer_slice_task(Frame& F, int s, int t, const unsigned char* TAB, const unsigned short* EIDXP, const unsigned char* XW, const float* SW, void* DST) {
    const int lane = F.lane, r = lane >> 3, cp = lane & 7; const size_t tok0 = (size_t)t * 64 + F.wave * 8;
    const unsigned char* sbase = TAB + (size_t)s * NEXP * 128;
    const unsigned char* xb = IS_U ? (XW + s * 128 + cp * 16) : (XW + r * 16);
    constexpr size_t XS = IS_U ? 1024 : 128;
    PeerIdsH iA, iB; v4u xA, xB; v4u r0[8], r1[8], r2[8], r3[8];
    peer_ids_half(iA, lane, tok0, 0, EIDXP); peer_ids_half(iB, lane, tok0, 1, EIDXP);
    xA = *(const GAS v4u*)(xb + tok0 * XS); xB = *(const GAS v4u*)(xb + (tok0 + 1) * XS);
    peer_half_issue3(iA, lane, sbase, r0); peer_ids_half(iA, lane, tok0 + 1, 0, EIDXP);
    peer_half_issue3(iB, lane, sbase, r1); peer_ids_half(iB, lane, tok0 + 1, 1, EIDXP);
    peer_half_issue3(iA, lane, sbase, r2); peer_ids_half(iA, lane, tok0 + 2, 0, EIDXP);
#define PEER_FINISH(tk_, v16_) do { int o0_, o1_; \
        if (IS_U) { tr_reduce16<4, 2, 1>(lane, v16_, o0_, o1_); int* a_ = (int*)DST + (size_t)(tk_) * 128 + cp * 8 + r; __hip_atomic_fetch_add(a_, o0_, __ATOMIC_RELAXED, __HIP_MEMORY_SCOPE_AGENT); __hip_atomic_fetch_add(a_ + 64, o1_, __ATOMIC_RELAXED, __HIP_MEMORY_SCOPE_AGENT); }       \
        else { tr_reduce16<32, 16, 8>(lane, v16_, o0_, o1_); const float sw_ = SW[(tk_)]; *(GAS unsigned*)((bf16*)DST + (tk_) * 1024 + s * 128 + 16 * cp + 2 * r) = cvtpk((float)o0_ * sw_, (float)o1_ * sw_); } } while (0)
#pragma unroll 1
    for (int j = 0; j < 4; ++j) {
        const size_t tk = tok0 + 2 * j; int v16[16];
        peer_half_issue3(iB, lane, sbase, r3);
        if (j < 3) peer_ids_half(iB, lane, tk + 2, 1, EIDXP);
        if (IS_U) {
#pragma unroll
            for (int q = 0; q < 8; ++q) v16[q] = dot16_i8(r0[q], xA);
        } else {
#pragma unroll
            for (int q = 0; q < 16; ++q) v16[q] = 0;
            half_axpy_i8(r0, (int)xA.x, (int)xA.y, v16);
        }
        if (j < 3) { peer_half_issue3(iA, lane, sbase, r0); peer_ids_half(iA, lane, tk + 3, 0, EIDXP); }
        if (IS_U) {
#pragma unroll
            for (int q = 0; q < 8; ++q) v16[8 + q] = dot16_i8(r1[q], xA);
        } else half_axpy_i8(r1, (int)xA.z, (int)xA.w, v16);
        PEER_FINISH(tk, v16);
        if (j < 3) { peer_half_issue3(iB, lane, sbase, r1); peer_ids_half(iB, lane, tk + 3, 1, EIDXP); xA = *(const GAS v4u*)(xb + (tk + 2) * XS); }
        if (IS_U) {
#pragma unroll
            for (int q = 0; q < 8; ++q) v16[q] = dot16_i8(r2[q], xB);
        } else {
#pragma unroll
            for (int q = 0; q < 16; ++q) v16[q] = 0;
            half_axpy_i8(r2, (int)xB.x, (int)xB.y, v16);
        }
        if (j < 3) { peer_half_issue3(iA, lane, sbase, r2); if (j < 2) peer_ids_half(iA, lane, tk + 4, 0, EIDXP); }
        if (IS_U) {
#pragma unroll
            for (int q = 0; q < 8; ++q) v16[8 + q] = dot16_i8(r3[q], xB);
        } else half_axpy_i8(r3, (int)xB.z, (int)xB.w, v16);
        PEER_FINISH(tk + 1, v16);
        if (j < 3) xB = *(const GAS v4u*)(xb + (tk + 3) * XS);
    }
#undef PEER_FINISH
}
template <bool IS_U>
__device__ __forceinline__ void peer_slice_stream(Frame& F, int s, int tokB, int tokE, const unsigned char* TAB, const unsigned short* EIDXP, const unsigned char* XW, const float* SW, void* DST) {
    const int lane = F.lane, r = lane >> 3, cp = lane & 7; const size_t tok0 = (size_t)tokB; const size_t tokL = (size_t)tokE - 1; const int np = (tokE - tokB + 1) >> 1;
#define CL(t_) ((t_) < tokL ? (t_) : tokL)
    const unsigned char* sbase = TAB + (size_t)s * NEXP * 128;
    const unsigned char* xb = IS_U ? (XW + s * 128 + cp * 16) : (XW + r * 16);
    constexpr size_t XS = IS_U ? 1024 : 128;
    PeerIdsH iA, iB; v4u xA, xB; v4u r0[8], r1[8], r2[8], r3[8];
    peer_ids_half(iA, lane, tok0, 0, EIDXP); peer_ids_half(iB, lane, tok0, 1, EIDXP);
    xA = *(const GAS v4u*)(xb + tok0 * XS); xB = *(const GAS v4u*)(xb + CL(tok0 + 1) * XS);
    peer_half_issue3(iA, lane, sbase, r0); peer_ids_half(iA, lane, CL(tok0 + 1), 0, EIDXP);
    peer_half_issue3(iB, lane, sbase, r1); peer_ids_half(iB, lane, CL(tok0 + 1), 1, EIDXP);
    peer_half_issue3(iA, lane, sbase, r2); peer_ids_half(iA, lane, CL(tok0 + 2), 0, EIDXP);
#define PEER_FINISH(tk_, v16_) do { int o0_, o1_; \
        if (IS_U) { tr_reduce16<4, 2, 1>(lane, v16_, o0_, o1_); int* a_ = (int*)DST + (size_t)(tk_) * 128 + cp * 8 + r; __hip_atomic_fetch_add(a_, o0_, __ATOMIC_RELAXED, __HIP_MEMORY_SCOPE_AGENT); __hip_atomic_fetch_add(a_ + 64, o1_, __ATOMIC_RELAXED, __HIP_MEMORY_SCOPE_AGENT); }       \
        else { tr_reduce16<32, 16, 8>(lane, v16_, o0_, o1_); const float sw_ = SW[(tk_)]; *(GAS unsigned*)((bf16*)DST + (tk_) * 1024 + s * 128 + 16 * cp + 2 * r) = cvtpk((float)o0_ * sw_, (float)o1_ * sw_); } } while (0)
#pragma unroll 1
    for (int j = 0; j < np; ++j) { const bool more = j < np - 1;
        const size_t tk = tok0 + 2 * j; int v16[16];
        peer_half_issue3(iB, lane, sbase, r3);
        if (more) peer_ids_half(iB, lane, CL(tk + 2), 1, EIDXP);
        if (IS_U) {
#pragma unroll
            for (int q = 0; q < 8; ++q) v16[q] = dot16_i8(r0[q], xA);
        } else {
#pragma unroll
            for (int q = 0; q < 16; ++q) v16[q] = 0;
            half_axpy_i8(r0, (int)xA.x, (int)xA.y, v16);
        }
        if (more) { peer_half_issue3(iA, lane, sbase, r0); peer_ids_half(iA, lane, CL(tk + 3), 0, EIDXP); }
        if (IS_U) {
#pragma unroll
            for (int q = 0; q < 8; ++q) v16[8 + q] = dot16_i8(r1[q], xA);
        } else half_axpy_i8(r1, (int)xA.z, (int)xA.w, v16);
        PEER_FINISH(tk, v16);
        if (more) { peer_half_issue3(iB, lane, sbase, r1); peer_ids_half(iB, lane, CL(tk + 3), 1, EIDXP); xA = *(const GAS v4u*)(xb + CL(tk + 2) * XS); }
        if (IS_U) {
#pragma unroll
            for (int q = 0; q < 8; ++q) v16[q] = dot16_i8(r2[q], xB);
        } else {
#pragma unroll
            for (int q = 0; q < 16; ++q) v16[q] = 0;
            half_axpy_i8(r2, (int)xB.x, (int)xB.y, v16);
        }
        if (more) { peer_half_issue3(iA, lane, sbase, r2); if (j < np - 2) peer_ids_half(iA, lane, CL(tk + 4), 0, EIDXP); }
        if (IS_U) {
#pragma unroll
            for (int q = 0; q < 8; ++q) v16[8 + q] = dot16_i8(r3[q], xB);
        } else half_axpy_i8(r3, (int)xB.z, (int)xB.w, v16);
        if (tk + 1 <= tokL) PEER_FINISH(tk + 1, v16);
        if (more) xB = *(const GAS v4u*)(xb + CL(tk + 3) * XS);
    }
#undef PEER_FINISH
#undef CL
}
template <int NR>
__device__ __forceinline__ void peer_reduce_tokens(int lane, const size_t (&toks)[NR], const int* PART, const int* EIDX, const float* USC, const float* VSC, const float* SX, const float* GW, unsigned char* WQ, float* SW) {
    const int pi0 = ((lane >> 3) & 1) * 64 + (lane >> 4) * 8 + (lane & 7);
    int p0[NR][1], p1[NR][1], e0[NR], e1[NR]; float g0[NR], g1[NR], sx[NR], u0[NR], u1[NR], c0[NR], c1[NR];
#pragma unroll
    for (int r = 0; r < NR; ++r) { const size_t tok = toks[r];
        p0[r][0] = PART[tok * 128 + pi0]; p1[r][0] = PART[tok * 128 + pi0 + 32];
        e0[r] = EIDX[tok * 128 + lane] & (NEXP - 1); e1[r] = EIDX[tok * 128 + 64 + lane] & (NEXP - 1); g0[r] = GW[tok * 128 + lane]; g1[r] = GW[tok * 128 + 64 + lane]; sx[r] = SX[tok]; }
#pragma unroll
    for (int r = 0; r < NR; ++r) { u0[r] = USC[e0[r]]; u1[r] = USC[e1[r]]; c0[r] = VSC[e0[r]]; c1[r] = VSC[e1[r]]; }
    float w0[NR], w1[NR], m[NR];
#pragma unroll
    for (int r = 0; r < NR; ++r) { const int a0 = p0[r][0], a1 = p1[r][0];
        w0[r] = g0[r] * gelu_tanh((float)a0 * u0[r] * sx[r]) * c0[r]; w1[r] = g1[r] * gelu_tanh((float)a1 * u1[r] * sx[r]) * c1[r];
        m[r] = fmaxf(fabsf(w0[r]), fabsf(w1[r])); }
    wave_max_n<NR>(m);
#pragma unroll
    for (int r = 0; r < NR; ++r) { const size_t tok = toks[r]; const float inv = m[r] > 0.f ? 127.0f / m[r] : 0.f;
        const int q0 = (int)rintf(w0[r] * inv), q1 = (int)rintf(w1[r] * inv);
        WQ[tok * 128 + (lane & 7) * 16 + (lane >> 3)] = (unsigned char)(q0 & 0xff);
        WQ[tok * 128 + (lane & 7) * 16 + 8 + (lane >> 3)] = (unsigned char)(q1 & 0xff);
        if (lane == 0) SW[tok] = m[r] * (1.0f / 127.0f); }
}
template <int NR> struct Ln2Raw { u32x2v_t x[NR][4], f[NR][4]; };
template <int NR>
__device__ __forceinline__ void ln2_load(Ln2Raw<NR>& raw, int lane, const bf16* X1B, const bf16* FFN, const size_t (&rows)[NR]) {
#pragma unroll
    for (int r = 0; r < NR; ++r)
#pragma unroll
        for (int j = 0; j < 4; ++j) { raw.x[r][j] = ((const GAS u32x2v_t*)(X1B + rows[r] * D))[lane + 64 * j]; raw.f[r][j] = ((const GAS u32x2v_t*)(FFN + rows[r] * D))[lane + 64 * j]; }
}
template <int NR>
__device__ __forceinline__ void ln2_rows(const Ln2Raw<NR>& raw, int lane, const size_t (&rows)[NR], const float* g, const float* bt, float* X2, bf16* X2B) {
    f32x4 gg[4], bb[4];
#pragma unroll
    for (int j = 0; j < 4; ++j) { gg[j] = ((const GAS f32x4*)g)[lane + 64 * j]; bb[j] = ((const GAS f32x4*)bt)[lane + 64 * j]; }
    f32x4 v[NR][4]; float s[NR], s2[NR];
#pragma unroll
    for (int r = 0; r < NR; ++r) { s[r] = 0.f;
#pragma unroll
        for (int j = 0; j < 4; ++j) { const u32x2v_t xb = raw.x[r][j], fb = raw.f[r][j]; const unsigned x0 = xb[0], x1_ = xb[1], f0 = fb[0], f1 = fb[1];
            const f32x4 a = (f32x4){bf_lo(x0), bf_hi(x0), bf_lo(x1_), bf_hi(x1_)}, f = (f32x4){bf_lo(f0), bf_hi(f0), bf_lo(f1), bf_hi(f1)};
            v[r][j] = a * ALPHA + f; s[r] += (v[r][j].x + v[r][j].y) + (v[r][j].z + v[r][j].w); } }
    wave_sum_n<NR>(s);
#pragma unroll
    for (int r = 0; r < NR; ++r) { const float mean = s[r] * (1.f / D); s2[r] = 0.f;
#pragma unroll
        for (int j = 0; j < 4; ++j) { v[r][j] = v[r][j] - mean; s2[r] += (v[r][j].x * v[r][j].x + v[r][j].y * v[r][j].y) + (v[r][j].z * v[r][j].z + v[r][j].w * v[r][j].w); } }
    wave_sum_n<NR>(s2);
#pragma unroll
    for (int r = 0; r < NR; ++r) { const float rstd = 1.f / sqrtf(s2[r] * (1.f / D) + LN_EPS); const size_t m = rows[r];
#pragma unroll
        for (int j = 0; j < 4; ++j) { const f32x4 o = v[r][j] * rstd * gg[j] + bb[j];
            u32x2v_t w; w.x = cvtpk(o.x, o.y); w.y = cvtpk(o.z, o.w);
            ((GAS u32x2v_t*)(X2B + m * D))[lane + 64 * j] = w; } }
}
template <class Epi>
__device__ __forceinline__ void sample_gemm(Frame& F, const bf16* A, const bf16* Bt, int N, int K, const Epi& epi, int cu_lo = 0, int cu = -1) {
    const int lane = F.lane, r32 = lane & 31, hi = lane >> 5;
    const int ntile = 8 * (N / 32);
    const int Gs = F.G - cu_lo; const int me = cu < 0 ? F.vcu : cu;
    if (me < cu_lo) return;
    for (int wt = (me - cu_lo) + F.wave * Gs; wt < ntile; wt += Gs * NWAVES) {
        const int rt = wt & 7, ct = wt >> 3;
        const bf16* ap = A + (size_t)(32 * rt + r32) * K + 64 * hi;
        const bf16* bp = Bt + (size_t)(32 * ct + r32) * K + 64 * hi;
        f32x16 acc = f32x16{};
        bf16x8 a0[8], b0[8], a1[8], b1[8];
#pragma unroll
        for (int j = 0; j < 8; ++j) { a0[j] = *(const GAS bf16x8*)(ap + 8 * j); b0[j] = *(const GAS bf16x8*)(bp + 8 * j); }
#pragma unroll 1
        for (int k0 = 0; k0 < K; k0 += 256) {
#pragma unroll
            for (int j = 0; j < 8; ++j) { a1[j] = *(const GAS bf16x8*)(ap + k0 + 128 + 8 * j); b1[j] = *(const GAS bf16x8*)(bp + k0 + 128 + 8 * j); }
#pragma unroll
            for (int j = 0; j < 8; ++j) acc = __builtin_amdgcn_mfma_f32_32x32x16_bf16(a0[j], b0[j], acc, 0, 0, 0);
            if (k0 + 256 < K) {
#pragma unroll
                for (int j = 0; j < 8; ++j) { a0[j] = *(const GAS bf16x8*)(ap + k0 + 256 + 8 * j); b0[j] = *(const GAS bf16x8*)(bp + k0 + 256 + 8 * j); }
            }
#pragma unroll
            for (int j = 0; j < 8; ++j) acc = __builtin_amdgcn_mfma_f32_32x32x16_bf16(a1[j], b1[j], acc, 0, 0, 0);
        }
#pragma unroll
        for (int r = 0; r < 16; ++r) epi(32 * rt + crow(r, hi), 32 * ct + r32, acc[r], 32 * ct);
    }
}
template <class Pre, class Fin>
__device__ __forceinline__ void sample_gemm_ks(Frame& F, const bf16* A, const bf16* Bt, int N, const Pre& pre, const Fin& fin) {
    constexpr int K = 1024;
    const int lane = F.lane, r32 = lane & 31, hi = lane >> 5;
    const int ntile = 8 * (N / 32);
    LAS float* red = (LAS float*)(F.lds + RING_OFF);
    const int orr = 2 * F.wave + (lane >> 5), opp = lane & 31, ohi = opp >> 4, oc = (2 * opp) & 31;
    for (int wt = F.vcu; wt < ntile; wt += F.G) {
        const int rt = wt & 7, ct = wt >> 3;
        const int row = 32 * rt + crow(orr, ohi), col = 32 * ct + oc;
        const auto pv = pre(row, col);
        const bf16* ap = A + (size_t)(32 * rt + r32) * K + 128 * F.wave + 64 * hi;
        const bf16* bp = Bt + (size_t)(32 * ct + r32) * K + 128 * F.wave + 64 * hi;
        bf16x8 a[8], b[8];
#pragma unroll
        for (int j = 0; j < 8; ++j) { a[j] = *(const GAS bf16x8*)(ap + 8 * j); b[j] = *(const GAS bf16x8*)(bp + 8 * j); }
        f32x16 acc = f32x16{};
#pragma unroll
        for (int j = 0; j < 8; ++j) acc = __builtin_amdgcn_mfma_f32_32x32x16_bf16(a[j], b[j], acc, 0, 0, 0);
#pragma unroll
        for (int r = 0; r < 16; ++r) red[(F.wave * 16 + r) * 64 + lane] = acc[r];
        __syncthreads();
        float v0 = 0.f, v1 = 0.f;
#pragma unroll
        for (int w = 0; w < NWAVES; ++w) { const f32x2v_t t = *(const LAS f32x2v_t*)(red + (w * 16 + orr) * 64 + 2 * opp); v0 += t.x; v1 += t.y; }
        fin(row, col, v0, v1, pv);
        __syncthreads();
    }
}
__global__ void __launch_bounds__(NWAVES * 64, 2) mega_fwd(Args args) {
    extern __shared__ __attribute__((aligned(16))) unsigned char lds[];
    Frame F;
    F.lds = (LAS unsigned char*)lds;
    F.MISC = (volatile LAS unsigned*)(F.lds + MISC_OFF);
    F.tid = threadIdx.x; F.lane = F.tid & 63; F.wave = __builtin_amdgcn_readfirstlane(F.tid >> 6);
    F.G = gridDim.x; { const int bx = blockIdx.x; F.vcu = (F.G % 8 == 0) ? (bx % 8) * (F.G / 8) + bx / 8 : bx; }
    unsigned char* ws = args.ws;
    F.ctl = (gu32*)(ws + WS_CTL);
    for (int u = F.tid; u < (LDS_BYTES - LDSCTL_OFF) / 4; u += NWAVES * 64) ((LAS unsigned*)(F.lds + LDSCTL_OFF))[u] = 0u;
    __syncthreads();
    XcdBarrier bar = xcd_barrier_post((unsigned*)(F.ctl + CW_BAR), F.MISC + 8);
    float* out = args.out;
#define LAUNDER() do { asm volatile("" : "+v"(F.tid)); F.lane = F.tid & 63; } while (0)

    LAUNDER();
    p0_prologue(F, args, ws);
    xcd_barrier(bar);

    LAUNDER();
    {
        pg8::Gemm g{(const pg8::bf16_t*)(ws + WS_XB), (const pg8::bf16_t*)(ws + WS_WIN_T), MP, INW, D}; pg8::StaticOrder S; S.init(MP, INW, F.G, (int)blockIdx.x);
        pg8::EpiIn E{(pg8::bf16_t*)(ws + WS_Q), (pg8::bf16_t*)(ws + WS_KB), (pg8::bf16_t*)(ws + WS_VB), (pg8::bf16_t*)(ws + WS_XR), (pg8::bf16_t*)(ws + WS_GT),
                     out + O_KP, out + O_VP, out + O_CP, out + O_KS, out + O_VS, out + O_CS};
        pg8::gemm_phase<pg8::EpiIn, pg8::StaticOrder, true, true>(F.lds + RING_OFF, g, S, E);
    }
    {
        LAUNDER();
        pg8::Gemm g{(const pg8::bf16_t*)(ws + WS_PE), (const pg8::bf16_t*)(ws + WS_WPLE_T), MP, D, 256};
        pg8::EpiBf16 E{(pg8::bf16_t*)(ws + WS_PLE), D};
        const int hg = F.G / 2;
        if ((int)blockIdx.x >= hg) { pg8::StaticOrder S; S.init(MP, D, F.G - hg, (int)blockIdx.x - hg); pg8::gemm_phase<pg8::EpiBf16, pg8::StaticOrder, true, true>(F.lds + RING_OFF, g, S, E); }
    }
    LAUNDER();
    {
        bf16 *Qs = (bf16*)(ws + WS_Q) + (size_t)MP * 512, *KBs = (bf16*)(ws + WS_KB) + (size_t)MP * 512, *VBs = (bf16*)(ws + WS_VB) + (size_t)MP * 512, *XRs = (bf16*)(ws + WS_XR) + (size_t)MP * 512, *GTs = (bf16*)(ws + WS_GT) + (size_t)MP * 512;
        float *ks = out + O_KS, *vs = out + O_VS, *cs = out + O_CS;
        sample_gemm(F, (const bf16*)(ws + WS_XB) + (size_t)MP * D, (const bf16*)(ws + WS_WIN_T), INW, D, [&](int row, int col, float v, int c0) {
            const int kind = col >> 9, cc = col & 511, t = row & 7;
            if (kind <= 1 && (c0 & 63) == 0) {
                const float oth = __shfl_xor(v, 8); const int d = cc & 15, i = d & 7;
                const float RC[8] = {0.15915494309189535f, 0.03086376340470123f, 0.005985185712713705f, 0.001160663641240061f, 0.00022507907903927653f, 4.364795279280289e-05f, 8.464330808241401e-06f, 1.6414262627950345e-06f};
                float rc = RC[0];
#pragma unroll
                for (int q = 1; q < 8; ++q) rc = (i == q) ? RC[q] : rc;
                float rv = (float)(PAST + t) * rc; rv = rv - floorf(rv);
                const float c = __builtin_amdgcn_cosf(rv), sn = __builtin_amdgcn_sinf(rv);
                if ((cc & 63) < 16) v = d < 8 ? v * c - oth * sn : v * c + oth * sn;
            }
            if (kind == 0) Qs[(size_t)row * 512 + cc] = (bf16)f2bf(v * 0.18033688011112042f);
            else if (kind == 1) { KBs[(size_t)row * 512 + cc] = (bf16)f2bf(v); ks[(size_t)row * 512 + cc] = v; }
            else if (kind == 2) { VBs[(size_t)row * 512 + cc] = (bf16)f2bf(v); vs[(size_t)row * 512 + cc] = v; }
            else if (kind == 3) { XRs[(size_t)row * 512 + cc] = (bf16)f2bf(v); if (t >= 5) cs[(size_t)((row >> 3) * 3 + (t - 5)) * 512 + cc] = v; }
            else GTs[(size_t)row * 512 + cc] = (bf16)f2bf(v);
        }, F.G / 2, (int)blockIdx.x);
        bf16* PLEs = (bf16*)(ws + WS_PLE) + (size_t)MP * D;
        sample_gemm(F, (const bf16*)(ws + WS_PE) + (size_t)MP * 256, (const bf16*)(ws + WS_WPLE_T), D, 256, [&](int row, int col, float v, int) { PLEs[(size_t)row * D + col] = (bf16)f2bf(v); }, F.G / 2, (int)blockIdx.x);
    }
    xcd_barrier(bar);

    float lam;
    { const float a = wave_sum(((const float*)args.in[10])[F.lane] * ((const float*)args.in[11])[F.lane]);
      const float b = wave_sum(((const float*)args.in[12])[F.lane] * ((const float*)args.in[13])[F.lane]);
      lam = expf(a) - expf(b) + LAM_INIT; }
    const float* subln = (const float*)args.in[14];
    bf16* MIX = (bf16*)(ws + WS_MIX);

    LAUNDER();
    {
        const bf16 *XR = (const bf16*)(ws + WS_XR), *GT = (const bf16*)(ws + WS_GT), *WAT = (const bf16*)(ws + WS_WAT), *WXT = (const bf16*)(ws + WS_WXT);
        const bf16 *Qb = (const bf16*)(ws + WS_Q), *KBb = (const bf16*)(ws + WS_KB), *VBb = (const bf16*)(ws + WS_VB);
        const bool samp_first = (F.vcu & 1) == 0;
        if (samp_first) for (int it = F.vcu; it < NBS * 8; it += F.G) sattn_item(F, it >> 3, it & 7, it, (const float*)args.in[4], (const float*)args.in[5], (const int*)args.in[8], Qb, (float*)(ws + WS_SPART), (float*)(ws + WS_SSTAT));
        for (int pu = F.vcu; pu < 256; pu += F.G) {
            const int bh = pu >> 3, s = pu & 7;
            pattn_unit(F, bh >> 2, bh & 3, s, Qb, KBb, VBb, MIX, lam, subln);
            pattn_unit(F, bh >> 2, bh & 3, 15 - s, Qb, KBb, VBb, MIX, lam, subln);
        }
        for (int u = F.vcu; u < 256; u += F.G) rg_prompt_unit<true>(F, args, u >> 5, (u >> 2) & 7, u & 3, XR, GT, WAT, WXT, MIX, out + O_HP, (float*)(ws + WS_RGC));
        if (!samp_first) for (int it = F.vcu; it < NBS * 8; it += F.G) sattn_item(F, it >> 3, it & 7, it, (const float*)args.in[4], (const float*)args.in[5], (const int*)args.in[8], Qb, (float*)(ws + WS_SPART), (float*)(ws + WS_SSTAT));
    }
    xcd_barrier(bar);

    LAUNDER();
    {
        const int gw = F.vcu * NWAVES + F.wave, NGW = F.G * NWAVES;
        for (int u = F.vcu; u < 256; u += F.G) rg_prompt_unit<false>(F, args, u >> 5, (u >> 2) & 7, u & 3, (const bf16*)(ws + WS_XR), (const bf16*)(ws + WS_GT), (const bf16*)(ws + WS_WAT), (const bf16*)(ws + WS_WXT), MIX, out + O_HP, (float*)(ws + WS_RGC));
        for (int u = NGW - 1 - gw; u < NBS * 8; u += NGW) rg_sample_unit(F, args, u >> 3, u & 7, (const bf16*)(ws + WS_XR), (const bf16*)(ws + WS_GT), (const bf16*)(ws + WS_WAT), (const bf16*)(ws + WS_WXT), MIX, out + O_HS);
        for (int u = gw; u < NBS * 4 * 8; u += NGW) scomb_unit(F, u >> 5, (u >> 3) & 3, u & 7, (const bf16*)(ws + WS_Q), (const bf16*)(ws + WS_KB), (const bf16*)(ws + WS_VB), (const float*)(ws + WS_SPART), (const float*)(ws + WS_SSTAT), MIX, lam, subln);
    }
    xcd_barrier(bar);

    LAUNDER();
    {
        pg8::Gemm g{(const pg8::bf16_t*)(ws + WS_MIX), (const pg8::bf16_t*)(ws + WS_WOUT_T), MP, D, D}; pg8::StaticOrder S; S.init(MP, D, F.G, (int)blockIdx.x);
        pg8::EpiPre1 E{(const pg8::bf16_t*)(ws + WS_XB), (pg8::bf16_t*)(ws + WS_PRE1), ALPHA};
        pg8::gemm_phase<pg8::EpiPre1, pg8::StaticOrder, true, true>(F.lds + RING_OFF, g, S, E);
        { const float* xs = (const float*)args.in[1]; bf16* PRE1s = (bf16*)(ws + WS_PRE1) + (size_t)MP * D;
          sample_gemm_ks(F, (const bf16*)(ws + WS_MIX) + (size_t)MP * D, (const bf16*)(ws + WS_WOUT_T), D,
              [&](int row, int col) { return *(const GAS f32x2v_t*)(xs + (size_t)row * D + col); },
              [&](int row, int col, float v0, float v1, const f32x2v_t& x) { *(GAS unsigned*)(PRE1s + (size_t)row * D + col) = pk2(ALPHA * x.x + v0, ALPHA * x.y + v1); }); }
    }
    xcd_barrier(bar);

    LAUNDER();
    {
        const int gw = F.vcu * NWAVES + F.wave, NGW = F.G * NWAVES;
        {
            const bf16* PRE = (const bf16*)(ws + WS_PRE1);
            size_t rc[3], rn[3]; LnRaw<3> cur, nxt;
#pragma unroll
            for (int r = 0; r < 3; ++r) rc[r] = (size_t)(gw + r * NGW < M ? gw + r * NGW : M - 1);
            ln1_load<3>(cur, F.lane, PRE, rc);
            for (int m0 = gw; m0 < M; m0 += 3 * NGW) {
#pragma unroll
                for (int r = 0; r < 3; ++r) { const int m = m0 + (3 + r) * NGW; rn[r] = (size_t)(m < M ? m : M - 1); }
                ln1_load<3>(nxt, F.lane, PRE, rn);
                ln1_rows<3>(cur, F.lane, rc, (const float*)args.in[23], (const float*)args.in[24], (float*)(ws + WS_X1), (bf16*)(ws + WS_X1B), ws + WS_X1Q, (float*)(ws + WS_SX));
#pragma unroll
                for (int r = 0; r < 3; ++r) ((GAS u32x2v_t*)((int*)(ws + WS_PART) + rc[r] * 128))[F.lane] = (u32x2v_t){0u, 0u};
                cur = nxt;
#pragma unroll
                for (int r = 0; r < 3; ++r) rc[r] = rn[r];
            }
        }
    }
    xcd_barrier(bar);

    LAUNDER();
    {
        pg8::Gemm g{(const pg8::bf16_t*)(ws + WS_X1B), (const pg8::bf16_t*)(ws + WS_WQ_T), MP, 2048, D}; pg8::StaticOrder S; S.init(MP, 2048, F.G, (int)blockIdx.x);
        pg8::EpiBf16 E{(pg8::bf16_t*)(ws + WS_PQ), 2048};
        pg8::gemm_phase<pg8::EpiBf16, pg8::StaticOrder, true, true>(F.lds + RING_OFF, g, S, E);
        { bf16* PQs = (bf16*)(ws + WS_PQ) + (size_t)MP * 2048;
          sample_gemm_ks(F, (const bf16*)(ws + WS_X1B) + (size_t)MP * D, (const bf16*)(ws + WS_WQ_T), 2048,
              [&](int, int) { return 0; },
              [&](int row, int col, float v0, float v1, int) { *(GAS unsigned*)(PQs + (size_t)row * 2048 + col) = pk2(v0, v1); }); }
    }
    xcd_barrier(bar);

    LAUNDER();
    {
        const int h5 = F.vcu & 7, cg = F.vcu >> 3, ngr = F.G >> 3, NTG = M / 32;
        { const GAS v4u* ksrc = (const GAS v4u*)((const bf16*)(ws + WS_KEYS) + (size_t)h5 * 2 * 16384);
#pragma unroll
          for (int i = 0; i < 8; ++i) { const int gch = F.tid + 512 * i, row = gch >> 4, c = gch & 15;
              *(LAS v4u*)(F.lds + RING_OFF + TK_KEYS_OFF + row * 256 + ((c ^ (row & 15)) * 16)) = ksrc[gch]; }
          __syncthreads(); }
        const int ntg = cg < NTG ? (NTG - cg + ngr - 1) / ngr : 0;
        { bf16x8 qn[8], kn[8];
          if (F.wave < ntg) peer_topk_prefetch(F.lane, __builtin_amdgcn_readfirstlane(cg + ngr * F.wave), h5, 0, (const bf16*)(ws + WS_PQ), (const bf16*)(ws + WS_KEYS), qn, kn);
          for (int j = F.wave; j < ntg; j += NWAVES) { const int jn = j + NWAVES;
              peer_topk_unit(F, __builtin_amdgcn_readfirstlane(cg + ngr * j), h5, __builtin_amdgcn_readfirstlane(cg + ngr * jn), h5, jn < ntg, qn, kn,
                             (const bf16*)(ws + WS_PQ), (const bf16*)(ws + WS_KEYS), (int*)(ws + WS_EIDX), (unsigned short*)(ws + WS_EIDXP), (float*)(ws + WS_GW)); } }
        { const bool std = (F.G == 256);
          const bool extra = std && F.vcu < 64 && F.wave == 0;
          const int lin = F.vcu * NWAVES + F.wave;
          const int before = std ? (F.vcu < 64 ? F.vcu + (F.wave > 0 ? 1 : 0) : 64) : 0;
          const int ncv = F.G * NWAVES - (std ? 64 : 0);
          if (!extra) for (int c = lin - before; c < 4096; c += ncv) {
              if (c < 2048) convert_i8_rows8((const float*)args.in[27], ws + WS_U, (float*)(ws + WS_USC), c * 8, F.lane);
              else convert_i8_rows8((const float*)args.in[28], ws + WS_V, (float*)(ws + WS_VSC), (c - 2048) * 8, F.lane);
          } }
    }
    xcd_barrier(bar);

    LAUNDER();
    {
        const unsigned char* X1Q = ws + WS_X1Q; const unsigned char* U8S = ws + WS_U; const unsigned short* EIDXP = (const unsigned short*)(ws + WS_EIDXP); int* PART = (int*)(ws + WS_PART);
        { const int cps = F.G >> 3, sl = F.vcu / cps, nws = cps * NWAVES, tpw = (M + nws - 1) / nws, tb = ((F.vcu % cps) * NWAVES + F.wave) * tpw, te = tb + tpw < M ? tb + tpw : M;
          if (sl < 8 && tb < te) peer_slice_stream<true>(F, sl, tb, te, U8S, EIDXP, X1Q, nullptr, PART); }
    }
    xcd_barrier(bar);

    LAUNDER();
    {
        const int gw = F.vcu * NWAVES + F.wave, NGW = F.G * NWAVES;
        for (int m0 = gw; m0 < M; m0 += 9 * NGW) {
            size_t toks[9];
#pragma unroll
            for (int r = 0; r < 9; ++r) toks[r] = (size_t)(m0 + r * NGW < M ? m0 + r * NGW : M - 1);
            peer_reduce_tokens<9>(F.lane, toks, (const int*)(ws + WS_PART), (const int*)(ws + WS_EIDX), (const float*)(ws + WS_USC), (const float*)(ws + WS_VSC), (const float*)(ws + WS_SX), (const float*)(ws + WS_GW), ws + WS_WQ, (float*)(ws + WS_SW));
        }
    }
    xcd_barrier(bar);

    LAUNDER();
    {
        const unsigned char* V8S = ws + WS_V; const unsigned short* EIDXP = (const unsigned short*)(ws + WS_EIDXP); float* FFN = (float*)(ws + WS_FFN);
        { const int cps = F.G >> 3, sl = F.vcu / cps, nws = cps * NWAVES, tpw = (M + nws - 1) / nws, tb = ((F.vcu % cps) * NWAVES + F.wave) * tpw, te = tb + tpw < M ? tb + tpw : M;
          if (sl < 8 && tb < te) peer_slice_stream<false>(F, sl, tb, te, V8S, EIDXP, ws + WS_WQ, (const float*)(ws + WS_SW), FFN); }
    }
    xcd_barrier(bar);

    LAUNDER();
    {
        const int gw = F.vcu * NWAVES + F.wave, NGW = F.G * NWAVES;
        {
            const bf16* X1Bp = (const bf16*)(ws + WS_X1B); const bf16* FFNp = (const bf16*)(ws + WS_FFN);
            size_t rc[3], rn[3]; Ln2Raw<3> cur, nxt;
#pragma unroll
            for (int r = 0; r < 3; ++r) rc[r] = (size_t)(gw + r * NGW < M ? gw + r * NGW : M - 1);
            ln2_load<3>(cur, F.lane, X1Bp, FFNp, rc);
            for (int m0 = gw; m0 < M; m0 += 3 * NGW) {
#pragma unroll
                for (int r = 0; r < 3; ++r) { const int m = m0 + (3 + r) * NGW; rn[r] = (size_t)(m < M ? m : M - 1); }
                ln2_load<3>(nxt, F.lane, X1Bp, FFNp, rn);
                ln2_rows<3>(cur, F.lane, rc, (const float*)args.in[29], (const float*)args.in[30], (float*)(ws + WS_X2), (bf16*)(ws + WS_X2B));
                cur = nxt;
#pragma unroll
                for (int r = 0; r < 3; ++r) rc[r] = rn[r];
            }
        }
    }
    xcd_barrier(bar);

    LAUNDER();
    {
        pg8::Gemm g{(const pg8::bf16_t*)(ws + WS_X2B), (const pg8::bf16_t*)(ws + WS_WG_T), MP, D, D}; pg8::StaticOrder S; S.init(MP, D, F.G, (int)blockIdx.x);
        pg8::EpiFinal E{(const pg8::bf16_t*)(ws + WS_X2B), (const pg8::bf16_t*)(ws + WS_PLE), (const float*)args.in[33], out + O_YP, out + O_YS, (float*)(ws + WS_PRE1)};
        pg8::gemm_phase<pg8::EpiFinal, pg8::StaticOrder, true, true>(F.lds + RING_OFF, g, S, E);
        { const bf16* X2Bs = (const bf16*)(ws + WS_X2B) + (size_t)MP * D; const bf16* PLEs = (const bf16*)(ws + WS_PLE) + (size_t)MP * D; const float* gb = (const float*)args.in[33]; float* ys = out + O_YS;
          struct P7Pre { unsigned x2, pl; f32x2v_t g; };
          sample_gemm_ks(F, X2Bs, (const bf16*)(ws + WS_WG_T), D,
              [&](int row, int col) { P7Pre q; q.x2 = *(const GAS unsigned*)(X2Bs + (size_t)row * D + col); q.pl = *(const GAS unsigned*)(PLEs + (size_t)row * D + col); q.g = *(const GAS f32x2v_t*)(gb + col); return q; },
              [&](int row, int col, float v0, float v1, const P7Pre& q) {
                  const float s0 = __builtin_amdgcn_rcpf(1.0f + __builtin_amdgcn_exp2f(-1.4426950408889634f * (v0 + q.g.x))), s1 = __builtin_amdgcn_rcpf(1.0f + __builtin_amdgcn_exp2f(-1.4426950408889634f * (v1 + q.g.y)));
                  f32x2v_t o; o.x = bf_lo(q.x2) + s0 * bf_lo(q.pl); o.y = bf_hi(q.x2) + s1 * bf_hi(q.pl);
                  *(GAS f32x2v_t*)(ys + (size_t)row * D + col) = o; }); }
    }
}

extern "C" void kernel_launch(void* const* d_in, const int* in_sizes, int n_in, void* d_out, int out_size, void* d_ws, size_t ws_size, hipStream_t stream) {
    static int grid = 0;
    if (grid == 0) {
        if (n_in != 34 || (size_t)out_size != O_END || ws_size < WS_END) { fprintf(stderr, "kernel_launch: unexpected shapes (n_in %d out %d ws %zu)\n", n_in, out_size, ws_size); grid = -1; return; }
        int dev = 0, cus = 0, per_cu = 0;
        if (hipGetDevice(&dev) != hipSuccess || hipDeviceGetAttribute(&cus, hipDeviceAttributeMultiprocessorCount, dev) != hipSuccess) { grid = -1; return; }
        if (hipFuncSetAttribute((const void*)mega_fwd, hipFuncAttributeMaxDynamicSharedMemorySize, LDS_BYTES) != hipSuccess) { fprintf(stderr, "kernel_launch: hipFuncSetAttribute failed\n"); grid = -1; return; }
        if (hipOccupancyMaxActiveBlocksPerMultiprocessor(&per_cu, (const void*)mega_fwd, NWAVES * 64, LDS_BYTES) != hipSuccess || per_cu < 1) { fprintf(stderr, "kernel_launch: occupancy query says %d\n", per_cu); }
        (void)hipGetLastError();
        grid = cus;
    }
    if (grid < 0) return;
    if (hipMemsetAsync((char*)d_ws + WS_CTL, 0, CTL_ZERO_BYTES, stream) != hipSuccess) return;
    Args a{};
    for (int i = 0; i < 34; ++i) a.in[i] = d_in[i];
    a.out = (float*)d_out; a.ws = (unsigned char*)d_ws;
    hipLaunchKernelGGL(mega_fwd, dim3(grid), dim3(NWAVES * 64), LDS_BYTES, stream, a);
}
```
